# Optimizing an MI355X kernel written in HIP

```python
import math
import jax, jax.numpy as jnp
from jax import lax
import numpy as np

D_MODEL = 1024
BATCH = 8
SEQ = 8192
DEPTH = 4

N_GROUPS = 4
GROUP_WIDTH = D_MODEL // N_GROUPS
HEADS = 4
HEAD_DIM = GROUP_WIDTH // HEADS
N_SLICES = 11
IN_WIDTH = N_SLICES * GROUP_WIDTH
CHUNK = 128
ROPE_BASE = 10000.0
LRU_C = 8.0
LRU_CONV_WIDTH = 4
LRU_CONV_PAD = (2, 1)
SC_CONV_WIDTH = 3
SC_CONV_PAD = (1, 1)
D_FF = math.ceil(8 * D_MODEL / 3 / 256) * 256
DEEPNORM_ALPHA = (2 * DEPTH) ** 0.25
DEEPNORM_BETA = (8 * DEPTH) ** -0.25
LN_EPS = 1e-5

kernel_name = 'hybrid_parallel_group_encoder'


def layer_norm(x, g, b):
    xf = x.astype(jnp.float32)
    mu = xf.mean(-1, keepdims=True)
    var = jnp.square(xf - mu).mean(-1, keepdims=True)
    return ((xf - mu) * lax.rsqrt(var + LN_EPS) * g + b).astype(x.dtype)


def depthwise_conv(x, w, pad):
    return lax.conv_general_dilated(
        x, w[:, None, :], window_strides=(1,), padding=[pad],
        dimension_numbers=('NWC', 'WIO', 'NWC'), feature_group_count=x.shape[-1])


def gmlp_mixer(u, v, ln_g, ln_b, w_s, b_s):
    bsz, s, w = u.shape
    u = jax.nn.gelu(u)
    v = layer_norm(jax.nn.gelu(v), ln_g, ln_b)
    vc = v.reshape(bsz, s // CHUNK, CHUNK, HEADS, HEAD_DIM)
    mixed = jnp.einsum('hpq,bnqhd->bnphd', w_s, vc) + b_s.T[None, None, :, :, None]
    return u * mixed.reshape(bsz, s, w)


def rotary(x, cos, sin):
    x1, x2 = jnp.split(x, 2, axis=-1)
    return jnp.concatenate([x1 * cos - x2 * sin, x2 * cos + x1 * sin], axis=-1)


def retention_mixer(q, k, v, g, positions, gn_g, gn_b):
    bsz, s, w = q.shape
    nc, f32 = s // CHUNK, jnp.float32
    inv_freq = ROPE_BASE ** (-jnp.arange(0, HEAD_DIM, 2, dtype=f32) / HEAD_DIM)
    ang = positions.astype(f32)[..., None] * inv_freq
    cos, sin = jnp.cos(ang)[:, :, None, :], jnp.sin(ang)[:, :, None, :]
    shp = (bsz, s, HEADS, HEAD_DIM)
    qh = rotary(q.astype(f32).reshape(shp), cos, sin)
    kh = rotary(k.astype(f32).reshape(shp), cos, sin) * HEAD_DIM ** -0.5
    vh = v.astype(f32).reshape(shp)
    cshp = (bsz, nc, CHUNK, HEADS, HEAD_DIM)
    qc, kc, vc = qh.reshape(cshp), kh.reshape(cshp), vh.reshape(cshp)
    log_gamma = jnp.log1p(-jnp.exp2(-5.0 - jnp.arange(HEADS, dtype=f32)))
    idx = jnp.arange(CHUNK, dtype=f32)
    intra = jnp.exp(log_gamma[:, None, None] * jnp.abs(idx[:, None] - idx[None, :]))
    scores = jnp.einsum('bnihd,bnjhd->bnhij', qc, kc) * intra
    out = jnp.einsum('bnhij,bnjhe->bnihe', scores, vc)
    k_dec_f = jnp.exp(log_gamma[None, :] * (CHUNK - 1 - idx)[:, None])
    k_dec_b = jnp.exp(log_gamma[None, :] * idx[:, None])
    u_f = jnp.einsum('bnjhd,bnjhe->nbhde', kc * k_dec_f[None, None, :, :, None], vc)
    u_b = jnp.einsum('bnjhd,bnjhe->nbhde', kc * k_dec_b[None, None, :, :, None], vc)
    chunk_decay = jnp.exp(log_gamma * CHUNK)[None, :, None, None]

    def step(state, u):
        return chunk_decay * state + u, state

    zero = jnp.zeros((bsz, HEADS, HEAD_DIM, HEAD_DIM), f32)
    _, r_prev = lax.scan(step, zero, u_f)
    _, l_next = lax.scan(step, zero, u_b, reverse=True)
    q_dec_f = jnp.exp(log_gamma[None, :] * (idx + 1.0)[:, None])
    q_dec_b = jnp.exp(log_gamma[None, :] * (CHUNK - idx)[:, None])
    out = (out
           + jnp.einsum('bnihd,nbhde->bnihe', qc * q_dec_f[None, None, :, :, None], r_prev)
           + jnp.einsum('bnihd,nbhde->bnihe', qc * q_dec_b[None, None, :, :, None], l_next))
    out = out.reshape(shp)
    mu = out.mean(-1, keepdims=True)
    var = jnp.square(out - mu).mean(-1, keepdims=True)
    out = ((out - mu) * lax.rsqrt(var + LN_EPS)).reshape(bsz, s, w) * gn_g + gn_b
    return (jax.nn.silu(g.astype(f32)) * out).astype(q.dtype)


def linear_scan(a, b):
    def combine(left, right):
        a_l, b_l = left
        a_r, b_r = right
        return a_l * a_r, a_r * b_l + b_r
    _, h = lax.associative_scan(combine, (a, b), axis=1)
    return h


def rglru_mixer(xr, gate, conv_w, conv_b, w_a, b_a, w_x, b_x, lam):
    bsz, s, w = xr.shape
    f32 = jnp.float32
    xf = (depthwise_conv(xr, conv_w, LRU_CONV_PAD) + conv_b).astype(f32)
    xb = xf.reshape(bsz, s, HEADS, HEAD_DIM)
    r = jax.nn.sigmoid(jnp.einsum('bshi,zhij->zbshj', xb, w_a).reshape(2, bsz, s, w) + b_a[:, None, None, :])
    i = jax.nn.sigmoid(jnp.einsum('bshi,zhij->zbshj', xb, w_x).reshape(2, bsz, s, w) + b_x[:, None, None, :])
    log_a = -LRU_C * jax.nn.softplus(-lam.astype(f32))[:, None, None, :] * r
    a = jnp.exp(log_a)
    b = xf[None] * i * jnp.sqrt(-jnp.expm1(2.0 * log_a))
    h_fwd = linear_scan(a[0], b[0])
    h_bwd = jnp.flip(linear_scan(jnp.flip(a[1], 1), jnp.flip(b[1], 1)), 1)
    return ((h_fwd + h_bwd) * jax.nn.gelu(gate.astype(f32))).astype(gate.dtype)


def short_conv_mixer(bg, cg, h, conv_w):
    return bg * depthwise_conv(cg * h, conv_w, SC_CONV_PAD)


def setup_inputs(seed: int = 0) -> dict:
    key = jax.random.key(seed)
    ks = jax.random.split(key, 24)
    L, D, W = DEPTH, D_MODEL, GROUP_WIDTH
    f32 = jnp.float32
    nrm = lambda k, shape, scale: jax.random.normal(k, shape, f32) * scale
    gain = lambda k, shape: 1.0 + 0.02 * jax.random.normal(k, shape, f32)
    u = jax.random.uniform(ks[12], (L, 2, W), f32, 0.9, 0.999)
    sig = u ** (1.0 / LRU_C)
    lru_lambda = jnp.log(sig) - jnp.log1p(-sig)
    return {
        'x': jax.random.normal(ks[0], (BATCH, SEQ, D), f32),
        'positions': jnp.broadcast_to(jnp.arange(SEQ, dtype=jnp.int32), (BATCH, SEQ)),
        'w_in': nrm(ks[1], (L, D, IN_WIDTH), D ** -0.5),
        'gmlp_ln_g': gain(ks[2], (L, W)),
        'gmlp_ln_b': nrm(ks[3], (L, W), 0.02),
        'gmlp_ws': nrm(ks[4], (L, HEADS, CHUNK, CHUNK), CHUNK ** -0.5),
        'gmlp_bs': gain(ks[5], (L, HEADS, CHUNK)),
        'ret_gn_g': gain(ks[6], (L, W)),
        'ret_gn_b': nrm(ks[7], (L, W), 0.02),
        'lru_conv_w': nrm(ks[8], (L, LRU_CONV_WIDTH, W), LRU_CONV_WIDTH ** -0.5),
        'lru_conv_b': nrm(ks[9], (L, W), 0.02),
        'lru_wa': nrm(ks[10], (L, 2, HEADS, HEAD_DIM, HEAD_DIM), HEAD_DIM ** -0.5),
        'lru_ba': nrm(ks[11], (L, 2, W), 0.02),
        'lru_wx': nrm(ks[13], (L, 2, HEADS, HEAD_DIM, HEAD_DIM), HEAD_DIM ** -0.5),
        'lru_bx': nrm(ks[14], (L, 2, W), 0.02),
        'lru_lambda': lru_lambda,
        'sc_conv_w': nrm(ks[15], (L, SC_CONV_WIDTH, W), SC_CONV_WIDTH ** -0.5),
        'w_out': nrm(ks[16], (L, D, D), D ** -0.5 * DEEPNORM_BETA),
        'ln1_g': gain(ks[17], (L, D)),
        'ln1_b': nrm(ks[18], (L, D), 0.02),
        'ffn_wg': nrm(ks[19], (L, D, D_FF), D ** -0.5),
        'ffn_wu': nrm(ks[20], (L, D, D_FF), D ** -0.5),
        'ffn_wd': nrm(ks[21], (L, D_FF, D), D_FF ** -0.5 * DEEPNORM_BETA),
        'ln2_g': gain(ks[22], (L, D)),
        'ln2_b': nrm(ks[23], (L, D), 0.02),
    }


def reference(x, positions, w_in, gmlp_ln_g, gmlp_ln_b, gmlp_ws, gmlp_bs, ret_gn_g, ret_gn_b,
              lru_conv_w, lru_conv_b, lru_wa, lru_ba, lru_wx, lru_bx, lru_lambda, sc_conv_w,
              w_out, ln1_g, ln1_b, ffn_wg, ffn_wu, ffn_wd, ln2_g, ln2_b):
    for l in range(DEPTH):
        z = jnp.einsum('bsd,dk->bsk', x, w_in[l])
        (a_u, a_v, r_q, r_k, r_v, r_g, c_x, c_gate, d_b, d_c, d_h) = jnp.split(z, N_SLICES, axis=-1)
        y = jnp.concatenate([
            gmlp_mixer(a_u, a_v, gmlp_ln_g[l], gmlp_ln_b[l], gmlp_ws[l], gmlp_bs[l]),
            retention_mixer(r_q, r_k, r_v, r_g, positions, ret_gn_g[l], ret_gn_b[l]),
            rglru_mixer(c_x, c_gate, lru_conv_w[l], lru_conv_b[l], lru_wa[l], lru_ba[l],
                        lru_wx[l], lru_bx[l], lru_lambda[l]),
            short_conv_mixer(d_b, d_c, d_h, sc_conv_w[l]),
        ], axis=-1)
        x = layer_norm(DEEPNORM_ALPHA * x + y @ w_out[l], ln1_g[l], ln1_b[l])
        f = (jax.nn.silu(x @ ffn_wg[l]) * (x @ ffn_wu[l])) @ ffn_wd[l]
        x = layer_norm(DEEPNORM_ALPHA * x + f, ln2_g[l], ln2_b[l])
    return x
```

```cpp
#include <hip/hip_runtime.h>
#include <hip/hip_cooperative_groups.h>
#include <cstdio>
#include <cstdint>
namespace cg = cooperative_groups;
namespace pg8 {
#define PG8_LAS __attribute__((address_space(3)))
typedef unsigned short bf16_t;
typedef short bf16x8 __attribute__((ext_vector_type(8)));
typedef float f32x4 __attribute__((ext_vector_type(4)));
typedef unsigned u32x4 __attribute__((ext_vector_type(4)));
constexpr int BM = 256, BK = 64, HALF = 128, HTB = HALF * BK * 2  , STAGE_BYTES = 8 * HTB, NXCD = 8, WGM = 8;

__host__ __device__ __forceinline__ int lds_byte(int r, int c) { const int st = (r >> 4) * 2 + (c >> 5), rr = r & 15, cc = c & 31, ob = rr * 64 + cc * 2; return st * 1024 + (ob ^ (((ob >> 9) & 1) << 5)); }
__host__ __device__ __forceinline__ void stage_rc(int b, int& R, int& C) { const int st = b / 1024, sb = b % 1024, swz = sb ^ (((sb >> 9) & 1) << 5); R = (st >> 1) * 16 + swz / 64; C = (st & 1) * 32 + (swz % 64) / 2; }
__host__ __device__ __forceinline__ int perm32(int rho) { const int n = rho >> 4, i = rho & 15; return 8 * (i >> 2) + 4 * n + (i & 3); }

struct Unit { int pm, pn; };
struct Gemm { const bf16_t* A; const bf16_t* Bt; int M, N, K; };

struct StaticOrder {
    int nM, nN, nwg, G, c;
    __host__ __device__ void init(int M, int N, int G_, int c_) { nM = M / BM; nN = N / BM; nwg = nM * nN; G = G_; c = c_; }
    __host__ __device__ bool next(int i, Unit& u) const {
        const long L = (long)i * G + c; if (L >= nwg) return false;
        int wgid = (int)L; { const int q = nwg / NXCD, r = nwg % NXCD, xcd = wgid % NXCD, off = wgid / NXCD; wgid = (xcd < r ? xcd * (q + 1) : r * (q + 1) + (xcd - r) * q) + off; }
        const int nig = WGM * nN, gid = wgid / nig, fm = gid * WGM, gsz = (nM - fm) < WGM ? (nM - fm) : WGM;
        u.pm = fm + ((wgid % nig) % gsz); u.pn = (wgid % nig) / gsz; return true;
    }
    __device__ __forceinline__ void a_ready(const Unit&) const {}
    __device__ __forceinline__ void done(const Unit&) const {}
};

__device__ __forceinline__ unsigned cvt_pk_bf16(float lo, float hi) { unsigned r; asm volatile("v_cvt_pk_bf16_f32 %0, %1, %2" : "=v"(r) : "v"(lo), "v"(hi)); return r; }
typedef float f32x2 __attribute__((ext_vector_type(2)));
__device__ __forceinline__ f32x2 gelu_pk(f32x2 v) {
    const f32x2 av = __builtin_elementwise_abs(v), d = av * 0.2316418882f + 1.0f;
    f32x2 t; t.x = __builtin_amdgcn_rcpf(d.x); t.y = __builtin_amdgcn_rcpf(d.y);
    f32x2 q = t * 0.5307027145f + (-0.7265760135f); q = q * t + 0.7107068705f; q = q * t + (-0.142248368f); q = q * t + 0.127414796f; q = q * t;
    const f32x2 s = (v * v) * (-0.72134752044f);
    f32x2 e; e.x = __builtin_amdgcn_exp2f(s.x); e.y = __builtin_amdgcn_exp2f(s.y);
    const f32x2 m = v * (q * e), r = v - m;
    f32x2 o; o.x = v.x < 0.f ? m.x : r.x; o.y = v.y < 0.f ? m.y : r.y; return o;
}

template <int ACT  > struct EpiBf16 {
    static constexpr bool PERM = true, AFTER_DRAIN = false; static_assert(ACT == 0 || ACT == 1, "EpiBf16: ACT is 0 (none) or 1 (gelu_pk)");
    bf16_t* O; int ldc; const float* bias; int split_cols; size_t split_stride; float scale0;
    __device__ __forceinline__ void operator()(const f32x4 (&acc)[2][2][4][2], const Unit& u, int wr, int wc, int fr, int fq) const {
        const int row0 = u.pm * BM + wr * 64 + fr; int colt = u.pn * BM; bf16_t* base = O;
        float sc = 1.f; if (split_cols) { const int t = colt / split_cols; base += (size_t)t * split_stride; colt -= t * split_cols; if (t == 0) sc = scale0; }
        const int col0 = colt + wc * 32 + 8 * fq, bcol0 = u.pn * BM + wc * 32 + 8 * fq;
        f32x4 bv[2][2];
#pragma unroll
        for (int bj = 0; bj < 2; ++bj)
#pragma unroll
            for (int n = 0; n < 2; ++n) bv[bj][n] = bias ? *(const f32x4*)(bias + bcol0 + bj * HALF + 4 * n) : (f32x4){0.f, 0.f, 0.f, 0.f};
#pragma unroll
        for (int ai = 0; ai < 2; ++ai)
#pragma unroll
            for (int m = 0; m < 4; ++m) { bf16_t* rowp = base + (size_t)(row0 + ai * HALF + m * 16) * ldc + col0;
#pragma unroll
                for (int bj = 0; bj < 2; ++bj) { f32x4 v0 = acc[ai][bj][m][0] + bv[bj][0], v1 = acc[ai][bj][m][1] + bv[bj][1];
                    if (ACT == 1) { f32x2 a = gelu_pk((f32x2){v0[0], v0[1]}), b = gelu_pk((f32x2){v0[2], v0[3]}), c = gelu_pk((f32x2){v1[0], v1[1]}), d = gelu_pk((f32x2){v1[2], v1[3]});
                        v0 = (f32x4){a.x, a.y, b.x, b.y}; v1 = (f32x4){c.x, c.y, d.x, d.y}; }
                    v0 = v0 * sc; v1 = v1 * sc; u32x4 w; w.x = cvt_pk_bf16(v0[0], v0[1]); w.y = cvt_pk_bf16(v0[2], v0[3]); w.z = cvt_pk_bf16(v1[0], v1[1]); w.w = cvt_pk_bf16(v1[2], v1[3]);
                    *(u32x4*)(rowp + bj * HALF) = w; } }
    }
};
template <class Epi, class Sched, bool ALIGN_EPI = false, bool SP2 = false>
__device__ __forceinline__ void gemm_phase(PG8_LAS unsigned char* lds, const Gemm g, const Sched& S, const Epi& E) {
    int tid_ = threadIdx.x; asm volatile("" : "+v"(tid_)); const int tid = tid_, wid = __builtin_amdgcn_readfirstlane(tid >> 6), lane = tid & 63, wr = wid >> 2, wc = wid & 3, fr = lane & 15, fq = lane >> 4;
    const int K = g.K, nt = K / BK;
    unsigned voffA[2], voffB[2];
#pragma unroll
    for (int i = 0; i < 2; ++i) { int R, C; stage_rc(tid * 16 + i * 8192, R, C); const int Rb = Epi::PERM ? ((R & ~31) + perm32(R & 31)) : R;
        voffA[i] = (unsigned)(R * K + C) * 2u; voffB[i] = (unsigned)(Rb * K + C) * 2u; }
    const size_t kstep = (size_t)(BK * 2);
    const size_t hstep = (size_t)HALF * K * 2;
    const size_t tstep = 2 * hstep;
    const unsigned ldsw = (unsigned)wid * 1024u;
    const int aoff = lds_byte(wr * 64 + fr, fq * 8), boff = lds_byte(wc * 32 + fr, fq * 8);
#define PG8_SA(b, h) (((b) * 2 + (h)) * HTB)
#define PG8_SB(b, h) ((4 + (b) * 2 + (h)) * HTB)
#define PG8_STAGE(bufoff, gbase, voff) do { _Pragma("unroll") for (int _i = 0; _i < 2; ++_i) \
        __builtin_amdgcn_global_load_lds((const unsigned*)((const char*)(gbase) + (voff)[_i]), (PG8_LAS unsigned*)(lds + (bufoff) + ldsw + _i * 8192), 16, 0, 0); } while (0)
#define PG8_LDA(dst, b, h) do { _Pragma("unroll") for (int m = 0; m < 4; ++m) _Pragma("unroll") for (int k = 0; k < 2; ++k) dst[m][k] = *(const PG8_LAS bf16x8*)(lds + PG8_SA(b, h) + aoff + m * 2048 + k * 1024); } while (0)
#define PG8_LDB(dst, b, h) do { _Pragma("unroll") for (int n = 0; n < 2; ++n) _Pragma("unroll") for (int k = 0; k < 2; ++k) dst[n][k] = *(const PG8_LAS bf16x8*)(lds + PG8_SB(b, h) + boff + n * 2048 + k * 1024); } while (0)
#define PG8_MMA(ai, bj, At, Bt) do { __builtin_amdgcn_s_setprio(1); _Pragma("unroll") for (int m = 0; m < 4; ++m) _Pragma("unroll") for (int n = 0; n < 2; ++n) _Pragma("unroll") for (int k = 0; k < 2; ++k) \
        acc[ai][bj][m][n] = __builtin_amdgcn_mfma_f32_16x16x32_bf16(Bt[n][k], At[m][k], acc[ai][bj][m][n], 0, 0, 0); __builtin_amdgcn_s_setprio(0); } while (0)
#define PG8_WAIT_V(n) asm volatile("s_waitcnt vmcnt(" #n ")" ::: "memory")
#define PG8_WAIT_L(n) asm volatile("s_waitcnt lgkmcnt(" #n ")" ::: "memory")
#define PG8_BAR __builtin_amdgcn_s_barrier()
#define PG8_SCHED __builtin_amdgcn_sched_barrier(0)
    Unit cur, nxt; int ui = 0;
    if (!S.next(0, cur)) return;
    f32x4 acc[2][2][4][2];
#pragma unroll
    for (int a = 0; a < 2; ++a)
#pragma unroll
        for (int b = 0; b < 2; ++b)
#pragma unroll
            for (int m = 0; m < 4; ++m)
#pragma unroll
                for (int n = 0; n < 2; ++n) acc[a][b][m][n] = (f32x4){0.f, 0.f, 0.f, 0.f};
    bf16x8 At[4][2], B0[2][2], B1[2][2];
    const char* cA = (const char*)g.A + (size_t)cur.pm * tstep; const char* cB = (const char*)g.Bt + (size_t)cur.pn * tstep;
    S.a_ready(cur);
    if constexpr (SP2) {
        PG8_STAGE(PG8_SB(0, 0), cB, voffB); PG8_STAGE(PG8_SB(0, 1), cB + hstep, voffB); PG8_STAGE(PG8_SA(0, 0), cA, voffA); PG8_STAGE(PG8_SA(0, 1), cA + hstep, voffA);
        if (wr == 1) PG8_BAR;
        PG8_WAIT_V(2); PG8_BAR;
        PG8_STAGE(PG8_SB(1, 0), cB + kstep, voffB); PG8_STAGE(PG8_SA(1, 0), cA + kstep, voffA); PG8_STAGE(PG8_SB(1, 1), cB + hstep + kstep, voffB);
        PG8_WAIT_V(6); PG8_BAR;
    } else {
        PG8_STAGE(PG8_SB(0, 0), cB, voffB); PG8_STAGE(PG8_SA(0, 0), cA, voffA); PG8_STAGE(PG8_SB(0, 1), cB + hstep, voffB); PG8_STAGE(PG8_SA(0, 1), cA + hstep, voffA);
        if (wr == 1) PG8_BAR;
        PG8_WAIT_V(4); PG8_BAR;
        PG8_STAGE(PG8_SB(1, 0), cB + kstep, voffB); PG8_STAGE(PG8_SA(1, 0), cA + kstep, voffA); PG8_STAGE(PG8_SB(1, 1), cB + hstep + kstep, voffB);
        PG8_WAIT_V(6); PG8_BAR;
    }
    for (;;) {
        const bool has_next = S.next(ui + 1, nxt);
        const char* nA = has_next ? (const char*)g.A + (size_t)nxt.pm * tstep : cA; const char* nB = has_next ? (const char*)g.Bt + (size_t)nxt.pn * tstep : cB;
        for (int t = 0; t < nt; t += 2) {
            const bool last = (t == nt - 2);
            const char* a1 = cA + (size_t)(t + 1) * kstep;
            const char* a2 = last ? nA : cA + (size_t)(t + 2) * kstep; const char* b2 = last ? nB : cB + (size_t)(t + 2) * kstep;
            const char* a3 = a2 + kstep; const char* b3 = b2 + kstep;
            if (last && has_next) S.a_ready(nxt);
            if constexpr (SP2) {
            PG8_LDB(B0, 0, 0); PG8_LDB(B1, 0, 1); PG8_SCHED; PG8_LDA(At, 0, 0); PG8_STAGE(PG8_SA(1, 1), a1 + hstep, voffA);
            PG8_WAIT_V(8); PG8_WAIT_L(0); PG8_BAR; PG8_MMA(0, 0, At, B0); PG8_MMA(0, 1, At, B1); PG8_BAR; PG8_SCHED;
            PG8_LDA(At, 0, 1); PG8_STAGE(PG8_SB(0, 0), b2, voffB); PG8_STAGE(PG8_SB(0, 1), b2 + hstep, voffB); PG8_STAGE(PG8_SA(0, 0), a2, voffA);
            PG8_WAIT_V(8); PG8_WAIT_L(0); PG8_BAR; PG8_MMA(1, 0, At, B0); PG8_MMA(1, 1, At, B1); PG8_BAR; PG8_SCHED;
            PG8_LDB(B0, 1, 0); PG8_LDB(B1, 1, 1); PG8_SCHED; PG8_LDA(At, 1, 0); PG8_STAGE(PG8_SA(0, 1), a2 + hstep, voffA);
            PG8_WAIT_V(8); PG8_WAIT_L(0); PG8_BAR; PG8_MMA(0, 0, At, B0); PG8_MMA(0, 1, At, B1); PG8_BAR; PG8_SCHED;
            PG8_LDA(At, 1, 1); PG8_STAGE(PG8_SB(1, 0), b3, voffB); PG8_STAGE(PG8_SB(1, 1), b3 + hstep, voffB); PG8_STAGE(PG8_SA(1, 0), a3, voffA);
            PG8_WAIT_V(8); PG8_WAIT_L(0); PG8_BAR; PG8_MMA(1, 0, At, B0); PG8_MMA(1, 1, At, B1); PG8_BAR; PG8_SCHED;
            } else {
            PG8_LDB(B0, 0, 0); PG8_SCHED; PG8_LDA(At, 0, 0); PG8_STAGE(PG8_SA(1, 1), a1 + hstep, voffA);
            PG8_WAIT_L(8); PG8_BAR; PG8_WAIT_L(0); PG8_MMA(0, 0, At, B0); PG8_BAR; PG8_SCHED;
            PG8_LDB(B1, 0, 1); PG8_STAGE(PG8_SB(0, 0), b2, voffB);
            PG8_BAR; PG8_WAIT_L(0); PG8_MMA(0, 1, At, B1); PG8_BAR;
            PG8_LDA(At, 0, 1); PG8_STAGE(PG8_SA(0, 0), a2, voffA);
            PG8_BAR; PG8_WAIT_L(0); PG8_MMA(1, 0, At, B0); PG8_BAR; PG8_SCHED;
            PG8_STAGE(PG8_SB(0, 1), b2 + hstep, voffB);
            PG8_WAIT_V(6); PG8_BAR; PG8_MMA(1, 1, At, B1); PG8_BAR;
            PG8_LDB(B0, 1, 0); PG8_SCHED; PG8_LDA(At, 1, 0); PG8_STAGE(PG8_SA(0, 1), a2 + hstep, voffA);
            PG8_WAIT_L(8); PG8_BAR; PG8_WAIT_L(0); PG8_MMA(0, 0, At, B0); PG8_BAR; PG8_SCHED;
            PG8_LDB(B1, 1, 1); PG8_STAGE(PG8_SB(1, 0), b3, voffB);
            PG8_BAR; PG8_WAIT_L(0); PG8_MMA(0, 1, At, B1); PG8_BAR;
            PG8_LDA(At, 1, 1); PG8_STAGE(PG8_SA(1, 0), a3, voffA);
            PG8_BAR; PG8_WAIT_L(0); PG8_MMA(1, 0, At, B0); PG8_BAR; PG8_SCHED;
            PG8_STAGE(PG8_SB(1, 1), b3 + hstep, voffB);
            PG8_WAIT_V(6); PG8_BAR; PG8_MMA(1, 1, At, B1); PG8_BAR;
            }
        }
        if constexpr (ALIGN_EPI) { if (wr == 0) PG8_BAR; }
        if constexpr (!Epi::AFTER_DRAIN) { E(acc, cur, wr, wc, fr, fq); S.done(cur); }
        if (!has_next) break;
#pragma unroll
        for (int a = 0; a < 2; ++a)
#pragma unroll
            for (int b = 0; b < 2; ++b)
#pragma unroll
                for (int m = 0; m < 4; ++m)
#pragma unroll
                    for (int n = 0; n < 2; ++n) acc[a][b][m][n] = (f32x4){0.f, 0.f, 0.f, 0.f};
        cur = nxt; cA = nA; cB = nB; ++ui;
        if constexpr (ALIGN_EPI) { if (wr == 1) PG8_BAR; }
    }
    PG8_WAIT_V(0);
    if constexpr (!ALIGN_EPI) { if (wr == 0) PG8_BAR; }
    PG8_BAR;
    if constexpr (Epi::AFTER_DRAIN) { E.fused(acc, cur, wr, wc, fr, fq, lds, wid, lane); S.done(cur); }
#undef PG8_SA
#undef PG8_SB
#undef PG8_STAGE
#undef PG8_LDA
#undef PG8_LDB
#undef PG8_MMA
#undef PG8_WAIT_V
#undef PG8_WAIT_L
#undef PG8_BAR
#undef PG8_SCHED
}
}

constexpr int BATCH = 8, SEQ = 8192, DM = 1024, DEPTH = 4, GWID = 256, NHEAD = 4, HDIM = 64, INW = 2816, CHUNK = 128, DFF = 2816;
constexpr int M = BATCH * SEQ;
constexpr int NCH = SEQ / CHUNK;
constexpr int NCHUNK = M / CHUNK;
constexpr float LN_EPS = 1e-5f;
constexpr float DN_ALPHA = 1.6817928305074290f;
constexpr int ZC_AU = 0, ZC_AV = 256, ZC_RQ = 512, ZC_RK = 768, ZC_RV = 1024, ZC_RG = 1280, ZC_CX = 1536, ZC_CG = 1792, ZC_DB = 2048, ZC_DC = 2304, ZC_DH = 2560;

#define LAS __attribute__((address_space(3)))
typedef unsigned short bf16;
typedef short bf16x8 __attribute__((ext_vector_type(8)));
typedef float f32x4 __attribute__((ext_vector_type(4)));
typedef unsigned u32x4 __attribute__((ext_vector_type(4)));
typedef unsigned u32x2 __attribute__((ext_vector_type(2)));

constexpr size_t SZ_WIN = (size_t)INW * DM * 2, SZ_WOUT = (size_t)DM * DM * 2, SZ_WGU = (size_t)2 * DFF * DM * 2, SZ_WD = (size_t)DM * DFF * 2, SZ_LRUW = (size_t)16 * 4096 * 2;
constexpr size_t OFF_WIN = 0;
constexpr size_t OFF_WOUT = OFF_WIN + DEPTH * SZ_WIN;
constexpr size_t OFF_WGU = OFF_WOUT + DEPTH * SZ_WOUT;
constexpr size_t OFF_WD = OFF_WGU + DEPTH * SZ_WGU;
constexpr size_t OFF_LRUW = OFF_WD + DEPTH * SZ_WD;
constexpr size_t OFF_XB = OFF_LRUW + DEPTH * SZ_LRUW;
constexpr size_t OFF_Z = OFF_XB + (size_t)M * DM * 2;
constexpr size_t OFF_Y = OFF_Z + (size_t)M * INW * 2;
constexpr size_t OFF_UF = OFF_Y + (size_t)M * DM * 2;
constexpr size_t USTRIDE = (size_t)BATCH * NHEAD * 4096;
constexpr size_t OFF_UB = OFF_UF + (size_t)NCH * USTRIDE * 4;
constexpr size_t OFF_CA = OFF_UB + (size_t)NCH * USTRIDE * 4;
constexpr size_t OFF_CH = OFF_CA + (size_t)BATCH * NCH * 512 * 4;
constexpr size_t WS_END = OFF_CH + (size_t)BATCH * NCH * 512 * 4;
constexpr int LDS_BYTES = 131072;

__device__ __forceinline__ float bflo(unsigned w) { return __uint_as_float(w << 16); }
__device__ __forceinline__ float bfhi(unsigned w) { return __uint_as_float(w & 0xffff0000u); }
__device__ __forceinline__ void unpack8(const u32x4 w, float* f) { f[0] = bflo(w.x); f[1] = bfhi(w.x); f[2] = bflo(w.y); f[3] = bfhi(w.y); f[4] = bflo(w.z); f[5] = bfhi(w.z); f[6] = bflo(w.w); f[7] = bfhi(w.w); }
__device__ __forceinline__ void unpack4(const u32x2 w, float* f) { f[0] = bflo(w.x); f[1] = bfhi(w.x); f[2] = bflo(w.y); f[3] = bfhi(w.y); }
__device__ __forceinline__ unsigned pk2(float lo, float hi) { return pg8::cvt_pk_bf16(lo, hi); }
__device__ __forceinline__ bf16 f2bf(float x) { return (bf16)(pg8::cvt_pk_bf16(x, 0.f) & 0xffffu); }
__device__ __forceinline__ u32x4 pack8(const float* f) { u32x4 w; w.x = pk2(f[0], f[1]); w.y = pk2(f[2], f[3]); w.z = pk2(f[4], f[5]); w.w = pk2(f[6], f[7]); return w; }
__device__ __forceinline__ float sigmoid_f(float x) { return __builtin_amdgcn_rcpf(1.0f + __expf(-x)); }
__device__ __forceinline__ float silu_f(float x) { return x * sigmoid_f(x); }
__device__ __forceinline__ float gelu_f(float x) { return x * sigmoid_f(1.5957691216057308f * (x + 0.044715f * x * x * x)); }
__device__ __forceinline__ float log_gamma_h(int h) { return h == 0 ? -0.0317486983145803f : (h == 1 ? -0.015748356968139168f : (h == 2 ? -0.007843177461025893f : -0.003913899321136329f)); }
__device__ __forceinline__ void rope_cs(float pos, int i, float& c, float& s) {
    const float invf = exp2f(-(float)i * 0.4152410118609203f);
    const float ang = pos * invf;
    const float n = rintf(ang * 0.15915494309189535f);
    float r = fmaf(-n, 6.2831854820251465f, ang); r = fmaf(-n, -1.7484555e-7f, r);
    const float rv = r * 0.15915494309189535f;
    s = __builtin_amdgcn_sinf(rv); c = __builtin_amdgcn_cosf(rv);
}
#define MFMA16(a, b, c) __builtin_amdgcn_mfma_f32_16x16x32_bf16((a), (b), (c), 0, 0, 0)
template <int CTRL> __device__ __forceinline__ float dpp_f(float oldv, float src) { return __int_as_float(__builtin_amdgcn_update_dpp(__float_as_int(oldv), __float_as_int(src), CTRL, 0xf, 0xf, false)); }

struct EpiRes {
    static constexpr bool PERM = false, AFTER_DRAIN = false;
    const float* res; float* out; float alpha;
    __device__ __forceinline__ void operator()(const pg8::f32x4 (&acc)[2][2][4][2], const pg8::Unit& u, int wr, int wc, int fr, int fq) const {
        const int row0 = u.pm * 256 + wr * 64 + fr, col0 = u.pn * 256 + wc * 32 + 4 * fq;
#pragma unroll
        for (int ai = 0; ai < 2; ++ai)
#pragma unroll
            for (int m = 0; m < 4; ++m) { const size_t off = (size_t)(row0 + ai * 128 + m * 16) * DM + col0;
#pragma unroll
                for (int bj = 0; bj < 2; ++bj)
#pragma unroll
                    for (int n = 0; n < 2; ++n) { const f32x4 r = *(const f32x4*)(res + off + bj * 128 + n * 16); *(f32x4*)(out + off + bj * 128 + n * 16) = r * alpha + acc[ai][bj][m][n]; }
                asm volatile("" ::: "memory"); }
    }
};
struct EpiSwiGLU {
    static constexpr bool PERM = true, AFTER_DRAIN = false;
    bf16* O;
    __device__ __forceinline__ void operator()(const pg8::f32x4 (&acc)[2][2][4][2], const pg8::Unit& u, int wr, int wc, int fr, int fq) const {
        const int row0 = u.pm * 256 + wr * 64 + fr, col0 = u.pn * 128 + wc * 32 + 8 * fq;
#pragma unroll
        for (int ai = 0; ai < 2; ++ai)
#pragma unroll
            for (int m = 0; m < 4; ++m) { bf16* rowp = O + (size_t)(row0 + ai * 128 + m * 16) * DFF + col0;
                const f32x4 g0 = acc[ai][0][m][0], g1 = acc[ai][0][m][1], u0 = acc[ai][1][m][0], u1 = acc[ai][1][m][1];
                u32x4 w; w.x = pk2(silu_f(g0[0]) * u0[0], silu_f(g0[1]) * u0[1]); w.y = pk2(silu_f(g0[2]) * u0[2], silu_f(g0[3]) * u0[3]);
                w.z = pk2(silu_f(g1[0]) * u1[0], silu_f(g1[1]) * u1[1]); w.w = pk2(silu_f(g1[2]) * u1[2], silu_f(g1[3]) * u1[3]);
                *(u32x4*)rowp = w; }
    }
};

struct Args { const void* in[25]; float* out; unsigned char* ws; };
struct Ctx {
    const float* x; const int* pos; const float* w_in; const float* gmlp_ln_g; const float* gmlp_ln_b; const float* gmlp_ws; const float* gmlp_bs; const float* ret_gn_g; const float* ret_gn_b;
    const float* lru_conv_w; const float* lru_conv_b; const float* lru_wa; const float* lru_ba; const float* lru_wx; const float* lru_bx; const float* lru_lambda; const float* sc_conv_w;
    const float* w_out; const float* ln1_g; const float* ln1_b; const float* ffn_wg; const float* ffn_wu; const float* ffn_wd; const float* ln2_g; const float* ln2_b;
    float* out; bf16 *WIN, *WOUT, *WGU, *WD, *LRUW, *XB, *Z, *Y; float *UF, *UB, *CA, *CH;
};

__device__ __forceinline__ void tr_item(const float* W, int N, bf16* dst_rows, int ldt, int k0, int n0, LAS float* scr, int lane) {
#pragma unroll 8
    for (int i = 0; i < 32; ++i) { const int kk = 2 * i + (lane >> 5); scr[kk * 33 + (lane & 31)] = W[(size_t)(k0 + kk) * N + n0 + (lane & 31)]; }
    asm volatile("s_waitcnt lgkmcnt(0)" ::: "memory");
    const int c = lane & 7;
#pragma unroll
    for (int j = 0; j < 4; ++j) { const int n = (lane >> 3) + 8 * j; const LAS float* s = scr + (8 * c) * 33 + n;
        u32x4 o; o.x = pk2(s[0 * 33], s[1 * 33]); o.y = pk2(s[2 * 33], s[3 * 33]); o.z = pk2(s[4 * 33], s[5 * 33]); o.w = pk2(s[6 * 33], s[7 * 33]);
        *(u32x4*)(dst_rows + (size_t)n * ldt + k0 + 8 * c) = o; }
    asm volatile("s_waitcnt lgkmcnt(0)" ::: "memory");
}
__device__ __forceinline__ void prologue(const Ctx& C, LAS unsigned char* lds) {
    int tid_ = threadIdx.x; asm volatile("" : "+v"(tid_)); const int tid = tid_, lane = tid & 63, wave = tid >> 6;
    LAS float* scr = (LAS float*)(lds + wave * 16384);
    const int gw = blockIdx.x * 8 + wave, NGW = gridDim.x * 8;
    constexpr int I_IN = (DM / 64) * (INW / 32), I_OUT = (DM / 64) * (DM / 32), I_G = (DM / 64) * (DFF / 32), I_D = (DFF / 64) * (DM / 32), I_L = 8 * 2;
    constexpr int PER_LAYER = I_IN + I_OUT + 2 * I_G + I_D + 2 * I_L;
    for (int it = gw; it < DEPTH * PER_LAYER; it += NGW) {
        const int l = it / PER_LAYER; int r = it % PER_LAYER;
        if (r < I_IN) { const int nb = INW / 32, k0 = 64 * (r / nb), n0 = 32 * (r % nb); tr_item(C.w_in + (size_t)l * DM * INW, INW, C.WIN + (size_t)l * INW * DM + (size_t)n0 * DM, DM, k0, n0, scr, lane); continue; } r -= I_IN;
        if (r < I_OUT) { const int nb = DM / 32, k0 = 64 * (r / nb), n0 = 32 * (r % nb); tr_item(C.w_out + (size_t)l * DM * DM, DM, C.WOUT + (size_t)l * DM * DM + (size_t)n0 * DM, DM, k0, n0, scr, lane); continue; } r -= I_OUT;
        if (r < 2 * I_G) { const int up = r >= I_G; if (up) r -= I_G; const int nb = DFF / 32, k0 = 64 * (r / nb), n0 = 32 * (r % nb); const int drow = 256 * (n0 / 128) + (n0 % 128) + (up ? 128 : 0);
            tr_item((up ? C.ffn_wu : C.ffn_wg) + (size_t)l * DM * DFF, DFF, C.WGU + (size_t)l * 2 * DFF * DM + (size_t)drow * DM, DM, k0, n0, scr, lane); continue; } r -= 2 * I_G;
        if (r < I_D) { const int nb = DM / 32, k0 = 64 * (r / nb), n0 = 32 * (r % nb); tr_item(C.ffn_wd + (size_t)l * DFF * DM, DM, C.WD + (size_t)l * DM * DFF + (size_t)n0 * DFF, DFF, k0, n0, scr, lane); continue; } r -= I_D;
        { const int which = r >= I_L; if (which) r -= I_L; const int mat = r >> 1, n0 = 32 * (r & 1);
          tr_item((which ? C.lru_wx : C.lru_wa) + ((size_t)l * 8 + mat) * 4096, 64, C.LRUW + (((size_t)l * 2 + which) * 8 + mat) * 4096 + (size_t)n0 * 64, 64, 0, n0, scr, lane); }
    }
    const size_t gt = (size_t)blockIdx.x * 512 + tid, NT = (size_t)gridDim.x * 512;
    for (size_t i = gt; i < (size_t)M * DM / 8; i += NT) { const f32x4 a = *(const f32x4*)(C.x + i * 8), b = *(const f32x4*)(C.x + i * 8 + 4);
        u32x4 o; o.x = pk2(a[0], a[1]); o.y = pk2(a[2], a[3]); o.z = pk2(b[0], b[1]); o.w = pk2(b[2], b[3]); *(u32x4*)(C.XB + i * 8) = o; }
}

__device__ __forceinline__ float wave_sum(float v) {
#pragma unroll
    for (int o = 1; o < 64; o <<= 1) v += __shfl_xor(v, o);
    return v;
}
__device__ __forceinline__ void ln_phase(float* X, bf16* XB, const float* g, const float* b, bool write_bf) {
    int tid_ = threadIdx.x; asm volatile("" : "+v"(tid_)); const int lane = tid_ & 63, wave = tid_ >> 6;
    const int gw = blockIdx.x * 8 + wave, NGW = gridDim.x * 8;
    f32x4 gv[4], bv[4];
#pragma unroll
    for (int j = 0; j < 4; ++j) { gv[j] = *((const f32x4*)g + lane + 64 * j); bv[j] = *((const f32x4*)b + lane + 64 * j); }
    for (int m = gw; m < M; m += NGW) {
        f32x4* xr = (f32x4*)(X + (size_t)m * DM) + lane;
        f32x4 v[4]; float s = 0.f;
#pragma unroll
        for (int j = 0; j < 4; ++j) { v[j] = xr[64 * j]; s += (v[j][0] + v[j][1]) + (v[j][2] + v[j][3]); }
        const float mean = wave_sum(s) * (1.f / DM); float s2 = 0.f;
#pragma unroll
        for (int j = 0; j < 4; ++j) { v[j] = v[j] - mean; s2 += (v[j][0] * v[j][0] + v[j][1] * v[j][1]) + (v[j][2] * v[j][2] + v[j][3] * v[j][3]); }
        const float rstd = 1.f / sqrtf(wave_sum(s2) * (1.f / DM) + LN_EPS);
#pragma unroll
        for (int j = 0; j < 4; ++j) { const f32x4 o = v[j] * rstd * gv[j] + bv[j]; xr[64 * j] = o;
            if (write_bf) { u32x2 w; w.x = pk2(o[0], o[1]); w.y = pk2(o[2], o[3]); *((u32x2*)(XB + (size_t)m * DM) + lane + 64 * j) = w; } }
    }
}

__device__ __forceinline__ void gmlp_chunk(const Ctx& C, int l, int chunk, LAS unsigned char* lds) {
    int tid_ = threadIdx.x; asm volatile("" : "+v"(tid_)); const int tid = tid_, lane = tid & 63, w = tid >> 6, fr = lane & 15, fq = lane >> 4;
    LAS bf16* vnT = (LAS bf16*)lds;
    const int row0 = chunk * CHUNK;
    {
        const int t = tid >> 2, q4 = tid & 3;
        const bf16* src = C.Z + (size_t)(row0 + t) * INW + ZC_AV + 64 * q4;
        float v[64]; float s = 0.f;
#pragma unroll
        for (int i = 0; i < 8; ++i) { const u32x4 wv = *(const u32x4*)(src + 8 * i); float f[8]; unpack8(wv, f);
#pragma unroll
            for (int j = 0; j < 8; ++j) { v[8 * i + j] = gelu_f(f[j]); s += v[8 * i + j]; } }
        s += __shfl_xor(s, 1); s += __shfl_xor(s, 2);
        const float mean = s * (1.f / 256.f); float q = 0.f;
#pragma unroll
        for (int i = 0; i < 64; ++i) { v[i] -= mean; q += v[i] * v[i]; }
        q += __shfl_xor(q, 1); q += __shfl_xor(q, 2);
        const float rstd = 1.f / sqrtf(q * (1.f / 256.f) + LN_EPS);
        const float* g = C.gmlp_ln_g + l * GWID + 64 * q4; const float* bb = C.gmlp_ln_b + l * GWID + 64 * q4;
#pragma unroll
        for (int i = 0; i < 64; ++i) vnT[(64 * q4 + i) * 136 + t] = f2bf(v[i] * rstd * g[i] + bb[i]);
    }
    __syncthreads();
    {
        const int p = 16 * w + fr;
#pragma unroll 1
        for (int h = 0; h < NHEAD; ++h) {
            f32x4 acc[4];
#pragma unroll
            for (int nt = 0; nt < 4; ++nt) acc[nt] = (f32x4){0.f, 0.f, 0.f, 0.f};
            const float* wsrow = C.gmlp_ws + ((size_t)(l * NHEAD + h) * CHUNK + p) * CHUNK;
#pragma unroll
            for (int ks = 0; ks < 4; ++ks) {
                const f32x4 a0 = *(const f32x4*)(wsrow + 32 * ks + 8 * fq), a1 = *(const f32x4*)(wsrow + 32 * ks + 8 * fq + 4);
                u32x4 aw; aw.x = pk2(a0[0], a0[1]); aw.y = pk2(a0[2], a0[3]); aw.z = pk2(a1[0], a1[1]); aw.w = pk2(a1[2], a1[3]);
                const bf16x8 af = __builtin_bit_cast(bf16x8, aw);
#pragma unroll
                for (int nt = 0; nt < 4; ++nt) { const bf16x8 bfg = *(const LAS bf16x8*)(vnT + (64 * h + 16 * nt + fr) * 136 + 32 * ks + 8 * fq); acc[nt] = MFMA16(bfg, af, acc[nt]); }
            }
            const float bias = C.gmlp_bs[(l * NHEAD + h) * CHUNK + p];
#pragma unroll
            for (int nt = 0; nt < 4; ++nt) { const int c = 64 * h + 16 * nt + 4 * fq;
                const u32x2 uw = *(const u32x2*)(C.Z + (size_t)(row0 + p) * INW + ZC_AU + c); float uf[4]; unpack4(uw, uf);
                u32x2 o; o.x = pk2(gelu_f(uf[0]) * (acc[nt][0] + bias), gelu_f(uf[1]) * (acc[nt][1] + bias)); o.y = pk2(gelu_f(uf[2]) * (acc[nt][2] + bias), gelu_f(uf[3]) * (acc[nt][3] + bias));
                *(u32x2*)(C.Y + (size_t)(row0 + p) * DM + 0 + c) = o; }
        }
    }
    __syncthreads();
}

__device__ __forceinline__ void ret_pass1(const Ctx& C, int chunk, LAS unsigned char* lds) {
    int tid_ = threadIdx.x; asm volatile("" : "+v"(tid_)); const int tid = tid_, lane = tid & 63, w = tid >> 6, fr = lane & 15, fq = lane >> 4;
    LAS bf16* vT = (LAS bf16*)lds; LAS bf16* kfT = vT + 64 * 136; LAS bf16* kbT = kfT + 64 * 136;
    const int b = chunk >> 6, n = chunk & 63, row0 = chunk * CHUNK;
#pragma unroll 1
    for (int h = 0; h < NHEAD; ++h) {
        {
            const int j = tid >> 2, sub = tid & 3;
            const bf16* zrow = C.Z + (size_t)(row0 + j) * INW;
            const u32x4 k1w = *(const u32x4*)(zrow + ZC_RK + 64 * h + 8 * sub), k2w = *(const u32x4*)(zrow + ZC_RK + 64 * h + 32 + 8 * sub);
            const u32x4 v1w = *(const u32x4*)(zrow + ZC_RV + 64 * h + 16 * sub), v2w = *(const u32x4*)(zrow + ZC_RV + 64 * h + 16 * sub + 8);
            const float pos = (float)C.pos[row0 + j];
            const float lgm = log_gamma_h(h);
            const float decf = __expf(lgm * (float)(CHUNK - 1 - j)) * 0.125f, decb = __expf(lgm * (float)j) * 0.125f;
            float k1[8], k2[8]; unpack8(k1w, k1); unpack8(k2w, k2);
#pragma unroll
            for (int ii = 0; ii < 8; ++ii) { const int i = 8 * sub + ii; float c, s; rope_cs(pos, i, c, s);
                const float r1 = k1[ii] * c - k2[ii] * s, r2 = k2[ii] * c + k1[ii] * s;
                kfT[i * 136 + j] = f2bf(r1 * decf); kfT[(32 + i) * 136 + j] = f2bf(r2 * decf);
                kbT[i * 136 + j] = f2bf(r1 * decb); kbT[(32 + i) * 136 + j] = f2bf(r2 * decb); }
            const unsigned vw[8] = {v1w.x, v1w.y, v1w.z, v1w.w, v2w.x, v2w.y, v2w.z, v2w.w};
#pragma unroll
            for (int ii = 0; ii < 8; ++ii) { vT[(16 * sub + 2 * ii) * 136 + j] = (bf16)(vw[ii] & 0xffffu); vT[(16 * sub + 2 * ii + 1) * 136 + j] = (bf16)(vw[ii] >> 16); }
        }
        __syncthreads();
        {
            const int z = w >> 2, mt = w & 3; LAS bf16* kT = z ? kbT : kfT;
            f32x4 acc[4];
#pragma unroll
            for (int nt = 0; nt < 4; ++nt) acc[nt] = (f32x4){0.f, 0.f, 0.f, 0.f};
#pragma unroll
            for (int ks = 0; ks < 4; ++ks) { const bf16x8 af = *(const LAS bf16x8*)(vT + (16 * mt + fr) * 136 + 32 * ks + 8 * fq);
#pragma unroll
                for (int nt = 0; nt < 4; ++nt) { const bf16x8 bfg = *(const LAS bf16x8*)(kT + (16 * nt + fr) * 136 + 32 * ks + 8 * fq); acc[nt] = MFMA16(bfg, af, acc[nt]); } }
            float* U = (z ? C.UB : C.UF) + (size_t)n * USTRIDE + (size_t)(b * NHEAD + h) * 4096;
#pragma unroll
            for (int nt = 0; nt < 4; ++nt) *(f32x4*)(U + (16 * mt + fr) * 64 + 16 * nt + 4 * fq) = acc[nt];
        }
        __syncthreads();
    }
}

__device__ __forceinline__ void ret_pass2(const Ctx& C, int l, int chunk, LAS unsigned char* lds) {
    int tid_ = threadIdx.x; asm volatile("" : "+v"(tid_)); const int tid = tid_, lane = tid & 63, w = tid >> 6, fr = lane & 15, fq = lane >> 4;
    LAS bf16* kr = (LAS bf16*)lds; LAS bf16* qr = kr + 128 * 72; LAS bf16* BT = qr + 128 * 72; LAS bf16* Ss = BT + 64 * 264;
    const int b = chunk >> 6, n = chunk & 63, row0 = chunk * CHUNK;
#pragma unroll 1
    for (int h = 0; h < NHEAD; ++h) {
        const float lgm = log_gamma_h(h);
        {
            const int j = tid >> 2, sub = tid & 3;
            const bf16* zrow = C.Z + (size_t)(row0 + j) * INW;
            const u32x4 q1w = *(const u32x4*)(zrow + ZC_RQ + 64 * h + 8 * sub), q2w = *(const u32x4*)(zrow + ZC_RQ + 64 * h + 32 + 8 * sub);
            const u32x4 k1w = *(const u32x4*)(zrow + ZC_RK + 64 * h + 8 * sub), k2w = *(const u32x4*)(zrow + ZC_RK + 64 * h + 32 + 8 * sub);
            const u32x4 v1w = *(const u32x4*)(zrow + ZC_RV + 64 * h + 16 * sub), v2w = *(const u32x4*)(zrow + ZC_RV + 64 * h + 16 * sub + 8);
            const float pos = (float)C.pos[row0 + j];
            float q1[8], q2[8], k1[8], k2[8]; unpack8(q1w, q1); unpack8(q2w, q2); unpack8(k1w, k1); unpack8(k2w, k2);
            float oq1[8], oq2[8], ok1[8], ok2[8];
#pragma unroll
            for (int ii = 0; ii < 8; ++ii) { float c, s; rope_cs(pos, 8 * sub + ii, c, s);
                oq1[ii] = q1[ii] * c - q2[ii] * s; oq2[ii] = q2[ii] * c + q1[ii] * s;
                ok1[ii] = (k1[ii] * c - k2[ii] * s) * 0.125f; ok2[ii] = (k2[ii] * c + k1[ii] * s) * 0.125f; }
            *(LAS u32x4*)(qr + j * 72 + 8 * sub) = pack8(oq1); *(LAS u32x4*)(qr + j * 72 + 32 + 8 * sub) = pack8(oq2);
            *(LAS u32x4*)(kr + j * 72 + 8 * sub) = pack8(ok1); *(LAS u32x4*)(kr + j * 72 + 32 + 8 * sub) = pack8(ok2);
            const unsigned vw[8] = {v1w.x, v1w.y, v1w.z, v1w.w, v2w.x, v2w.y, v2w.z, v2w.w};
#pragma unroll
            for (int ii = 0; ii < 8; ++ii) { BT[(16 * sub + 2 * ii) * 264 + j] = (bf16)(vw[ii] & 0xffffu); BT[(16 * sub + 2 * ii + 1) * 264 + j] = (bf16)(vw[ii] >> 16); }
            const int e = tid >> 3, d0 = 8 * (tid & 7);
            const size_t uo = (size_t)n * USTRIDE + (size_t)(b * NHEAD + h) * 4096 + e * 64 + d0;
            { const f32x4 a = *(const f32x4*)(C.UF + uo), c4 = *(const f32x4*)(C.UF + uo + 4); u32x4 o; o.x = pk2(a[0], a[1]); o.y = pk2(a[2], a[3]); o.z = pk2(c4[0], c4[1]); o.w = pk2(c4[2], c4[3]); *(LAS u32x4*)(BT + e * 264 + 128 + d0) = o; }
            { const f32x4 a = *(const f32x4*)(C.UB + uo), c4 = *(const f32x4*)(C.UB + uo + 4); u32x4 o; o.x = pk2(a[0], a[1]); o.y = pk2(a[2], a[3]); o.z = pk2(c4[0], c4[1]); o.w = pk2(c4[2], c4[3]); *(LAS u32x4*)(BT + e * 264 + 192 + d0) = o; }
        }
        __syncthreads();
        {
            const int i = 16 * w + fr;
            bf16x8 qf[2];
#pragma unroll
            for (int ks = 0; ks < 2; ++ks) qf[ks] = *(const LAS bf16x8*)(qr + i * 72 + 32 * ks + 8 * fq);
            LAS bf16* Sw = Ss + w * 16 * 136;
#pragma unroll
            for (int nt = 0; nt < 8; ++nt) { f32x4 s = (f32x4){0.f, 0.f, 0.f, 0.f};
#pragma unroll
                for (int ks = 0; ks < 2; ++ks) { const bf16x8 kf = *(const LAS bf16x8*)(kr + (16 * nt + fr) * 72 + 32 * ks + 8 * fq); s = MFMA16(kf, qf[ks], s); }
                float sv[4];
#pragma unroll
                for (int r = 0; r < 4; ++r) { const int jj = 16 * nt + 4 * fq + r; sv[r] = s[r] * __expf(lgm * fabsf((float)(i - jj))); }
                u32x2 o; o.x = pk2(sv[0], sv[1]); o.y = pk2(sv[2], sv[3]);
                *(LAS u32x2*)(Sw + fr * 136 + 16 * nt + 4 * fq) = o; }
            asm volatile("s_waitcnt lgkmcnt(0)" ::: "memory");
            f32x4 a1[4], a2[4], a3[4];
#pragma unroll
            for (int nt = 0; nt < 4; ++nt) { a1[nt] = (f32x4){0.f, 0.f, 0.f, 0.f}; a2[nt] = a1[nt]; a3[nt] = a1[nt]; }
#pragma unroll
            for (int ks = 0; ks < 4; ++ks) { const bf16x8 sf = *(const LAS bf16x8*)(Sw + fr * 136 + 32 * ks + 8 * fq);
#pragma unroll
                for (int nt = 0; nt < 4; ++nt) { const bf16x8 bfr = *(const LAS bf16x8*)(BT + (16 * nt + fr) * 264 + 32 * ks + 8 * fq); a1[nt] = MFMA16(bfr, sf, a1[nt]); } }
#pragma unroll
            for (int ks = 0; ks < 2; ++ks)
#pragma unroll
                for (int nt = 0; nt < 4; ++nt) { const bf16x8 b2 = *(const LAS bf16x8*)(BT + (16 * nt + fr) * 264 + 128 + 32 * ks + 8 * fq); a2[nt] = MFMA16(b2, qf[ks], a2[nt]);
                    const bf16x8 b3 = *(const LAS bf16x8*)(BT + (16 * nt + fr) * 264 + 192 + 32 * ks + 8 * fq); a3[nt] = MFMA16(b3, qf[ks], a3[nt]); }
            const float sfw = __expf(lgm * (float)(i + 1)), sbw = __expf(lgm * (float)(CHUNK - i));
            float sum = 0.f;
#pragma unroll
            for (int nt = 0; nt < 4; ++nt) { a1[nt] = a1[nt] + a2[nt] * sfw + a3[nt] * sbw; sum += (a1[nt][0] + a1[nt][1]) + (a1[nt][2] + a1[nt][3]); }
            sum += __shfl_xor(sum, 16); sum += __shfl_xor(sum, 32);
            const float mean = sum * (1.f / 64.f); float q = 0.f;
#pragma unroll
            for (int nt = 0; nt < 4; ++nt) { a1[nt] = a1[nt] - mean; q += (a1[nt][0] * a1[nt][0] + a1[nt][1] * a1[nt][1]) + (a1[nt][2] * a1[nt][2] + a1[nt][3] * a1[nt][3]); }
            q += __shfl_xor(q, 16); q += __shfl_xor(q, 32);
            const float rstd = 1.f / sqrtf(q * (1.f / 64.f) + LN_EPS);
#pragma unroll
            for (int nt = 0; nt < 4; ++nt) { const int e = 64 * h + 16 * nt + 4 * fq;
                const f32x4 gg = *(const f32x4*)(C.ret_gn_g + l * GWID + e), gb = *(const f32x4*)(C.ret_gn_b + l * GWID + e);
                const u32x2 gw = *(const u32x2*)(C.Z + (size_t)(row0 + i) * INW + ZC_RG + e); float gf[4]; unpack4(gw, gf);
                float o[4];
#pragma unroll
                for (int r = 0; r < 4; ++r) o[r] = silu_f(gf[r]) * (a1[nt][r] * rstd * gg[r] + gb[r]);
                u32x2 ow; ow.x = pk2(o[0], o[1]); ow.y = pk2(o[2], o[3]);
                *(u32x2*)(C.Y + (size_t)(row0 + i) * DM + 256 + e) = ow; }
        }
        __syncthreads();
    }
}

#define SCAN_STEP_F(OFF) { const float ap = dpp_f<0x110 + OFF>(1.0f, Av), bp = dpp_f<0x110 + OFF>(0.0f, Bv); Bv = Av * bp + Bv; Av = Av * ap; }
#define SCAN_STEP_B(OFF) { const float ap = dpp_f<0x100 + OFF>(1.0f, Av), bp = dpp_f<0x100 + OFF>(0.0f, Bv); Bv = Av * bp + Bv; Av = Av * ap; }
template <int MODE>
__device__ __forceinline__ void lru_pass(const Ctx& C, int l, int chunk, LAS unsigned char* lds) {
    int tid_ = threadIdx.x; asm volatile("" : "+v"(tid_)); const int tid = tid_, lane = tid & 63, w = tid >> 6, fr = lane & 15, fq = lane >> 4;
    LAS bf16* xa = (LAS bf16*)lds;
    LAS float* xf = (LAS float*)(lds + 18432);
    LAS float* SUM = (LAS float*)(lds + 18432 + 34816);
    const int b = chunk >> 6, n = chunk & 63, row0 = chunk * CHUNK;
#pragma unroll 1
    for (int h = 0; h < NHEAD; ++h) {
        {
            const int t = tid >> 2, sub = tid & 3, ch = 64 * h + 16 * sub;
            float acc[16];
#pragma unroll
            for (int ii = 0; ii < 16; ii += 4) { const f32x4 cb = *(const f32x4*)(C.lru_conv_b + l * GWID + ch + ii); acc[ii] = cb[0]; acc[ii + 1] = cb[1]; acc[ii + 2] = cb[2]; acc[ii + 3] = cb[3]; }
#pragma unroll
            for (int k = 0; k < 4; ++k) { const int s = n * CHUNK + t + k - 2;
                if (s >= 0 && s < SEQ) { const bf16* p = C.Z + (size_t)(b * SEQ + s) * INW + ZC_CX + ch;
                    const u32x4 x1 = *(const u32x4*)p, x2 = *(const u32x4*)(p + 8); float xv[16]; unpack8(x1, xv); unpack8(x2, xv + 8);
                    const float* wp = C.lru_conv_w + (size_t)(l * 4 + k) * GWID + ch;
#pragma unroll
                    for (int ii = 0; ii < 16; ii += 4) { const f32x4 wv = *(const f32x4*)(wp + ii); acc[ii] += wv[0] * xv[ii]; acc[ii + 1] += wv[1] * xv[ii + 1]; acc[ii + 2] += wv[2] * xv[ii + 2]; acc[ii + 3] += wv[3] * xv[ii + 3]; } } }
            *(LAS u32x4*)(xa + t * 72 + 16 * sub) = pack8(acc); *(LAS u32x4*)(xa + t * 72 + 16 * sub + 8) = pack8(acc + 8);
#pragma unroll
            for (int ii = 0; ii < 16; ii += 4) *(LAS f32x4*)(xf + t * 68 + 16 * sub + ii) = (f32x4){acc[ii], acc[ii + 1], acc[ii + 2], acc[ii + 3]};
        }
        __syncthreads();
        float Aa[2][4][4], Bb[2][4][4];
        {
            const int t = 16 * w + fr;
            bf16x8 af[2];
#pragma unroll
            for (int ks = 0; ks < 2; ++ks) af[ks] = *(const LAS bf16x8*)(xa + t * 72 + 32 * ks + 8 * fq);
            f32x4 acc[4][4];
#pragma unroll
            for (int pr = 0; pr < 4; ++pr)
#pragma unroll
                for (int nt = 0; nt < 4; ++nt) acc[pr][nt] = (f32x4){0.f, 0.f, 0.f, 0.f};
#pragma unroll
            for (int pr = 0; pr < 4; ++pr) { const int which = pr >> 1, z = pr & 1;
                const bf16* WT = C.LRUW + (((size_t)l * 2 + which) * 8 + z * 4 + h) * 4096;
#pragma unroll
                for (int nt = 0; nt < 4; ++nt)
#pragma unroll
                    for (int ks = 0; ks < 2; ++ks) { const bf16x8 wf = *(const bf16x8*)(WT + (16 * nt + fr) * 64 + 32 * ks + 8 * fq); acc[pr][nt] = MFMA16(wf, af[ks], acc[pr][nt]); } }
#pragma unroll
            for (int z = 0; z < 2; ++z)
#pragma unroll
                for (int nt = 0; nt < 4; ++nt) { const f32x4 xv = *(const LAS f32x4*)(xf + t * 68 + 16 * nt + 4 * fq);
                    const int j = 64 * h + 16 * nt + 4 * fq;
                    const f32x4 ba = *(const f32x4*)(C.lru_ba + (l * 2 + z) * GWID + j), bx = *(const f32x4*)(C.lru_bx + (l * 2 + z) * GWID + j), lam = *(const f32x4*)(C.lru_lambda + (l * 2 + z) * GWID + j);
#pragma unroll
                    for (int r = 0; r < 4; ++r) { const float rg = sigmoid_f(acc[z][nt][r] + ba[r]), ig = sigmoid_f(acc[2 + z][nt][r] + bx[r]);
                        const float sp = log1pf(expf(-lam[r]));
                        const float la = -8.0f * sp * rg;
                        Aa[z][nt][r] = __expf(la); Bb[z][nt][r] = xv[r] * ig * sqrtf(-expm1f(2.0f * la)); } }
#pragma unroll
            for (int nt = 0; nt < 4; ++nt)
#pragma unroll
                for (int r = 0; r < 4; ++r) {
                    { float Av = Aa[0][nt][r], Bv = Bb[0][nt][r]; SCAN_STEP_F(1) SCAN_STEP_F(2) SCAN_STEP_F(4) SCAN_STEP_F(8) Aa[0][nt][r] = Av; Bb[0][nt][r] = Bv; }
                    { float Av = Aa[1][nt][r], Bv = Bb[1][nt][r]; SCAN_STEP_B(1) SCAN_STEP_B(2) SCAN_STEP_B(4) SCAN_STEP_B(8) Aa[1][nt][r] = Av; Bb[1][nt][r] = Bv; }
                }
#pragma unroll
            for (int z = 0; z < 2; ++z)
                if (fr == (z ? 0 : 15)) {
#pragma unroll
                    for (int nt = 0; nt < 4; ++nt)
#pragma unroll
                        for (int r = 0; r < 4; ++r) { const int c = 16 * nt + 4 * fq + r; SUM[((w * 2 + z) * 64 + c) * 2] = Aa[z][nt][r]; SUM[((w * 2 + z) * 64 + c) * 2 + 1] = Bb[z][nt][r]; } }
        }
        __syncthreads();
        if (MODE == 0) {
            if (tid < 128) { const int z = tid >> 6, c = tid & 63; float Hh = 0.f, Ap = 1.f;
                for (int i = 0; i < 8; ++i) { const int ww = z ? 7 - i : i; const float a = SUM[((ww * 2 + z) * 64 + c) * 2], hh = SUM[((ww * 2 + z) * 64 + c) * 2 + 1]; Hh = a * Hh + hh; Ap *= a; }
                const size_t o = ((size_t)(b * NCH + n) * 2 + z) * GWID + 64 * h + c; C.CA[o] = Ap; C.CH[o] = Hh; }
        } else {
            const int t = 16 * w + fr;
#pragma unroll
            for (int nt = 0; nt < 4; ++nt) { const int cl = 16 * nt + 4 * fq;
                float hsum[4];
#pragma unroll
                for (int r = 0; r < 4; ++r) {
                    float c0 = C.CH[((size_t)(b * NCH + n) * 2 + 0) * GWID + 64 * h + cl + r];
                    for (int ww = 0; ww < w; ++ww) c0 = SUM[((ww * 2 + 0) * 64 + cl + r) * 2] * c0 + SUM[((ww * 2 + 0) * 64 + cl + r) * 2 + 1];
                    float c1 = C.CH[((size_t)(b * NCH + n) * 2 + 1) * GWID + 64 * h + cl + r];
                    for (int ww = 7; ww > w; --ww) c1 = SUM[((ww * 2 + 1) * 64 + cl + r) * 2] * c1 + SUM[((ww * 2 + 1) * 64 + cl + r) * 2 + 1];
                    hsum[r] = (Bb[0][nt][r] + Aa[0][nt][r] * c0) + (Bb[1][nt][r] + Aa[1][nt][r] * c1); }
                const u32x2 gw = *(const u32x2*)(C.Z + (size_t)(row0 + t) * INW + ZC_CG + 64 * h + cl); float gf[4]; unpack4(gw, gf);
                u32x2 ow; ow.x = pk2(hsum[0] * gelu_f(gf[0]), hsum[1] * gelu_f(gf[1])); ow.y = pk2(hsum[2] * gelu_f(gf[2]), hsum[3] * gelu_f(gf[3]));
                *(u32x2*)(C.Y + (size_t)(row0 + t) * DM + 512 + 64 * h + cl) = ow; }
        }
        __syncthreads();
    }
}

__device__ __forceinline__ void sc_chunk(const Ctx& C, int l, int chunk) {
    int tid_ = threadIdx.x; asm volatile("" : "+v"(tid_)); const int tid = tid_; const int b = chunk >> 6, n = chunk & 63, row0 = chunk * CHUNK;
#pragma unroll 1
    for (int u = tid; u < CHUNK * 32; u += 512) { const int t = u >> 5, c8 = (u & 31) * 8; const int s = n * CHUNK + t;
        float acc[8];
#pragma unroll
        for (int i = 0; i < 8; ++i) acc[i] = 0.f;
#pragma unroll
        for (int k = 0; k < 3; ++k) { const int ss = s + k - 1;
            if (ss >= 0 && ss < SEQ) { const bf16* zr = C.Z + (size_t)(b * SEQ + ss) * INW;
                const u32x4 cw = *(const u32x4*)(zr + ZC_DC + c8), hw = *(const u32x4*)(zr + ZC_DH + c8); float cf[8], hf[8]; unpack8(cw, cf); unpack8(hw, hf);
                const float* wp = C.sc_conv_w + (size_t)(l * 3 + k) * GWID + c8; const f32x4 w0 = *(const f32x4*)wp, w1 = *(const f32x4*)(wp + 4);
#pragma unroll
                for (int i = 0; i < 4; ++i) { acc[i] += w0[i] * (cf[i] * hf[i]); acc[4 + i] += w1[i] * (cf[4 + i] * hf[4 + i]); } } }
        const u32x4 bw = *(const u32x4*)(C.Z + (size_t)(row0 + t) * INW + ZC_DB + c8); float bf_[8]; unpack8(bw, bf_);
#pragma unroll
        for (int i = 0; i < 8; ++i) acc[i] *= bf_[i];
        *(u32x4*)(C.Y + (size_t)(row0 + t) * DM + 768 + c8) = pack8(acc); }
}

__device__ __forceinline__ void carry_phase(const Ctx& C) {
    int tid_ = threadIdx.x; asm volatile("" : "+v"(tid_)); const int gt = blockIdx.x * 512 + tid_, NT = gridDim.x * 512;
    for (int e = gt; e < 2 * (int)USTRIDE; e += NT) { const int dir = e >= (int)USTRIDE, idx = dir ? e - (int)USTRIDE : e; const int h = (idx >> 12) & 3;
        const float cd = __expf(log_gamma_h(h) * (float)CHUNK);
        float* base = (dir ? C.UB : C.UF) + idx; float st = 0.f;
#pragma unroll 1
        for (int n8 = 0; n8 < NCH; n8 += 8) { float u[8];
#pragma unroll
            for (int i = 0; i < 8; ++i) { const int n = dir ? NCH - 1 - (n8 + i) : n8 + i; u[i] = base[(size_t)n * USTRIDE]; }
#pragma unroll
            for (int i = 0; i < 8; ++i) { const int n = dir ? NCH - 1 - (n8 + i) : n8 + i; base[(size_t)n * USTRIDE] = st; st = cd * st + u[i]; } }
    }
    if (gt < BATCH * 512) { const int b = gt >> 9, zc = gt & 511, z = zc >> 8; float st = 0.f;
#pragma unroll 1
        for (int i = 0; i < NCH; ++i) { const int n = z ? NCH - 1 - i : i; const size_t o = (size_t)(b * NCH + n) * 512 + zc; const float a = C.CA[o], hh = C.CH[o]; C.CH[o] = st; st = a * st + hh; } }
}

#define GRID_SYNC() do { asm volatile("s_waitcnt vmcnt(0) lgkmcnt(0)" ::: "memory"); __builtin_amdgcn_fence(__ATOMIC_RELEASE, "agent"); asm volatile("s_waitcnt vmcnt(0)" ::: "memory"); grid.sync(); __builtin_amdgcn_fence(__ATOMIC_ACQUIRE, "agent"); asm volatile("s_waitcnt vmcnt(0)" ::: "memory"); } while (0)
typedef const __attribute__((address_space(4))) Args* KArgP;
__device__ __forceinline__ KArgP launder(KArgP p) { asm volatile("" : "+s"(p)); return p; }
__device__ __forceinline__ Ctx make_ctx(KArgP ap) {
    const __attribute__((address_space(4))) Args& args = *ap;
    Ctx C;
    C.x = (const float*)args.in[0]; C.pos = (const int*)args.in[1]; C.w_in = (const float*)args.in[2]; C.gmlp_ln_g = (const float*)args.in[3]; C.gmlp_ln_b = (const float*)args.in[4];
    C.gmlp_ws = (const float*)args.in[5]; C.gmlp_bs = (const float*)args.in[6]; C.ret_gn_g = (const float*)args.in[7]; C.ret_gn_b = (const float*)args.in[8];
    C.lru_conv_w = (const float*)args.in[9]; C.lru_conv_b = (const float*)args.in[10]; C.lru_wa = (const float*)args.in[11]; C.lru_ba = (const float*)args.in[12];
    C.lru_wx = (const float*)args.in[13]; C.lru_bx = (const float*)args.in[14]; C.lru_lambda = (const float*)args.in[15]; C.sc_conv_w = (const float*)args.in[16];
    C.w_out = (const float*)args.in[17]; C.ln1_g = (const float*)args.in[18]; C.ln1_b = (const float*)args.in[19]; C.ffn_wg = (const float*)args.in[20]; C.ffn_wu = (const float*)args.in[21];
    C.ffn_wd = (const float*)args.in[22]; C.ln2_g = (const float*)args.in[23]; C.ln2_b = (const float*)args.in[24];
    C.out = args.out; unsigned char* ws = args.ws;
    C.WIN = (bf16*)(ws + OFF_WIN); C.WOUT = (bf16*)(ws + OFF_WOUT); C.WGU = (bf16*)(ws + OFF_WGU); C.WD = (bf16*)(ws + OFF_WD); C.LRUW = (bf16*)(ws + OFF_LRUW);
    C.XB = (bf16*)(ws + OFF_XB); C.Z = (bf16*)(ws + OFF_Z); C.Y = (bf16*)(ws + OFF_Y); C.UF = (float*)(ws + OFF_UF); C.UB = (float*)(ws + OFF_UB); C.CA = (float*)(ws + OFF_CA); C.CH = (float*)(ws + OFF_CH);
    return C;
}
__global__ void __launch_bounds__(512) hybrid_fwd(Args args) {
    extern __shared__ __attribute__((aligned(16))) unsigned char lds_raw[];
    LAS unsigned char* lds = (LAS unsigned char*)lds_raw;
    cg::grid_group grid = cg::this_grid();
    (void)args; const KArgP ap0 = (KArgP)__builtin_amdgcn_kernarg_segment_ptr();
    const int G = gridDim.x;

    { const Ctx C = make_ctx(launder(ap0)); prologue(C, lds); }
    GRID_SYNC();
#pragma unroll 1
    for (int l = 0; l < DEPTH; ++l) {
        {
            const Ctx C = make_ctx(launder(ap0));
            pg8::Gemm g{C.XB, C.WIN + (size_t)l * INW * DM, M, INW, DM}; pg8::StaticOrder S; S.init(M, INW, G, (int)blockIdx.x);
            pg8::EpiBf16<0> E{C.Z, INW, nullptr, 0, 0, 1.f};
            pg8::gemm_phase<pg8::EpiBf16<0>, pg8::StaticOrder, true, true>(lds, g, S, E);
        }
        GRID_SYNC();
#pragma unroll 1
        for (int c = blockIdx.x; c < NCHUNK; c += G) {
            { const Ctx C = make_ctx(launder(ap0)); gmlp_chunk(C, l, c, lds); }
            { const Ctx C = make_ctx(launder(ap0)); ret_pass1(C, c, lds); }
            { const Ctx C = make_ctx(launder(ap0)); lru_pass<0>(C, l, c, lds); }
            { const Ctx C = make_ctx(launder(ap0)); sc_chunk(C, l, c); } }
        GRID_SYNC();
        { const Ctx C = make_ctx(launder(ap0)); carry_phase(C); }
        GRID_SYNC();
#pragma unroll 1
        for (int c = blockIdx.x; c < NCHUNK; c += G) {
            { const Ctx C = make_ctx(launder(ap0)); ret_pass2(C, l, c, lds); }
            { const Ctx C = make_ctx(launder(ap0)); lru_pass<1>(C, l, c, lds); } }
        GRID_SYNC();
        {
            const Ctx C = make_ctx(launder(ap0));
            pg8::Gemm g{C.Y, C.WOUT + (size_t)l * DM * DM, M, DM, DM}; pg8::StaticOrder S; S.init(M, DM, G, (int)blockIdx.x);
            EpiRes E{l == 0 ? C.x : C.out, C.out, DN_ALPHA};
            pg8::gemm_phase<EpiRes, pg8::StaticOrder, true, true>(lds, g, S, E);
        }
        GRID_SYNC();
        { const Ctx C = make_ctx(launder(ap0)); ln_phase(C.out, C.XB, C.ln1_g + l * DM, C.ln1_b + l * DM, true); }
        GRID_SYNC();
        {
            const Ctx C = make_ctx(launder(ap0));
            pg8::Gemm g{C.XB, C.WGU + (size_t)l * 2 * DFF * DM, M, 2 * DFF, DM}; pg8::StaticOrder S; S.init(M, 2 * DFF, G, (int)blockIdx.x);
            EpiSwiGLU E{C.Z};
            pg8::gemm_phase<EpiSwiGLU, pg8::StaticOrder, true, true>(lds, g, S, E);
        }
        GRID_SYNC();
        {
            const Ctx C = make_ctx(launder(ap0));
            pg8::Gemm g{C.Z, C.WD + (size_t)l * DM * DFF, M, DM, DFF}; pg8::StaticOrder S; S.init(M, DM, G, (int)blockIdx.x);
            EpiRes E{C.out, C.out, DN_ALPHA};
            pg8::gemm_phase<EpiRes, pg8::StaticOrder, true, true>(lds, g, S, E);
        }
        GRID_SYNC();
        { const Ctx C = make_ctx(launder(ap0)); ln_phase(C.out, C.XB, C.ln2_g + l * DM, C.ln2_b + l * DM, l + 1 < DEPTH); }
        if (l + 1 < DEPTH) GRID_SYNC();
    }
}

extern "C" void kernel_launch(void* const* d_in, const int* in_sizes, int n_in, void* d_out, int out_size, void* d_ws, size_t ws_size, hipStream_t stream) {
    static int grid = 0;
    if (grid == 0) {
        if (n_in != 25 || out_size != M * DM || ws_size < WS_END) { fprintf(stderr, "kernel_launch: unexpected shapes (n_in %d out %d ws %zu need %zu)\n", n_in, out_size, ws_size, (size_t)WS_END); grid = -1; return; }
        int dev = 0, cus = 0, per_cu = 0;
        (void)hipGetDevice(&dev); (void)hipDeviceGetAttribute(&cus, hipDeviceAttributeMultiprocessorCount, dev);
        if (hipFuncSetAttribute((const void*)hybrid_fwd, hipFuncAttributeMaxDynamicSharedMemorySize, LDS_BYTES) != hipSuccess) { fprintf(stderr, "kernel_launch: hipFuncSetAttribute failed\n"); grid = -1; return; }
        if (hipOccupancyMaxActiveBlocksPerMultiprocessor(&per_cu, (const void*)hybrid_fwd, 512, LDS_BYTES) != hipSuccess || per_cu < 1) { fprintf(stderr, "kernel_launch: occupancy query says %d\n", per_cu); per_cu = 1; }
        (void)hipGetLastError();
        grid = cus * per_cu; if (grid > 256) grid = 256; if (grid < 1) grid = 256;
    }
    if (grid < 0) return;
    Args a{};
    for (int i = 0; i < 25; ++i) a.in[i] = d_in[i];
    a.out = (float*)d_out; a.ws = (unsigned char*)d_ws;
    void* kargs[] = {&a};
    hipError_t e = hipLaunchCooperativeKernel((const void*)hybrid_fwd, dim3(grid), dim3(512), kargs, LDS_BYTES, stream);
    if (e != hipSuccess) fprintf(stderr, "cooperative launch failed: %s (grid %d)\n", hipGetErrorString(e), grid);
}
```

```cpp
#include <hip/hip_runtime.h>
#include <hip/hip_cooperative_groups.h>
#include <cstdio>
#include <cstdint>
namespace cg = cooperative_groups;
namespace pg8 {
#define PG8_LAS __attribute__((address_space(3)))
typedef unsigned short bf16_t;
typedef short bf16x8 __attribute__((ext_vector_type(8)));
typedef float f32x4 __attribute__((ext_vector_type(4)));
typedef unsigned u32x4 __attribute__((ext_vector_type(4)));
constexpr int BM = 256, BK = 64, HALF = 128, HTB = HALF * BK * 2  , STAGE_BYTES = 8 * HTB, NXCD = 8, WGM = 8;

__host__ __device__ __forceinline__ int lds_byte(int r, int c) { const int st = (r >> 4) * 2 + (c >> 5), rr = r & 15, cc = c & 31, ob = rr * 64 + cc * 2; return st * 1024 + (ob ^ (((ob >> 9) & 1) << 5)); }
__host__ __device__ __forceinline__ void stage_rc(int b, int& R, int& C) { const int st = b / 1024, sb = b % 1024, swz = sb ^ (((sb >> 9) & 1) << 5); R = (st >> 1) * 16 + swz / 64; C = (st & 1) * 32 + (swz % 64) / 2; }
__host__ __device__ __forceinline__ int perm32(int rho) { const int n = rho >> 4, i = rho & 15; return 8 * (i >> 2) + 4 * n + (i & 3); }

struct Unit { int pm, pn; };
struct Gemm { const bf16_t* A; const bf16_t* Bt; int M, N, K; };

struct StaticOrder {
    int nM, nN, nwg, G, c;
    __host__ __device__ void init(int M, int N, int G_, int c_) { nM = M / BM; nN = N / BM; nwg = nM * nN; G = G_; c = c_; }
    __host__ __device__ bool next(int i, Unit& u) const {
        const long L = (long)i * G + c; if (L >= nwg) return false;
        int wgid = (int)L; { const int q = nwg / NXCD, r = nwg % NXCD, xcd = wgid % NXCD, off = wgid / NXCD; wgid = (xcd < r ? xcd * (q + 1) : r * (q + 1) + (xcd - r) * q) + off; }
        const int nig = WGM * nN, gid = wgid / nig, fm = gid * WGM, gsz = (nM - fm) < WGM ? (nM - fm) : WGM;
        u.pm = fm + ((wgid % nig) % gsz); u.pn = (wgid % nig) / gsz; return true;
    }
    __device__ __forceinline__ void a_ready(const Unit&) const {}
    __device__ __forceinline__ void done(const Unit&) const {}
};

__device__ __forceinline__ unsigned cvt_pk_bf16(float lo, float hi) { unsigned r; asm volatile("v_cvt_pk_bf16_f32 %0, %1, %2" : "=v"(r) : "v"(lo), "v"(hi)); return r; }
typedef float f32x2 __attribute__((ext_vector_type(2)));
__device__ __forceinline__ f32x2 gelu_pk(f32x2 v) {
    const f32x2 av = __builtin_elementwise_abs(v), d = av * 0.2316418882f + 1.0f;
    f32x2 t; t.x = __builtin_amdgcn_rcpf(d.x); t.y = __builtin_amdgcn_rcpf(d.y);
    f32x2 q = t * 0.5307027145f + (-0.7265760135f); q = q * t + 0.7107068705f; q = q * t + (-0.142248368f); q = q * t + 0.127414796f; q = q * t;
    const f32x2 s = (v * v) * (-0.72134752044f);
    f32x2 e; e.x = __builtin_amdgcn_exp2f(s.x); e.y = __builtin_amdgcn_exp2f(s.y);
    const f32x2 m = v * (q * e), r = v - m;
    f32x2 o; o.x = v.x < 0.f ? m.x : r.x; o.y = v.y < 0.f ? m.y : r.y; return o;
}

template <int ACT  > struct EpiBf16 {
    static constexpr bool PERM = true, AFTER_DRAIN = false; static_assert(ACT == 0 || ACT == 1, "EpiBf16: ACT is 0 (none) or 1 (gelu_pk)");
    bf16_t* O; int ldc; const float* bias; int split_cols; size_t split_stride; float scale0;
    __device__ __forceinline__ void operator()(const f32x4 (&acc)[2][2][4][2], const Unit& u, int wr, int wc, int fr, int fq) const {
        const int row0 = u.pm * BM + wr * 64 + fr; int colt = u.pn * BM; bf16_t* base = O;
        float sc = 1.f; if (split_cols) { const int t = colt / split_cols; base += (size_t)t * split_stride; colt -= t * split_cols; if (t == 0) sc = scale0; }
        const int col0 = colt + wc * 32 + 8 * fq, bcol0 = u.pn * BM + wc * 32 + 8 * fq;
        f32x4 bv[2][2];
#pragma unroll
        for (int bj = 0; bj < 2; ++bj)
#pragma unroll
            for (int n = 0; n < 2; ++n) bv[bj][n] = bias ? *(const f32x4*)(bias + bcol0 + bj * HALF + 4 * n) : (f32x4){0.f, 0.f, 0.f, 0.f};
#pragma unroll
        for (int ai = 0; ai < 2; ++ai)
#pragma unroll
            for (int m = 0; m < 4; ++m) { bf16_t* rowp = base + (size_t)(row0 + ai * HALF + m * 16) * ldc + col0;
#pragma unroll
                for (int bj = 0; bj < 2; ++bj) { f32x4 v0 = acc[ai][bj][m][0] + bv[bj][0], v1 = acc[ai][bj][m][1] + bv[bj][1];
                    if (ACT == 1) { f32x2 a = gelu_pk((f32x2){v0[0], v0[1]}), b = gelu_pk((f32x2){v0[2], v0[3]}), c = gelu_pk((f32x2){v1[0], v1[1]}), d = gelu_pk((f32x2){v1[2], v1[3]});
                        v0 = (f32x4){a.x, a.y, b.x, b.y}; v1 = (f32x4){c.x, c.y, d.x, d.y}; }
                    v0 = v0 * sc; v1 = v1 * sc; u32x4 w; w.x = cvt_pk_bf16(v0[0], v0[1]); w.y = cvt_pk_bf16(v0[2], v0[3]); w.z = cvt_pk_bf16(v1[0], v1[1]); w.w = cvt_pk_bf16(v1[2], v1[3]);
                    *(u32x4*)(rowp + bj * HALF) = w; } }
    }
};
template <class Epi, class Sched, bool ALIGN_EPI = false, bool SP2 = false>
__device__ __forceinline__ void gemm_phase(PG8_LAS unsigned char* lds, const Gemm g, const Sched& S, const Epi& E) {
    int tid_ = threadIdx.x; asm volatile("" : "+v"(tid_)); const int tid = tid_, wid = __builtin_amdgcn_readfirstlane(tid >> 6), lane = tid & 63, wr = wid >> 2, wc = wid & 3, fr = lane & 15, fq = lane >> 4;
    const int K = g.K, nt = K / BK;
    unsigned voffA[2], voffB[2];
#pragma unroll
    for (int i = 0; i < 2; ++i) { int R, C; stage_rc(tid * 16 + i * 8192, R, C); const int Rb = Epi::PERM ? ((R & ~31) + perm32(R & 31)) : R;
        voffA[i] = (unsigned)(R * K + C) * 2u; voffB[i] = (unsigned)(Rb * K + C) * 2u; }
    const size_t kstep = (size_t)(BK * 2);
    const size_t hstep = (size_t)HALF * K * 2;
    const size_t tstep = 2 * hstep;
    const unsigned ldsw = (unsigned)wid * 1024u;
    const int aoff = lds_byte(wr * 64 + fr, fq * 8), boff = lds_byte(wc * 32 + fr, fq * 8);
#define PG8_SA(b, h) (((b) * 2 + (h)) * HTB)
#define PG8_SB(b, h) ((4 + (b) * 2 + (h)) * HTB)
#define PG8_STAGE(bufoff, gbase, voff) do { _Pragma("unroll") for (int _i = 0; _i < 2; ++_i) \
        __builtin_amdgcn_global_load_lds((const unsigned*)((const char*)(gbase) + (voff)[_i]), (PG8_LAS unsigned*)(lds + (bufoff) + ldsw + _i * 8192), 16, 0, 0); } while (0)
#define PG8_LDA(dst, b, h) do { _Pragma("unroll") for (int m = 0; m < 4; ++m) _Pragma("unroll") for (int k = 0; k < 2; ++k) dst[m][k] = *(const PG8_LAS bf16x8*)(lds + PG8_SA(b, h) + aoff + m * 2048 + k * 1024); } while (0)
#define PG8_LDB(dst, b, h) do { _Pragma("unroll") for (int n = 0; n < 2; ++n) _Pragma("unroll") for (int k = 0; k < 2; ++k) dst[n][k] = *(const PG8_LAS bf16x8*)(lds + PG8_SB(b, h) + boff + n * 2048 + k * 1024); } while (0)
#define PG8_MMA(ai, bj, At, Bt) do { __builtin_amdgcn_s_setprio(1); _Pragma("unroll") for (int m = 0; m < 4; ++m) _Pragma("unroll") for (int n = 0; n < 2; ++n) _Pragma("unroll") for (int k = 0; k < 2; ++k) \
        acc[ai][bj][m][n] = __builtin_amdgcn_mfma_f32_16x16x32_bf16(Bt[n][k], At[m][k], acc[ai][bj][m][n], 0, 0, 0); __builtin_amdgcn_s_setprio(0); } while (0)
#define PG8_WAIT_V(n) asm volatile("s_waitcnt vmcnt(" #n ")" ::: "memory")
#define PG8_WAIT_L(n) asm volatile("s_waitcnt lgkmcnt(" #n ")" ::: "memory")
#define PG8_BAR __builtin_amdgcn_s_barrier()
#define PG8_SCHED __builtin_amdgcn_sched_barrier(0)
    Unit cur, nxt; int ui = 0;
    if (!S.next(0, cur)) return;
    f32x4 acc[2][2][4][2];
#pragma unroll
    for (int a = 0; a < 2; ++a)
#pragma unroll
        for (int b = 0; b < 2; ++b)
#pragma unroll
            for (int m = 0; m < 4; ++m)
#pragma unroll
                for (int n = 0; n < 2; ++n) acc[a][b][m][n] = (f32x4){0.f, 0.f, 0.f, 0.f};
    bf16x8 At[4][2], B0[2][2], B1[2][2];
    const char* cA = (const char*)g.A + (size_t)cur.pm * tstep; const char* cB = (const char*)g.Bt + (size_t)cur.pn * tstep;
    S.a_ready(cur);
    if constexpr (SP2) {
        PG8_STAGE(PG8_SB(0, 0), cB, voffB); PG8_STAGE(PG8_SB(0, 1), cB + hstep, voffB); PG8_STAGE(PG8_SA(0, 0), cA, voffA); PG8_STAGE(PG8_SA(0, 1), cA + hstep, voffA);
        if (wr == 1) PG8_BAR;
        PG8_WAIT_V(2); PG8_BAR;
        PG8_STAGE(PG8_SB(1, 0), cB + kstep, voffB); PG8_STAGE(PG8_SA(1, 0), cA + kstep, voffA); PG8_STAGE(PG8_SB(1, 1), cB + hstep + kstep, voffB);
        PG8_WAIT_V(6); PG8_BAR;
    } else {
        PG8_STAGE(PG8_SB(0, 0), cB, voffB); PG8_STAGE(PG8_SA(0, 0), cA, voffA); PG8_STAGE(PG8_SB(0, 1), cB + hstep, voffB); PG8_STAGE(PG8_SA(0, 1), cA + hstep, voffA);
        if (wr == 1) PG8_BAR;
        PG8_WAIT_V(4); PG8_BAR;
        PG8_STAGE(PG8_SB(1, 0), cB + kstep, voffB); PG8_STAGE(PG8_SA(1, 0), cA + kstep, voffA); PG8_STAGE(PG8_SB(1, 1), cB + hstep + kstep, voffB);
        PG8_WAIT_V(6); PG8_BAR;
    }
    for (;;) {
        const bool has_next = S.next(ui + 1, nxt);
        const char* nA = has_next ? (const char*)g.A + (size_t)nxt.pm * tstep : cA; const char* nB = has_next ? (const char*)g.Bt + (size_t)nxt.pn * tstep : cB;
        for (int t = 0; t < nt; t += 2) {
            const bool last = (t == nt - 2);
            const char* a1 = cA + (size_t)(t + 1) * kstep;
            const char* a2 = last ? nA : cA + (size_t)(t + 2) * kstep; const char* b2 = last ? nB : cB + (size_t)(t + 2) * kstep;
            const char* a3 = a2 + kstep; const char* b3 = b2 + kstep;
            if (last && has_next) S.a_ready(nxt);
            if constexpr (SP2) {
            PG8_LDB(B0, 0, 0); PG8_LDB(B1, 0, 1); PG8_SCHED; PG8_LDA(At, 0, 0); PG8_STAGE(PG8_SA(1, 1), a1 + hstep, voffA);
            PG8_WAIT_V(8); PG8_WAIT_L(0); PG8_BAR; PG8_MMA(0, 0, At, B0); PG8_MMA(0, 1, At, B1); PG8_BAR; PG8_SCHED;
            PG8_LDA(At, 0, 1); PG8_STAGE(PG8_SB(0, 0), b2, voffB); PG8_STAGE(PG8_SB(0, 1), b2 + hstep, voffB); PG8_STAGE(PG8_SA(0, 0), a2, voffA);
            PG8_WAIT_V(8); PG8_WAIT_L(0); PG8_BAR; PG8_MMA(1, 0, At, B0); PG8_MMA(1, 1, At, B1); PG8_BAR; PG8_SCHED;
            PG8_LDB(B0, 1, 0); PG8_LDB(B1, 1, 1); PG8_SCHED; PG8_LDA(At, 1, 0); PG8_STAGE(PG8_SA(0, 1), a2 + hstep, voffA);
            PG8_WAIT_V(8); PG8_WAIT_L(0); PG8_BAR; PG8_MMA(0, 0, At, B0); PG8_MMA(0, 1, At, B1); PG8_BAR; PG8_SCHED;
            PG8_LDA(At, 1, 1); PG8_STAGE(PG8_SB(1, 0), b3, voffB); PG8_STAGE(PG8_SB(1, 1), b3 + hstep, voffB); PG8_STAGE(PG8_SA(1, 0), a3, voffA);
            PG8_WAIT_V(8); PG8_WAIT_L(0); PG8_BAR; PG8_MMA(1, 0, At, B0); PG8_MMA(1, 1, At, B1); PG8_BAR; PG8_SCHED;
            } else {
            PG8_LDB(B0, 0, 0); PG8_SCHED; PG8_LDA(At, 0, 0); PG8_STAGE(PG8_SA(1, 1), a1 + hstep, voffA);
            PG8_WAIT_L(8); PG8_BAR; PG8_WAIT_L(0); PG8_MMA(0, 0, At, B0); PG8_BAR; PG8_SCHED;
            PG8_LDB(B1, 0, 1); PG8_STAGE(PG8_SB(0, 0), b2, voffB);
            PG8_BAR; PG8_WAIT_L(0); PG8_MMA(0, 1, At, B1); PG8_BAR;
            PG8_LDA(At, 0, 1); PG8_STAGE(PG8_SA(0, 0), a2, voffA);
            PG8_BAR; PG8_WAIT_L(0); PG8_MMA(1, 0, At, B0); PG8_BAR; PG8_SCHED;
            PG8_STAGE(PG8_SB(0, 1), b2 + hstep, voffB);
            PG8_WAIT_V(6); PG8_BAR; PG8_MMA(1, 1, At, B1); PG8_BAR;
            PG8_LDB(B0, 1, 0); PG8_SCHED; PG8_LDA(At, 1, 0); PG8_STAGE(PG8_SA(0, 1), a2 + hstep, voffA);
            PG8_WAIT_L(8); PG8_BAR; PG8_WAIT_L(0); PG8_MMA(0, 0, At, B0); PG8_BAR; PG8_SCHED;
            PG8_LDB(B1, 1, 1); PG8_STAGE(PG8_SB(1, 0), b3, voffB);
            PG8_BAR; PG8_WAIT_L(0); PG8_MMA(0, 1, At, B1); PG8_BAR;
            PG8_LDA(At, 1, 1); PG8_STAGE(PG8_SA(1, 0), a3, voffA);
            PG8_BAR; PG8_WAIT_L(0); PG8_MMA(1, 0, At, B0); PG8_BAR; PG8_SCHED;
            PG8_STAGE(PG8_SB(1, 1), b3 + hstep, voffB);
            PG8_WAIT_V(6); PG8_BAR; PG8_MMA(1, 1, At, B1); PG8_BAR;
            }
        }
        if constexpr (ALIGN_EPI) { if (wr == 0) PG8_BAR; }
        if constexpr (!Epi::AFTER_DRAIN) { E(acc, cur, wr, wc, fr, fq); S.done(cur); }
        if (!has_next) break;
#pragma unroll
        for (int a = 0; a < 2; ++a)
#pragma unroll
            for (int b = 0; b < 2; ++b)
#pragma unroll
                for (int m = 0; m < 4; ++m)
#pragma unroll
                    for (int n = 0; n < 2; ++n) acc[a][b][m][n] = (f32x4){0.f, 0.f, 0.f, 0.f};
        cur = nxt; cA = nA; cB = nB; ++ui;
        if constexpr (ALIGN_EPI) { if (wr == 1) PG8_BAR; }
    }
    PG8_WAIT_V(0);
    if constexpr (!ALIGN_EPI) { if (wr == 0) PG8_BAR; }
    PG8_BAR;
    if constexpr (Epi::AFTER_DRAIN) { E.fused(acc, cur, wr, wc, fr, fq, lds, wid, lane); S.done(cur); }
#undef PG8_SA
#undef PG8_SB
#undef PG8_STAGE
#undef PG8_LDA
#undef PG8_LDB
#undef PG8_MMA
#undef PG8_WAIT_V
#undef PG8_WAIT_L
#undef PG8_BAR
#undef PG8_SCHED
}
}

constexpr int BATCH = 8, SEQ = 8192, DM = 1024, DEPTH = 4, GWID = 256, NHEAD = 4, HDIM = 64, INW = 2816, CHUNK = 128, DFF = 2816;
constexpr int M = BATCH * SEQ;
constexpr int NCH = SEQ / CHUNK;
constexpr int NCHUNK = M / CHUNK;
constexpr float LN_EPS = 1e-5f;
constexpr float DN_ALPHA = 1.6817928305074290f;
constexpr int ZC_AU = 0, ZC_AV = 256, ZC_RQ = 512, ZC_RK = 768, ZC_RV = 1024, ZC_RG = 1280, ZC_CX = 1536, ZC_CG = 1792, ZC_DB = 2048, ZC_DC = 2304, ZC_DH = 2560;

#define LAS __attribute__((address_space(3)))
typedef unsigned short bf16;
typedef short bf16x8 __attribute__((ext_vector_type(8)));
typedef float f32x4 __attribute__((ext_vector_type(4)));
typedef unsigned u32x4 __attribute__((ext_vector_type(4)));
typedef unsigned u32x2 __attribute__((ext_vector_type(2)));

constexpr size_t SZ_WIN = (size_t)INW * DM * 2, SZ_WOUT = (size_t)DM * DM * 2, SZ_WGU = (size_t)2 * DFF * DM * 2, SZ_WD = (size_t)DM * DFF * 2, SZ_LRUW = (size_t)16 * 4096 * 2;
constexpr size_t OFF_WIN = 0;
constexpr size_t OFF_WOUT = OFF_WIN + DEPTH * SZ_WIN;
constexpr size_t OFF_WGU = OFF_WOUT + DEPTH * SZ_WOUT;
constexpr size_t OFF_WD = OFF_WGU + DEPTH * SZ_WGU;
constexpr size_t OFF_LRUW = OFF_WD + DEPTH * SZ_WD;
constexpr size_t OFF_XB = OFF_LRUW + DEPTH * SZ_LRUW;
constexpr size_t OFF_Z = OFF_XB + (size_t)M * DM * 2;
constexpr size_t OFF_Y = OFF_Z + (size_t)M * INW * 2;
constexpr size_t OFF_UF = OFF_Y + (size_t)M * DM * 2;
constexpr size_t USTRIDE = (size_t)BATCH * NHEAD * 4096;
constexpr size_t OFF_UB = OFF_UF + (size_t)NCH * USTRIDE * 4;
constexpr size_t OFF_CA = OFF_UB + (size_t)NCH * USTRIDE * 4;
constexpr size_t OFF_CH = OFF_CA + (size_t)BATCH * NCH * 512 * 4;
constexpr size_t OFF_CTL = OFF_CH + (size_t)BATCH * NCH * 512 * 4;
constexpr size_t CTL_BYTES = 16384;
constexpr size_t WS_END = OFF_CTL + CTL_BYTES;
constexpr int LDS_MISC_OFF = 131072, LDS_BYTES = 131072 + 256;

__device__ __forceinline__ float bflo(unsigned w) { return __uint_as_float(w << 16); }
__device__ __forceinline__ float bfhi(unsigned w) { return __uint_as_float(w & 0xffff0000u); }
__device__ __forceinline__ void unpack8(const u32x4 w, float* f) { f[0] = bflo(w.x); f[1] = bfhi(w.x); f[2] = bflo(w.y); f[3] = bfhi(w.y); f[4] = bflo(w.z); f[5] = bfhi(w.z); f[6] = bflo(w.w); f[7] = bfhi(w.w); }
__device__ __forceinline__ void unpack4(const u32x2 w, float* f) { f[0] = bflo(w.x); f[1] = bfhi(w.x); f[2] = bflo(w.y); f[3] = bfhi(w.y); }
__device__ __forceinline__ unsigned pk2(float lo, float hi) { return pg8::cvt_pk_bf16(lo, hi); }
__device__ __forceinline__ bf16 f2bf(float x) { return (bf16)(pg8::cvt_pk_bf16(x, 0.f) & 0xffffu); }
__device__ __forceinline__ u32x4 pack8(const float* f) { u32x4 w; w.x = pk2(f[0], f[1]); w.y = pk2(f[2], f[3]); w.z = pk2(f[4], f[5]); w.w = pk2(f[6], f[7]); return w; }
__device__ __forceinline__ float sigmoid_f(float x) { return __builtin_amdgcn_rcpf(1.0f + __expf(-x)); }
__device__ __forceinline__ float silu_f(float x) { return x * sigmoid_f(x); }
__device__ __forceinline__ float gelu_f(float x) { return x * sigmoid_f(1.5957691216057308f * (x + 0.044715f * x * x * x)); }
__device__ __forceinline__ float log_gamma_h(int h) { return h == 0 ? -0.0317486983145803f : (h == 1 ? -0.015748356968139168f : (h == 2 ? -0.007843177461025893f : -0.003913899321136329f)); }
__device__ __forceinline__ void rope_cs(float pos, int i, float& c, float& s) {
    const float invf = exp2f(-(float)i * 0.4152410118609203f);
    const float ang = pos * invf;
    const float n = rintf(ang * 0.15915494309189535f);
    float r = fmaf(-n, 6.2831854820251465f, ang); r = fmaf(-n, -1.7484555e-7f, r);
    const float rv = r * 0.15915494309189535f;
    s = __builtin_amdgcn_sinf(rv); c = __builtin_amdgcn_cosf(rv);
}
#define MFMA16(a, b, c) __builtin_amdgcn_mfma_f32_16x16x32_bf16((a), (b), (c), 0, 0, 0)
template <int CTRL> __device__ __forceinline__ float dpp_f(float oldv, float src) { return __int_as_float(__builtin_amdgcn_update_dpp(__float_as_int(oldv), __float_as_int(src), CTRL, 0xf, 0xf, false)); }

struct EpiRes {
    static constexpr bool PERM = false, AFTER_DRAIN = false;
    const float* res; float* out; float alpha;
    __device__ __forceinline__ void operator()(const pg8::f32x4 (&acc)[2][2][4][2], const pg8::Unit& u, int wr, int wc, int fr, int fq) const {
        const int row0 = u.pm * 256 + wr * 64 + fr, col0 = u.pn * 256 + wc * 32 + 4 * fq;
#pragma unroll
        for (int ai = 0; ai < 2; ++ai)
#pragma unroll
            for (int m = 0; m < 4; ++m) { const size_t off = (size_t)(row0 + ai * 128 + m * 16) * DM + col0;
#pragma unroll
                for (int bj = 0; bj < 2; ++bj)
#pragma unroll
                    for (int n = 0; n < 2; ++n) { const f32x4 r = *(const f32x4*)(res + off + bj * 128 + n * 16); *(f32x4*)(out + off + bj * 128 + n * 16) = r * alpha + acc[ai][bj][m][n]; }
                asm volatile("" ::: "memory"); }
    }
};
struct EpiSwiGLU {
    static constexpr bool PERM = true, AFTER_DRAIN = false;
    bf16* O;
    __device__ __forceinline__ void operator()(const pg8::f32x4 (&acc)[2][2][4][2], const pg8::Unit& u, int wr, int wc, int fr, int fq) const {
        const int row0 = u.pm * 256 + wr * 64 + fr, col0 = u.pn * 128 + wc * 32 + 8 * fq;
#pragma unroll
        for (int ai = 0; ai < 2; ++ai)
#pragma unroll
            for (int m = 0; m < 4; ++m) { bf16* rowp = O + (size_t)(row0 + ai * 128 + m * 16) * DFF + col0;
                const f32x4 g0 = acc[ai][0][m][0], g1 = acc[ai][0][m][1], u0 = acc[ai][1][m][0], u1 = acc[ai][1][m][1];
                u32x4 w; w.x = pk2(silu_f(g0[0]) * u0[0], silu_f(g0[1]) * u0[1]); w.y = pk2(silu_f(g0[2]) * u0[2], silu_f(g0[3]) * u0[3]);
                w.z = pk2(silu_f(g1[0]) * u1[0], silu_f(g1[1]) * u1[1]); w.w = pk2(silu_f(g1[2]) * u1[2], silu_f(g1[3]) * u1[3]);
                *(u32x4*)rowp = w; }
    }
};

struct Args { const void* in[25]; float* out; unsigned char* ws; };
struct Ctx {
    const float* x; const int* pos; const float* w_in; const float* gmlp_ln_g; const float* gmlp_ln_b; const float* gmlp_ws; const float* gmlp_bs; const float* ret_gn_g; const float* ret_gn_b;
    const float* lru_conv_w; const float* lru_conv_b; const float* lru_wa; const float* lru_ba; const float* lru_wx; const float* lru_bx; const float* lru_lambda; const float* sc_conv_w;
    const float* w_out; const float* ln1_g; const float* ln1_b; const float* ffn_wg; const float* ffn_wu; const float* ffn_wd; const float* ln2_g; const float* ln2_b;
    float* out; bf16 *WIN, *WOUT, *WGU, *WD, *LRUW, *XB, *Z, *Y; float *UF, *UB, *CA, *CH;
};

__device__ __forceinline__ void tr_item(const float* W, int N, bf16* dst_rows, int ldt, int k0, int n0, LAS float* scr, int lane) {
#pragma unroll 8
    for (int i = 0; i < 32; ++i) { const int kk = 2 * i + (lane >> 5); scr[kk * 33 + (lane & 31)] = W[(size_t)(k0 + kk) * N + n0 + (lane & 31)]; }
    asm volatile("s_waitcnt lgkmcnt(0)" ::: "memory");
    const int c = lane & 7;
#pragma unroll
    for (int j = 0; j < 4; ++j) { const int n = (lane >> 3) + 8 * j; const LAS float* s = scr + (8 * c) * 33 + n;
        u32x4 o; o.x = pk2(s[0 * 33], s[1 * 33]); o.y = pk2(s[2 * 33], s[3 * 33]); o.z = pk2(s[4 * 33], s[5 * 33]); o.w = pk2(s[6 * 33], s[7 * 33]);
        *(u32x4*)(dst_rows + (size_t)n * ldt + k0 + 8 * c) = o; }
    asm volatile("s_waitcnt lgkmcnt(0)" ::: "memory");
}
__device__ __forceinline__ void prologue(const Ctx& C, LAS unsigned char* lds) {
    int tid_ = threadIdx.x; asm volatile("" : "+v"(tid_)); const int tid = tid_, lane = tid & 63, wave = tid >> 6;
    LAS float* scr = (LAS float*)(lds + wave * 16384);
    const int gw = blockIdx.x * 8 + wave, NGW = gridDim.x * 8;
    constexpr int I_IN = (DM / 64) * (INW / 32), I_OUT = (DM / 64) * (DM / 32), I_G = (DM / 64) * (DFF / 32), I_D = (DFF / 64) * (DM / 32), I_L = 8 * 2;
    constexpr int PER_LAYER = I_IN + I_OUT + 2 * I_G + I_D + 2 * I_L;
    for (int it = gw; it < DEPTH * PER_LAYER; it += NGW) {
        const int l = it / PER_LAYER; int r = it % PER_LAYER;
        if (r < I_IN) { const int nb = INW / 32, k0 = 64 * (r / nb), n0 = 32 * (r % nb); tr_item(C.w_in + (size_t)l * DM * INW, INW, C.WIN + (size_t)l * INW * DM + (size_t)n0 * DM, DM, k0, n0, scr, lane); continue; } r -= I_IN;
        if (r < I_OUT) { const int nb = DM / 32, k0 = 64 * (r / nb), n0 = 32 * (r % nb); tr_item(C.w_out + (size_t)l * DM * DM, DM, C.WOUT + (size_t)l * DM * DM + (size_t)n0 * DM, DM, k0, n0, scr, lane); continue; } r -= I_OUT;
        if (r < 2 * I_G) { const int up = r >= I_G; if (up) r -= I_G; const int nb = DFF / 32, k0 = 64 * (r / nb), n0 = 32 * (r % nb); const int drow = 256 * (n0 / 128) + (n0 % 128) + (up ? 128 : 0);
            tr_item((up ? C.ffn_wu : C.ffn_wg) + (size_t)l * DM * DFF, DFF, C.WGU + (size_t)l * 2 * DFF * DM + (size_t)drow * DM, DM, k0, n0, scr, lane); continue; } r -= 2 * I_G;
        if (r < I_D) { const int nb = DM / 32, k0 = 64 * (r / nb), n0 = 32 * (r % nb); tr_item(C.ffn_wd + (size_t)l * DFF * DM, DM, C.WD + (size_t)l * DM * DFF + (size_t)n0 * DFF, DFF, k0, n0, scr, lane); continue; } r -= I_D;
        { const int which = r >= I_L; if (which) r -= I_L; const int mat = r >> 1, n0 = 32 * (r & 1);
          tr_item((which ? C.lru_wx : C.lru_wa) + ((size_t)l * 8 + mat) * 4096, 64, C.LRUW + (((size_t)l * 2 + which) * 8 + mat) * 4096 + (size_t)n0 * 64, 64, 0, n0, scr, lane); }
    }
    const size_t gt = (size_t)blockIdx.x * 512 + tid, NT = (size_t)gridDim.x * 512;
    for (size_t i = gt; i < (size_t)M * DM / 8; i += NT) { const f32x4 a = *(const f32x4*)(C.x + i * 8), b = *(const f32x4*)(C.x + i * 8 + 4);
        u32x4 o; o.x = pk2(a[0], a[1]); o.y = pk2(a[2], a[3]); o.z = pk2(b[0], b[1]); o.w = pk2(b[2], b[3]); *(u32x4*)(C.XB + i * 8) = o; }
}

__device__ __forceinline__ float wave_sum(float v) {
#pragma unroll
    for (int o = 1; o < 64; o <<= 1) v += __shfl_xor(v, o);
    return v;
}
__device__ __forceinline__ void ln_phase(float* X, bf16* XB, const float* g, const float* b, bool write_bf) {
    int tid_ = threadIdx.x; asm volatile("" : "+v"(tid_)); const int lane = tid_ & 63, wave = tid_ >> 6;
    const int gw = blockIdx.x * 8 + wave, NGW = gridDim.x * 8;
    f32x4 gv[4], bv[4];
#pragma unroll
    for (int j = 0; j < 4; ++j) { gv[j] = *((const f32x4*)g + lane + 64 * j); bv[j] = *((const f32x4*)b + lane + 64 * j); }
    for (int m = gw; m < M; m += NGW) {
        f32x4* xr = (f32x4*)(X + (size_t)m * DM) + lane;
        f32x4 v[4]; float s = 0.f;
#pragma unroll
        for (int j = 0; j < 4; ++j) { v[j] = xr[64 * j]; s += (v[j][0] + v[j][1]) + (v[j][2] + v[j][3]); }
        const float mean = wave_sum(s) * (1.f / DM); float s2 = 0.f;
#pragma unroll
        for (int j = 0; j < 4; ++j) { v[j] = v[j] - mean; s2 += (v[j][0] * v[j][0] + v[j][1] * v[j][1]) + (v[j][2] * v[j][2] + v[j][3] * v[j][3]); }
        const float rstd = 1.f / sqrtf(wave_sum(s2) * (1.f / DM) + LN_EPS);
#pragma unroll
        for (int j = 0; j < 4; ++j) { const f32x4 o = v[j] * rstd * gv[j] + bv[j]; xr[64 * j] = o;
            if (write_bf) { u32x2 w; w.x = pk2(o[0], o[1]); w.y = pk2(o[2], o[3]); *((u32x2*)(XB + (size_t)m * DM) + lane + 64 * j) = w; } }
    }
}

__device__ __forceinline__ void gmlp_chunk(const Ctx& C, int l, int chunk, LAS unsigned char* lds) {
    int tid_ = threadIdx.x; asm volatile("" : "+v"(tid_)); const int tid = tid_, lane = tid & 63, w = tid >> 6, fr = lane & 15, fq = lane >> 4;
    LAS bf16* vnT = (LAS bf16*)lds;
    const int row0 = chunk * CHUNK;
    {
        const int t = tid >> 2, q4 = tid & 3;
        const bf16* src = C.Z + (size_t)(row0 + t) * INW + ZC_AV + 64 * q4;
        float v[64]; float s = 0.f;
#pragma unroll
        for (int i = 0; i < 8; ++i) { const u32x4 wv = *(const u32x4*)(src + 8 * i); float f[8]; unpack8(wv, f);
#pragma unroll
            for (int j = 0; j < 8; ++j) { v[8 * i + j] = gelu_f(f[j]); s += v[8 * i + j]; } }
        s += __shfl_xor(s, 1); s += __shfl_xor(s, 2);
        const float mean = s * (1.f / 256.f); float q = 0.f;
#pragma unroll
        for (int i = 0; i < 64; ++i) { v[i] -= mean; q += v[i] * v[i]; }
        q += __shfl_xor(q, 1); q += __shfl_xor(q, 2);
        const float rstd = 1.f / sqrtf(q * (1.f / 256.f) + LN_EPS);
        const float* g = C.gmlp_ln_g + l * GWID + 64 * q4; const float* bb = C.gmlp_ln_b + l * GWID + 64 * q4;
#pragma unroll
        for (int i = 0; i < 64; ++i) vnT[(64 * q4 + i) * 136 + t] = f2bf(v[i] * rstd * g[i] + bb[i]);
    }
    __syncthreads();
    {
        const int p = 16 * w + fr;
#pragma unroll 1
        for (int h = 0; h < NHEAD; ++h) {
            f32x4 acc[4];
#pragma unroll
            for (int nt = 0; nt < 4; ++nt) acc[nt] = (f32x4){0.f, 0.f, 0.f, 0.f};
            const float* wsrow = C.gmlp_ws + ((size_t)(l * NHEAD + h) * CHUNK + p) * CHUNK;
#pragma unroll
            for (int ks = 0; ks < 4; ++ks) {
                const f32x4 a0 = *(const f32x4*)(wsrow + 32 * ks + 8 * fq), a1 = *(const f32x4*)(wsrow + 32 * ks + 8 * fq + 4);
                u32x4 aw; aw.x = pk2(a0[0], a0[1]); aw.y = pk2(a0[2], a0[3]); aw.z = pk2(a1[0], a1[1]); aw.w = pk2(a1[2], a1[3]);
                const bf16x8 af = __builtin_bit_cast(bf16x8, aw);
#pragma unroll
                for (int nt = 0; nt < 4; ++nt) { const bf16x8 bfg = *(const LAS bf16x8*)(vnT + (64 * h + 16 * nt + fr) * 136 + 32 * ks + 8 * fq); acc[nt] = MFMA16(bfg, af, acc[nt]); }
            }
            const float bias = C.gmlp_bs[(l * NHEAD + h) * CHUNK + p];
#pragma unroll
            for (int nt = 0; nt < 4; ++nt) { const int c = 64 * h + 16 * nt + 4 * fq;
                const u32x2 uw = *(const u32x2*)(C.Z + (size_t)(row0 + p) * INW + ZC_AU + c); float uf[4]; unpack4(uw, uf);
                u32x2 o; o.x = pk2(gelu_f(uf[0]) * (acc[nt][0] + bias), gelu_f(uf[1]) * (acc[nt][1] + bias)); o.y = pk2(gelu_f(uf[2]) * (acc[nt][2] + bias), gelu_f(uf[3]) * (acc[nt][3] + bias));
                *(u32x2*)(C.Y + (size_t)(row0 + p) * DM + 0 + c) = o; }
        }
    }
    __syncthreads();
}

__device__ __forceinline__ void ret_pass1(const Ctx& C, int chunk, LAS unsigned char* lds) {
    int tid_ = threadIdx.x; asm volatile("" : "+v"(tid_)); const int tid = tid_, lane = tid & 63, w = tid >> 6, fr = lane & 15, fq = lane >> 4;
    LAS bf16* vT = (LAS bf16*)lds; LAS bf16* kfT = vT + 64 * 136; LAS bf16* kbT = kfT + 64 * 136;
    const int b = chunk >> 6, n = chunk & 63, row0 = chunk * CHUNK;
#pragma unroll 1
    for (int h = 0; h < NHEAD; ++h) {
        {
            const int j = tid >> 2, sub = tid & 3;
            const bf16* zrow = C.Z + (size_t)(row0 + j) * INW;
            const u32x4 k1w = *(const u32x4*)(zrow + ZC_RK + 64 * h + 8 * sub), k2w = *(const u32x4*)(zrow + ZC_RK + 64 * h + 32 + 8 * sub);
            const u32x4 v1w = *(const u32x4*)(zrow + ZC_RV + 64 * h + 16 * sub), v2w = *(const u32x4*)(zrow + ZC_RV + 64 * h + 16 * sub + 8);
            const float pos = (float)C.pos[row0 + j];
            const float lgm = log_gamma_h(h);
            const float decf = __expf(lgm * (float)(CHUNK - 1 - j)) * 0.125f, decb = __expf(lgm * (float)j) * 0.125f;
            float k1[8], k2[8]; unpack8(k1w, k1); unpack8(k2w, k2);
#pragma unroll
            for (int ii = 0; ii < 8; ++ii) { const int i = 8 * sub + ii; float c, s; rope_cs(pos, i, c, s);
                const float r1 = k1[ii] * c - k2[ii] * s, r2 = k2[ii] * c + k1[ii] * s;
                kfT[i * 136 + j] = f2bf(r1 * decf); kfT[(32 + i) * 136 + j] = f2bf(r2 * decf);
                kbT[i * 136 + j] = f2bf(r1 * decb); kbT[(32 + i) * 136 + j] = f2bf(r2 * decb); }
            const unsigned vw[8] = {v1w.x, v1w.y, v1w.z, v1w.w, v2w.x, v2w.y, v2w.z, v2w.w};
#pragma unroll
            for (int ii = 0; ii < 8; ++ii) { vT[(16 * sub + 2 * ii) * 136 + j] = (bf16)(vw[ii] & 0xffffu); vT[(16 * sub + 2 * ii + 1) * 136 + j] = (bf16)(vw[ii] >> 16); }
        }
        __syncthreads();
        {
            const int z = w >> 2, mt = w & 3; LAS bf16* kT = z ? kbT : kfT;
            f32x4 acc[4];
#pragma unroll
            for (int nt = 0; nt < 4; ++nt) acc[nt] = (f32x4){0.f, 0.f, 0.f, 0.f};
#pragma unroll
            for (int ks = 0; ks < 4; ++ks) { const bf16x8 af = *(const LAS bf16x8*)(vT + (16 * mt + fr) * 136 + 32 * ks + 8 * fq);
#pragma unroll
                for (int nt = 0; nt < 4; ++nt) { const bf16x8 bfg = *(const LAS bf16x8*)(kT + (16 * nt + fr) * 136 + 32 * ks + 8 * fq); acc[nt] = MFMA16(bfg, af, acc[nt]); } }
            float* U = (z ? C.UB : C.UF) + (size_t)n * USTRIDE + (size_t)(b * NHEAD + h) * 4096;
#pragma unroll
            for (int nt = 0; nt < 4; ++nt) *(f32x4*)(U + (16 * mt + fr) * 64 + 16 * nt + 4 * fq) = acc[nt];
        }
        __syncthreads();
    }
}

__device__ __forceinline__ void ret_pass2(const Ctx& C, int l, int chunk, LAS unsigned char* lds) {
    int tid_ = threadIdx.x; asm volatile("" : "+v"(tid_)); const int tid = tid_, lane = tid & 63, w = tid >> 6, fr = lane & 15, fq = lane >> 4;
    LAS bf16* kr = (LAS bf16*)lds; LAS bf16* qr = kr + 128 * 72; LAS bf16* BT = qr + 128 * 72; LAS bf16* Ss = BT + 64 * 264;
    const int b = chunk >> 6, n = chunk & 63, row0 = chunk * CHUNK;
#pragma unroll 1
    for (int h = 0; h < NHEAD; ++h) {
        const float lgm = log_gamma_h(h);
        {
            const int j = tid >> 2, sub = tid & 3;
            const bf16* zrow = C.Z + (size_t)(row0 + j) * INW;
            const u32x4 q1w = *(const u32x4*)(zrow + ZC_RQ + 64 * h + 8 * sub), q2w = *(const u32x4*)(zrow + ZC_RQ + 64 * h + 32 + 8 * sub);
            const u32x4 k1w = *(const u32x4*)(zrow + ZC_RK + 64 * h + 8 * sub), k2w = *(const u32x4*)(zrow + ZC_RK + 64 * h + 32 + 8 * sub);
            const u32x4 v1w = *(const u32x4*)(zrow + ZC_RV + 64 * h + 16 * sub), v2w = *(const u32x4*)(zrow + ZC_RV + 64 * h + 16 * sub + 8);
            const float pos = (float)C.pos[row0 + j];
            float q1[8], q2[8], k1[8], k2[8]; unpack8(q1w, q1); unpack8(q2w, q2); unpack8(k1w, k1); unpack8(k2w, k2);
            float oq1[8], oq2[8], ok1[8], ok2[8];
#pragma unroll
            for (int ii = 0; ii < 8; ++ii) { float c, s; rope_cs(pos, 8 * sub + ii, c, s);
                oq1[ii] = q1[ii] * c - q2[ii] * s; oq2[ii] = q2[ii] * c + q1[ii] * s;
                ok1[ii] = (k1[ii] * c - k2[ii] * s) * 0.125f; ok2[ii] = (k2[ii] * c + k1[ii] * s) * 0.125f; }
            *(LAS u32x4*)(qr + j * 72 + 8 * sub) = pack8(oq1); *(LAS u32x4*)(qr + j * 72 + 32 + 8 * sub) = pack8(oq2);
            *(LAS u32x4*)(kr + j * 72 + 8 * sub) = pack8(ok1); *(LAS u32x4*)(kr + j * 72 + 32 + 8 * sub) = pack8(ok2);
            const unsigned vw[8] = {v1w.x, v1w.y, v1w.z, v1w.w, v2w.x, v2w.y, v2w.z, v2w.w};
#pragma unroll
            for (int ii = 0; ii < 8; ++ii) { BT[(16 * sub + 2 * ii) * 264 + j] = (bf16)(vw[ii] & 0xffffu); BT[(16 * sub + 2 * ii + 1) * 264 + j] = (bf16)(vw[ii] >> 16); }
            const int e = tid >> 3, d0 = 8 * (tid & 7);
            const size_t uo = (size_t)n * USTRIDE + (size_t)(b * NHEAD + h) * 4096 + e * 64 + d0;
            { const f32x4 a = *(const f32x4*)(C.UF + uo), c4 = *(const f32x4*)(C.UF + uo + 4); u32x4 o; o.x = pk2(a[0], a[1]); o.y = pk2(a[2], a[3]); o.z = pk2(c4[0], c4[1]); o.w = pk2(c4[2], c4[3]); *(LAS u32x4*)(BT + e * 264 + 128 + d0) = o; }
            { const f32x4 a = *(const f32x4*)(C.UB + uo), c4 = *(const f32x4*)(C.UB + uo + 4); u32x4 o; o.x = pk2(a[0], a[1]); o.y = pk2(a[2], a[3]); o.z = pk2(c4[0], c4[1]); o.w = pk2(c4[2], c4[3]); *(LAS u32x4*)(BT + e * 264 + 192 + d0) = o; }
        }
        __syncthreads();
        {
            const int i = 16 * w + fr;
            bf16x8 qf[2];
#pragma unroll
            for (int ks = 0; ks < 2; ++ks) qf[ks] = *(const LAS bf16x8*)(qr + i * 72 + 32 * ks + 8 * fq);
            LAS bf16* Sw = Ss + w * 16 * 136;
#pragma unroll
            for (int nt = 0; nt < 8; ++nt) { f32x4 s = (f32x4){0.f, 0.f, 0.f, 0.f};
#pragma unroll
                for (int ks = 0; ks < 2; ++ks) { const bf16x8 kf = *(const LAS bf16x8*)(kr + (16 * nt + fr) * 72 + 32 * ks + 8 * fq); s = MFMA16(kf, qf[ks], s); }
                float sv[4];
#pragma unroll
                for (int r = 0; r < 4; ++r) { const int jj = 16 * nt + 4 * fq + r; sv[r] = s[r] * __expf(lgm * fabsf((float)(i - jj))); }
                u32x2 o; o.x = pk2(sv[0], sv[1]); o.y = pk2(sv[2], sv[3]);
                *(LAS u32x2*)(Sw + fr * 136 + 16 * nt + 4 * fq) = o; }
            asm volatile("s_waitcnt lgkmcnt(0)" ::: "memory");
            f32x4 a1[4], a2[4], a3[4];
#pragma unroll
            for (int nt = 0; nt < 4; ++nt) { a1[nt] = (f32x4){0.f, 0.f, 0.f, 0.f}; a2[nt] = a1[nt]; a3[nt] = a1[nt]; }
#pragma unroll
            for (int ks = 0; ks < 4; ++ks) { const bf16x8 sf = *(const LAS bf16x8*)(Sw + fr * 136 + 32 * ks + 8 * fq);
#pragma unroll
                for (int nt = 0; nt < 4; ++nt) { const bf16x8 bfr = *(const LAS bf16x8*)(BT + (16 * nt + fr) * 264 + 32 * ks + 8 * fq); a1[nt] = MFMA16(bfr, sf, a1[nt]); } }
#pragma unroll
            for (int ks = 0; ks < 2; ++ks)
#pragma unroll
                for (int nt = 0; nt < 4; ++nt) { const bf16x8 b2 = *(const LAS bf16x8*)(BT + (16 * nt + fr) * 264 + 128 + 32 * ks + 8 * fq); a2[nt] = MFMA16(b2, qf[ks], a2[nt]);
                    const bf16x8 b3 = *(const LAS bf16x8*)(BT + (16 * nt + fr) * 264 + 192 + 32 * ks + 8 * fq); a3[nt] = MFMA16(b3, qf[ks], a3[nt]); }
            const float sfw = __expf(lgm * (float)(i + 1)), sbw = __expf(lgm * (float)(CHUNK - i));
            float sum = 0.f;
#pragma unroll
            for (int nt = 0; nt < 4; ++nt) { a1[nt] = a1[nt] + a2[nt] * sfw + a3[nt] * sbw; sum += (a1[nt][0] + a1[nt][1]) + (a1[nt][2] + a1[nt][3]); }
            sum += __shfl_xor(sum, 16); sum += __shfl_xor(sum, 32);
            const float mean = sum * (1.f / 64.f); float q = 0.f;
#pragma unroll
            for (int nt = 0; nt < 4; ++nt) { a1[nt] = a1[nt] - mean; q += (a1[nt][0] * a1[nt][0] + a1[nt][1] * a1[nt][1]) + (a1[nt][2] * a1[nt][2] + a1[nt][3] * a1[nt][3]); }
            q += __shfl_xor(q, 16); q += __shfl_xor(q, 32);
            const float rstd = 1.f / sqrtf(q * (1.f / 64.f) + LN_EPS);
#pragma unroll
            for (int nt = 0; nt < 4; ++nt) { const int e = 64 * h + 16 * nt + 4 * fq;
                const f32x4 gg = *(const f32x4*)(C.ret_gn_g + l * GWID + e), gb = *(const f32x4*)(C.ret_gn_b + l * GWID + e);
                const u32x2 gw = *(const u32x2*)(C.Z + (size_t)(row0 + i) * INW + ZC_RG + e); float gf[4]; unpack4(gw, gf);
                float o[4];
#pragma unroll
                for (int r = 0; r < 4; ++r) o[r] = silu_f(gf[r]) * (a1[nt][r] * rstd * gg[r] + gb[r]);
                u32x2 ow; ow.x = pk2(o[0], o[1]); ow.y = pk2(o[2], o[3]);
                *(u32x2*)(C.Y + (size_t)(row0 + i) * DM + 256 + e) = ow; }
        }
        __syncthreads();
    }
}

#define SCAN_STEP_F(OFF) { const float ap = dpp_f<0x110 + OFF>(1.0f, Av), bp = dpp_f<0x110 + OFF>(0.0f, Bv); Bv = Av * bp + Bv; Av = Av * ap; }
#define SCAN_STEP_B(OFF) { const float ap = dpp_f<0x100 + OFF>(1.0f, Av), bp = dpp_f<0x100 + OFF>(0.0f, Bv); Bv = Av * bp + Bv; Av = Av * ap; }
template <int MODE>
__device__ __forceinline__ void lru_pass(const Ctx& C, int l, int chunk, LAS unsigned char* lds) {
    int tid_ = threadIdx.x; asm volatile("" : "+v"(tid_)); const int tid = tid_, lane = tid & 63, w = tid >> 6, fr = lane & 15, fq = lane >> 4;
    LAS bf16* xa = (LAS bf16*)lds;
    LAS float* xf = (LAS float*)(lds + 18432);
    LAS float* SUM = (LAS float*)(lds + 18432 + 34816);
    const int b = chunk >> 6, n = chunk & 63, row0 = chunk * CHUNK;
#pragma unroll 1
    for (int h = 0; h < NHEAD; ++h) {
        {
            const int t = tid >> 2, sub = tid & 3, ch = 64 * h + 16 * sub;
            float acc[16];
#pragma unroll
            for (int ii = 0; ii < 16; ii += 4) { const f32x4 cb = *(const f32x4*)(C.lru_conv_b + l * GWID + ch + ii); acc[ii] = cb[0]; acc[ii + 1] = cb[1]; acc[ii + 2] = cb[2]; acc[ii + 3] = cb[3]; }
#pragma unroll
            for (int k = 0; k < 4; ++k) { const int s = n * CHUNK + t + k - 2;
                if (s >= 0 && s < SEQ) { const bf16* p = C.Z + (size_t)(b * SEQ + s) * INW + ZC_CX + ch;
                    const u32x4 x1 = *(const u32x4*)p, x2 = *(const u32x4*)(p + 8); float xv[16]; unpack8(x1, xv); unpack8(x2, xv + 8);
                    const float* wp = C.lru_conv_w + (size_t)(l * 4 + k) * GWID + ch;
#pragma unroll
                    for (int ii = 0; ii < 16; ii += 4) { const f32x4 wv = *(const f32x4*)(wp + ii); acc[ii] += wv[0] * xv[ii]; acc[ii + 1] += wv[1] * xv[ii + 1]; acc[ii + 2] += wv[2] * xv[ii + 2]; acc[ii + 3] += wv[3] * xv[ii + 3]; } } }
            *(LAS u32x4*)(xa + t * 72 + 16 * sub) = pack8(acc); *(LAS u32x4*)(xa + t * 72 + 16 * sub + 8) = pack8(acc + 8);
#pragma unroll
            for (int ii = 0; ii < 16; ii += 4) *(LAS f32x4*)(xf + t * 68 + 16 * sub + ii) = (f32x4){acc[ii], acc[ii + 1], acc[ii + 2], acc[ii + 3]};
        }
        __syncthreads();
        float Aa[2][4][4], Bb[2][4][4];
        {
            const int t = 16 * w + fr;
            bf16x8 af[2];
#pragma unroll
            for (int ks = 0; ks < 2; ++ks) af[ks] = *(const LAS bf16x8*)(xa + t * 72 + 32 * ks + 8 * fq);
            f32x4 acc[4][4];
#pragma unroll
            for (int pr = 0; pr < 4; ++pr)
#pragma unroll
                for (int nt = 0; nt < 4; ++nt) acc[pr][nt] = (f32x4){0.f, 0.f, 0.f, 0.f};
#pragma unroll
            for (int pr = 0; pr < 4; ++pr) { const int which = pr >> 1, z = pr & 1;
                const bf16* WT = C.LRUW + (((size_t)l * 2 + which) * 8 + z * 4 + h) * 4096;
#pragma unroll
                for (int nt = 0; nt < 4; ++nt)
#pragma unroll
                    for (int ks = 0; ks < 2; ++ks) { const bf16x8 wf = *(const bf16x8*)(WT + (16 * nt + fr) * 64 + 32 * ks + 8 * fq); acc[pr][nt] = MFMA16(wf, af[ks], acc[pr][nt]); } }
#pragma unroll
            for (int z = 0; z < 2; ++z)
#pragma unroll
                for (int nt = 0; nt < 4; ++nt) { const f32x4 xv = *(const LAS f32x4*)(xf + t * 68 + 16 * nt + 4 * fq);
                    const int j = 64 * h + 16 * nt + 4 * fq;
                    const f32x4 ba = *(const f32x4*)(C.lru_ba + (l * 2 + z) * GWID + j), bx = *(const f32x4*)(C.lru_bx + (l * 2 + z) * GWID + j), lam = *(const f32x4*)(C.lru_lambda + (l * 2 + z) * GWID + j);
#pragma unroll
                    for (int r = 0; r < 4; ++r) { const float rg = sigmoid_f(acc[z][nt][r] + ba[r]), ig = sigmoid_f(acc[2 + z][nt][r] + bx[r]);
                        const float sp = log1pf(expf(-lam[r]));
                        const float la = -8.0f * sp * rg;
                        Aa[z][nt][r] = __expf(la); Bb[z][nt][r] = xv[r] * ig * sqrtf(-expm1f(2.0f * la)); } }
#pragma unroll
            for (int nt = 0; nt < 4; ++nt)
#pragma unroll
                for (int r = 0; r < 4; ++r) {
                    { float Av = Aa[0][nt][r], Bv = Bb[0][nt][r]; SCAN_STEP_F(1) SCAN_STEP_F(2) SCAN_STEP_F(4) SCAN_STEP_F(8) Aa[0][nt][r] = Av; Bb[0][nt][r] = Bv; }
                    { float Av = Aa[1][nt][r], Bv = Bb[1][nt][r]; SCAN_STEP_B(1) SCAN_STEP_B(2) SCAN_STEP_B(4) SCAN_STEP_B(8) Aa[1][nt][r] = Av; Bb[1][nt][r] = Bv; }
                }
#pragma unroll
            for (int z = 0; z < 2; ++z)
                if (fr == (z ? 0 : 15)) {
#pragma unroll
                    for (int nt = 0; nt < 4; ++nt)
#pragma unroll
                        for (int r = 0; r < 4; ++r) { const int c = 16 * nt + 4 * fq + r; SUM[((w * 2 + z) * 64 + c) * 2] = Aa[z][nt][r]; SUM[((w * 2 + z) * 64 + c) * 2 + 1] = Bb[z][nt][r]; } }
        }
        __syncthreads();
        if (MODE == 0) {
            if (tid < 128) { const int z = tid >> 6, c = tid & 63; float Hh = 0.f, Ap = 1.f;
                for (int i = 0; i < 8; ++i) { const int ww = z ? 7 - i : i; const float a = SUM[((ww * 2 + z) * 64 + c) * 2], hh = SUM[((ww * 2 + z) * 64 + c) * 2 + 1]; Hh = a * Hh + hh; Ap *= a; }
                const size_t o = ((size_t)(b * NCH + n) * 2 + z) * GWID + 64 * h + c; C.CA[o] = Ap; C.CH[o] = Hh; }
        } else {
            const int t = 16 * w + fr;
#pragma unroll
            for (int nt = 0; nt < 4; ++nt) { const int cl = 16 * nt + 4 * fq;
                float hsum[4];
#pragma unroll
                for (int r = 0; r < 4; ++r) {
                    float c0 = C.CH[((size_t)(b * NCH + n) * 2 + 0) * GWID + 64 * h + cl + r];
                    for (int ww = 0; ww < w; ++ww) c0 = SUM[((ww * 2 + 0) * 64 + cl + r) * 2] * c0 + SUM[((ww * 2 + 0) * 64 + cl + r) * 2 + 1];
                    float c1 = C.CH[((size_t)(b * NCH + n) * 2 + 1) * GWID + 64 * h + cl + r];
                    for (int ww = 7; ww > w; --ww) c1 = SUM[((ww * 2 + 1) * 64 + cl + r) * 2] * c1 + SUM[((ww * 2 + 1) * 64 + cl + r) * 2 + 1];
                    hsum[r] = (Bb[0][nt][r] + Aa[0][nt][r] * c0) + (Bb[1][nt][r] + Aa[1][nt][r] * c1); }
                const u32x2 gw = *(const u32x2*)(C.Z + (size_t)(row0 + t) * INW + ZC_CG + 64 * h + cl); float gf[4]; unpack4(gw, gf);
                u32x2 ow; ow.x = pk2(hsum[0] * gelu_f(gf[0]), hsum[1] * gelu_f(gf[1])); ow.y = pk2(hsum[2] * gelu_f(gf[2]), hsum[3] * gelu_f(gf[3]));
                *(u32x2*)(C.Y + (size_t)(row0 + t) * DM + 512 + 64 * h + cl) = ow; }
        }
        __syncthreads();
    }
}

__device__ __forceinline__ void sc_chunk(const Ctx& C, int l, int chunk) {
    int tid_ = threadIdx.x; asm volatile("" : "+v"(tid_)); const int tid = tid_; const int b = chunk >> 6, n = chunk & 63, row0 = chunk * CHUNK;
#pragma unroll 1
    for (int u = tid; u < CHUNK * 32; u += 512) { const int t = u >> 5, c8 = (u & 31) * 8; const int s = n * CHUNK + t;
        float acc[8];
#pragma unroll
        for (int i = 0; i < 8; ++i) acc[i] = 0.f;
#pragma unroll
        for (int k = 0; k < 3; ++k) { const int ss = s + k - 1;
            if (ss >= 0 && ss < SEQ) { const bf16* zr = C.Z + (size_t)(b * SEQ + ss) * INW;
                const u32x4 cw = *(const u32x4*)(zr + ZC_DC + c8), hw = *(const u32x4*)(zr + ZC_DH + c8); float cf[8], hf[8]; unpack8(cw, cf); unpack8(hw, hf);
                const float* wp = C.sc_conv_w + (size_t)(l * 3 + k) * GWID + c8; const f32x4 w0 = *(const f32x4*)wp, w1 = *(const f32x4*)(wp + 4);
#pragma unroll
                for (int i = 0; i < 4; ++i) { acc[i] += w0[i] * (cf[i] * hf[i]); acc[4 + i] += w1[i] * (cf[4 + i] * hf[4 + i]); } } }
        const u32x4 bw = *(const u32x4*)(C.Z + (size_t)(row0 + t) * INW + ZC_DB + c8); float bf_[8]; unpack8(bw, bf_);
#pragma unroll
        for (int i = 0; i < 8; ++i) acc[i] *= bf_[i];
        *(u32x4*)(C.Y + (size_t)(row0 + t) * DM + 768 + c8) = pack8(acc); }
}

__device__ __forceinline__ void carry_phase(const Ctx& C) {
    int tid_ = threadIdx.x; asm volatile("" : "+v"(tid_)); const int gt = blockIdx.x * 512 + tid_, NT = gridDim.x * 512;
    for (int e = gt; e < 2 * (int)USTRIDE; e += NT) { const int dir = e >= (int)USTRIDE, idx = dir ? e - (int)USTRIDE : e; const int h = (idx >> 12) & 3;
        const float cd = __expf(log_gamma_h(h) * (float)CHUNK);
        float* base = (dir ? C.UB : C.UF) + idx; float st = 0.f;
#pragma unroll 1
        for (int n8 = 0; n8 < NCH; n8 += 8) { float u[8];
#pragma unroll
            for (int i = 0; i < 8; ++i) { const int n = dir ? NCH - 1 - (n8 + i) : n8 + i; u[i] = base[(size_t)n * USTRIDE]; }
#pragma unroll
            for (int i = 0; i < 8; ++i) { const int n = dir ? NCH - 1 - (n8 + i) : n8 + i; base[(size_t)n * USTRIDE] = st; st = cd * st + u[i]; } }
    }
    if (gt < BATCH * 512) { const int b = gt >> 9, zc = gt & 511, z = zc >> 8; float st = 0.f;
#pragma unroll 1
        for (int i = 0; i < NCH; ++i) { const int n = z ? NCH - 1 - i : i; const size_t o = (size_t)(b * NCH + n) * 512 + zc; const float a = C.CA[o], hh = C.CH[o]; C.CH[o] = st; st = a * st + hh; } }
}

#define RLX_AGENT __ATOMIC_RELAXED, __HIP_MEMORY_SCOPE_AGENT
#define XB_TMO      128
#define XB_XCNT(j)  (256  + 64 * (j))
#define XB_XSUB(j)  (1280 + 64 * (j))
#define XB_XGEN(j)  (2304 + 64 * (j))
#define XB_TOP      3328
#define XB_TOPGEN   3392
#define XCD_BAR_WORDS 3456
#define XB_SPIN_CAP (1u << 18)

__device__ __forceinline__ unsigned xb_ld(unsigned* p)              { return __hip_atomic_load(p, __ATOMIC_RELAXED, __HIP_MEMORY_SCOPE_AGENT); }
__device__ __forceinline__ unsigned xb_add(unsigned* p, unsigned v) { return __hip_atomic_fetch_add(p, v, __ATOMIC_RELAXED, __HIP_MEMORY_SCOPE_AGENT); }
__device__ __forceinline__ unsigned xb_xcc_id() { return (unsigned)__builtin_amdgcn_s_getreg((3 << 11) | 20) & 0xFu; }
#define XB_SPIN(cond, bar) do { unsigned _sp = 0; while (cond) { __builtin_amdgcn_s_sleep(1); \
    if ((++_sp & 255u) == 0u) { if (xb_ld(&(bar)[XB_TMO])) break; if (_sp > XB_SPIN_CAP) { atomicAdd(&(bar)[XB_TMO], 1u); break; } } } } while (0)

struct XcdBarrier {
    unsigned* bar; unsigned x;
    volatile LAS unsigned* st;
};

__device__ __forceinline__ XcdBarrier xcd_barrier_post(unsigned* bar, volatile LAS unsigned* st) {
    XcdBarrier b; b.bar = bar; b.x = xb_xcc_id(); b.st = st;
    if (threadIdx.x == 0) (void)xb_add(&bar[XB_XCNT(b.x)], 1u);
    return b;
}
__device__ __forceinline__ void xcd_barrier_complete(unsigned* bar, unsigned x, unsigned& nloc, unsigned& nx) {
    const unsigned G = gridDim.x * gridDim.y * gridDim.z;
    unsigned sum, cnt, mine, sp = 0u;
    for (;;) {
        sum = 0u; cnt = 0u; mine = 0u;
#pragma unroll
        for (unsigned j = 0; j < 16; ++j) { const unsigned c = xb_ld(&bar[XB_XCNT(j)]); sum += c; cnt += (c > 0u) ? 1u : 0u; mine = (j == x) ? c : mine; }
        if (sum == G) break;
        __builtin_amdgcn_s_sleep(1);
        if ((++sp & 255u) == 0u) { if (xb_ld(&bar[XB_TMO])) break; if (sp > XB_SPIN_CAP) { atomicAdd(&bar[XB_TMO], 1u); break; } }
    }
    nloc = mine > 0u ? mine : 1u; nx = cnt > 0u ? cnt : 1u;
}

__device__ __forceinline__ void xcd_barrier(const XcdBarrier& b) {
    asm volatile("s_waitcnt vmcnt(0)" ::: "memory");
    __syncthreads();
    if (threadIdx.x == 0) {
        unsigned* bar = b.bar;
        __builtin_amdgcn_s_waitcnt(0);
        unsigned nloc = b.st[0], nx = b.st[1];
        if (nloc == 0u) { xcd_barrier_complete(bar, b.x, nloc, nx); b.st[0] = nloc; b.st[1] = nx; }
        const unsigned old = xb_add(&bar[XB_XSUB(b.x)], 1u);
        const unsigned gen = old / nloc;
        if (old + 1u == (gen + 1u) * nloc) {
            __builtin_amdgcn_fence(__ATOMIC_RELEASE, "agent");
            asm volatile("s_waitcnt vmcnt(0)" ::: "memory");
            const unsigned og = xb_add(&bar[XB_TOP], 1u);
            const unsigned tg = og / nx;
            if (og + 1u == (tg + 1u) * nx) xb_add(&bar[XB_TOPGEN], 1u);
            else XB_SPIN(xb_ld(&bar[XB_TOPGEN]) == tg, bar);
            __builtin_amdgcn_fence(__ATOMIC_ACQUIRE, "agent");
            xb_add(&bar[XB_XGEN(b.x)], 1u);
            asm volatile("s_waitcnt vmcnt(0)" ::: "memory");
        } else {
            XB_SPIN(xb_ld(&bar[XB_XGEN(b.x)]) == gen, bar);
            __builtin_amdgcn_fence(__ATOMIC_ACQUIRE, "agent");
            asm volatile("s_waitcnt vmcnt(0)" ::: "memory");
        }
    }
    __syncthreads();
}

#define GRID_SYNC() do { asm volatile("s_waitcnt vmcnt(0) lgkmcnt(0)" ::: "memory"); grid.sync(); __builtin_amdgcn_fence(__ATOMIC_ACQUIRE, "agent"); asm volatile("s_waitcnt vmcnt(0)" ::: "memory"); } while (0)
typedef const __attribute__((address_space(4))) Args* KArgP;
__device__ __forceinline__ KArgP launder(KArgP p) { asm volatile("" : "+s"(p)); return p; }
__device__ __forceinline__ Ctx make_ctx(KArgP ap) {
    const __attribute__((address_space(4))) Args& args = *ap;
    Ctx C;
    C.x = (const float*)args.in[0]; C.pos = (const int*)args.in[1]; C.w_in = (const float*)args.in[2]; C.gmlp_ln_g = (const float*)args.in[3]; C.gmlp_ln_b = (const float*)args.in[4];
    C.gmlp_ws = (const float*)args.in[5]; C.gmlp_bs = (const float*)args.in[6]; C.ret_gn_g = (const float*)args.in[7]; C.ret_gn_b = (const float*)args.in[8];
    C.lru_conv_w = (const float*)args.in[9]; C.lru_conv_b = (const float*)args.in[10]; C.lru_wa = (const float*)args.in[11]; C.lru_ba = (const float*)args.in[12];
    C.lru_wx = (const float*)args.in[13]; C.lru_bx = (const float*)args.in[14]; C.lru_lambda = (const float*)args.in[15]; C.sc_conv_w = (const float*)args.in[16];
    C.w_out = (const float*)args.in[17]; C.ln1_g = (const float*)args.in[18]; C.ln1_b = (const float*)args.in[19]; C.ffn_wg = (const float*)args.in[20]; C.ffn_wu = (const float*)args.in[21];
    C.ffn_wd = (const float*)args.in[22]; C.ln2_g = (const float*)args.in[23]; C.ln2_b = (const float*)args.in[24];
    C.out = args.out; unsigned char* ws = args.ws;
    C.WIN = (bf16*)(ws + OFF_WIN); C.WOUT = (bf16*)(ws + OFF_WOUT); C.WGU = (bf16*)(ws + OFF_WGU); C.WD = (bf16*)(ws + OFF_WD); C.LRUW = (bf16*)(ws + OFF_LRUW);
    C.XB = (bf16*)(ws + OFF_XB); C.Z = (bf16*)(ws + OFF_Z); C.Y = (bf16*)(ws + OFF_Y); C.UF = (float*)(ws + OFF_UF); C.UB = (float*)(ws + OFF_UB); C.CA = (float*)(ws + OFF_CA); C.CH = (float*)(ws + OFF_CH);
    return C;
}
__global__ void __launch_bounds__(512) hybrid_fwd(Args args) {
    extern __shared__ __attribute__((aligned(16))) unsigned char lds_raw[];
    LAS unsigned char* lds = (LAS unsigned char*)lds_raw;
    cg::grid_group grid = cg::this_grid();
    (void)args; const KArgP ap0 = (KArgP)__builtin_amdgcn_kernarg_segment_ptr();
    unsigned char* const args_ws_ptr = ap0->ws;
    const int G = gridDim.x;
    if (threadIdx.x < 64) ((LAS unsigned*)(lds + LDS_MISC_OFF))[threadIdx.x] = 0u;
    __syncthreads();
    const XcdBarrier bar = xcd_barrier_post((unsigned*)(args_ws_ptr + OFF_CTL), (volatile LAS unsigned*)(lds + LDS_MISC_OFF));

    { const Ctx C = make_ctx(launder(ap0)); prologue(C, lds); }
    GRID_SYNC();
#pragma unroll 1
    for (int l = 0; l < DEPTH; ++l) {
        {
            const Ctx C = make_ctx(launder(ap0));
            pg8::Gemm g{C.XB, C.WIN + (size_t)l * INW * DM, M, INW, DM}; pg8::StaticOrder S; S.init(M, INW, G, (int)blockIdx.x);
            pg8::EpiBf16<0> E{C.Z, INW, nullptr, 0, 0, 1.f};
            pg8::gemm_phase<pg8::EpiBf16<0>, pg8::StaticOrder, true, true>(lds, g, S, E);
        }
        xcd_barrier(bar);
#pragma unroll 1
        for (int c = blockIdx.x; c < NCHUNK; c += G) {
            { const Ctx C = make_ctx(launder(ap0)); gmlp_chunk(C, l, c, lds); }
            { const Ctx C = make_ctx(launder(ap0)); ret_pass1(C, c, lds); }
            { const Ctx C = make_ctx(launder(ap0)); lru_pass<0>(C, l, c, lds); }
            { const Ctx C = make_ctx(launder(ap0)); sc_chunk(C, l, c); } }
        xcd_barrier(bar);
        { const Ctx C = make_ctx(launder(ap0)); carry_phase(C); }
        xcd_barrier(bar);
#pragma unroll 1
        for (int c = blockIdx.x; c < NCHUNK; c += G) {
            { const Ctx C = make_ctx(launder(ap0)); ret_pass2(C, l, c, lds); }
            { const Ctx C = make_ctx(launder(ap0)); lru_pass<1>(C, l, c, lds); } }
        xcd_barrier(bar);
        {
            const Ctx C = make_ctx(launder(ap0));
            pg8::Gemm g{C.Y, C.WOUT + (size_t)l * DM * DM, M, DM, DM}; pg8::StaticOrder S; S.init(M, DM, G, (int)blockIdx.x);
            EpiRes E{l == 0 ? C.x : C.out, C.out, DN_ALPHA};
            pg8::gemm_phase<EpiRes, pg8::StaticOrder, true, true>(lds, g, S, E);
        }
        xcd_barrier(bar);
        { const Ctx C = make_ctx(launder(ap0)); ln_phase(C.out, C.XB, C.ln1_g + l * DM, C.ln1_b + l * DM, true); }
        xcd_barrier(bar);
        {
            const Ctx C = make_ctx(launder(ap0));
            pg8::Gemm g{C.XB, C.WGU + (size_t)l * 2 * DFF * DM, M, 2 * DFF, DM}; pg8::StaticOrder S; S.init(M, 2 * DFF, G, (int)blockIdx.x);
            EpiSwiGLU E{C.Z};
            pg8::gemm_phase<EpiSwiGLU, pg8::StaticOrder, true, true>(lds, g, S, E);
        }
        xcd_barrier(bar);
        {
            const Ctx C = make_ctx(launder(ap0));
            pg8::Gemm g{C.Z, C.WD + (size_t)l * DM * DFF, M, DM, DFF}; pg8::StaticOrder S; S.init(M, DM, G, (int)blockIdx.x);
            EpiRes E{C.out, C.out, DN_ALPHA};
            pg8::gemm_phase<EpiRes, pg8::StaticOrder, true, true>(lds, g, S, E);
        }
        xcd_barrier(bar);
        { const Ctx C = make_ctx(launder(ap0)); ln_phase(C.out, C.XB, C.ln2_g + l * DM, C.ln2_b + l * DM, l + 1 < DEPTH); }
        if (l + 1 < DEPTH) xcd_barrier(bar);
    }
}

extern "C" void kernel_launch(void* const* d_in, const int* in_sizes, int n_in, void* d_out, int out_size, void* d_ws, size_t ws_size, hipStream_t stream) {
    static int grid = 0;
    if (grid == 0) {
        if (n_in != 25 || out_size != M * DM || ws_size < WS_END) { fprintf(stderr, "kernel_launch: unexpected shapes (n_in %d out %d ws %zu need %zu)\n", n_in, out_size, ws_size, (size_t)WS_END); grid = -1; return; }
        int dev = 0, cus = 0, per_cu = 0;
        (void)hipGetDevice(&dev); (void)hipDeviceGetAttribute(&cus, hipDeviceAttributeMultiprocessorCount, dev);
        if (hipFuncSetAttribute((const void*)hybrid_fwd, hipFuncAttributeMaxDynamicSharedMemorySize, LDS_BYTES) != hipSuccess) { fprintf(stderr, "kernel_launch: hipFuncSetAttribute failed\n"); grid = -1; return; }
        if (hipOccupancyMaxActiveBlocksPerMultiprocessor(&per_cu, (const void*)hybrid_fwd, 512, LDS_BYTES) != hipSuccess || per_cu < 1) { fprintf(stderr, "kernel_launch: occupancy query says %d\n", per_cu); per_cu = 1; }
        (void)hipGetLastError();
        grid = cus * per_cu; if (grid > 256) grid = 256; if (grid < 1) grid = 256;
    }
    if (grid < 0) return;
    if (hipMemsetAsync((char*)d_ws + OFF_CTL, 0, CTL_BYTES, stream) != hipSuccess) { fprintf(stderr, "kernel_launch: memset failed\n"); return; }
    Args a{};
    for (int i = 0; i < 25; ++i) a.in[i] = d_in[i];
    a.out = (float*)d_out; a.ws = (unsigned char*)d_ws;
    void* kargs[] = {&a};
    hipError_t e = hipLaunchCooperativeKernel((const void*)hybrid_fwd, dim3(grid), dim3(512), kargs, LDS_BYTES, stream);
    if (e != hipSuccess) fprintf(stderr, "cooperative launch failed: %s (grid %d)\n", hipGetErrorString(e), grid);
}
```

```cpp
#include <hip/hip_runtime.h>
#include <hip/hip_cooperative_groups.h>
#include <cstdio>
#include <cstdint>
namespace cg = cooperative_groups;
namespace pg8 {
#define PG8_LAS __attribute__((address_space(3)))
typedef unsigned short bf16_t;
typedef short bf16x8 __attribute__((ext_vector_type(8)));
typedef float f32x4 __attribute__((ext_vector_type(4)));
typedef unsigned u32x4 __attribute__((ext_vector_type(4)));
constexpr int BM = 256, BK = 64, HALF = 128, HTB = HALF * BK * 2  , STAGE_BYTES = 8 * HTB, NXCD = 8, WGM = 8;

__host__ __device__ __forceinline__ int lds_byte(int r, int c) { const int st = (r >> 4) * 2 + (c >> 5), rr = r & 15, cc = c & 31, ob = rr * 64 + cc * 2; return st * 1024 + (ob ^ (((ob >> 9) & 1) << 5)); }
__host__ __device__ __forceinline__ void stage_rc(int b, int& R, int& C) { const int st = b / 1024, sb = b % 1024, swz = sb ^ (((sb >> 9) & 1) << 5); R = (st >> 1) * 16 + swz / 64; C = (st & 1) * 32 + (swz % 64) / 2; }
__host__ __device__ __forceinline__ int perm32(int rho) { const int n = rho >> 4, i = rho & 15; return 8 * (i >> 2) + 4 * n + (i & 3); }

struct Unit { int pm, pn; };
struct Gemm { const bf16_t* A; const bf16_t* Bt; int M, N, K; };

struct StaticOrder {
    int nM, nN, nwg, G, c;
    __host__ __device__ void init(int M, int N, int G_, int c_) { nM = M / BM; nN = N / BM; nwg = nM * nN; G = G_; c = c_; }
    __host__ __device__ bool next(int i, Unit& u) const {
        const long L = (long)i * G + c; if (L >= nwg) return false;
        int wgid = (int)L; { const int q = nwg / NXCD, r = nwg % NXCD, xcd = wgid % NXCD, off = wgid / NXCD; wgid = (xcd < r ? xcd * (q + 1) : r * (q + 1) + (xcd - r) * q) + off; }
        const int nig = WGM * nN, gid = wgid / nig, fm = gid * WGM, gsz = (nM - fm) < WGM ? (nM - fm) : WGM;
        u.pm = fm + ((wgid % nig) % gsz); u.pn = (wgid % nig) / gsz; return true;
    }
    __device__ __forceinline__ void a_ready(const Unit&) const {}
    __device__ __forceinline__ void done(const Unit&) const {}
};

__device__ __forceinline__ unsigned cvt_pk_bf16(float lo, float hi) { unsigned r; asm volatile("v_cvt_pk_bf16_f32 %0, %1, %2" : "=v"(r) : "v"(lo), "v"(hi)); return r; }
typedef float f32x2 __attribute__((ext_vector_type(2)));
__device__ __forceinline__ f32x2 gelu_pk(f32x2 v) {
    const f32x2 av = __builtin_elementwise_abs(v), d = av * 0.2316418882f + 1.0f;
    f32x2 t; t.x = __builtin_amdgcn_rcpf(d.x); t.y = __builtin_amdgcn_rcpf(d.y);
    f32x2 q = t * 0.5307027145f + (-0.7265760135f); q = q * t + 0.7107068705f; q = q * t + (-0.142248368f); q = q * t + 0.127414796f; q = q * t;
    const f32x2 s = (v * v) * (-0.72134752044f);
    f32x2 e; e.x = __builtin_amdgcn_exp2f(s.x); e.y = __builtin_amdgcn_exp2f(s.y);
    const f32x2 m = v * (q * e), r = v - m;
    f32x2 o; o.x = v.x < 0.f ? m.x : r.x; o.y = v.y < 0.f ? m.y : r.y; return o;
}

template <int ACT  > struct EpiBf16 {
    static constexpr bool PERM = true, AFTER_DRAIN = false; static_assert(ACT == 0 || ACT == 1, "EpiBf16: ACT is 0 (none) or 1 (gelu_pk)");
    bf16_t* O; int ldc; const float* bias; int split_cols; size_t split_stride; float scale0;
    __device__ __forceinline__ void operator()(const f32x4 (&acc)[2][2][4][2], const Unit& u, int wr, int wc, int fr, int fq) const {
        const int row0 = u.pm * BM + wr * 64 + fr; int colt = u.pn * BM; bf16_t* base = O;
        float sc = 1.f; if (split_cols) { const int t = colt / split_cols; base += (size_t)t * split_stride; colt -= t * split_cols; if (t == 0) sc = scale0; }
        const int col0 = colt + wc * 32 + 8 * fq, bcol0 = u.pn * BM + wc * 32 + 8 * fq;
        f32x4 bv[2][2];
#pragma unroll
        for (int bj = 0; bj < 2; ++bj)
#pragma unroll
            for (int n = 0; n < 2; ++n) bv[bj][n] = bias ? *(const f32x4*)(bias + bcol0 + bj * HALF + 4 * n) : (f32x4){0.f, 0.f, 0.f, 0.f};
#pragma unroll
        for (int ai = 0; ai < 2; ++ai)
#pragma unroll
            for (int m = 0; m < 4; ++m) { bf16_t* rowp = base + (size_t)(row0 + ai * HALF + m * 16) * ldc + col0;
#pragma unroll
                for (int bj = 0; bj < 2; ++bj) { f32x4 v0 = acc[ai][bj][m][0] + bv[bj][0], v1 = acc[ai][bj][m][1] + bv[bj][1];
                    if (ACT == 1) { f32x2 a = gelu_pk((f32x2){v0[0], v0[1]}), b = gelu_pk((f32x2){v0[2], v0[3]}), c = gelu_pk((f32x2){v1[0], v1[1]}), d = gelu_pk((f32x2){v1[2], v1[3]});
                        v0 = (f32x4){a.x, a.y, b.x, b.y}; v1 = (f32x4){c.x, c.y, d.x, d.y}; }
                    v0 = v0 * sc; v1 = v1 * sc; u32x4 w; w.x = cvt_pk_bf16(v0[0], v0[1]); w.y = cvt_pk_bf16(v0[2], v0[3]); w.z = cvt_pk_bf16(v1[0], v1[1]); w.w = cvt_pk_bf16(v1[2], v1[3]);
                    *(u32x4*)(rowp + bj * HALF) = w; } }
    }
};
template <class Epi, class Sched, bool ALIGN_EPI = false, bool SP2 = false>
__device__ __forceinline__ void gemm_phase(PG8_LAS unsigned char* lds, const Gemm g, const Sched& S, const Epi& E) {
    int tid_ = threadIdx.x; asm volatile("" : "+v"(tid_)); const int tid = tid_, wid = __builtin_amdgcn_readfirstlane(tid >> 6), lane = tid & 63, wr = wid >> 2, wc = wid & 3, fr = lane & 15, fq = lane >> 4;
    const int K = g.K, nt = K / BK;
    unsigned voffA[2], voffB[2];
#pragma unroll
    for (int i = 0; i < 2; ++i) { int R, C; stage_rc(tid * 16 + i * 8192, R, C); const int Rb = Epi::PERM ? ((R & ~31) + perm32(R & 31)) : R;
        voffA[i] = (unsigned)(R * K + C) * 2u; voffB[i] = (unsigned)(Rb * K + C) * 2u; }
    const size_t kstep = (size_t)(BK * 2);
    const size_t hstep = (size_t)HALF * K * 2;
    const size_t tstep = 2 * hstep;
    const unsigned ldsw = (unsigned)wid * 1024u;
    const int aoff = lds_byte(wr * 64 + fr, fq * 8), boff = lds_byte(wc * 32 + fr, fq * 8);
#define PG8_SA(b, h) (((b) * 2 + (h)) * HTB)
#define PG8_SB(b, h) ((4 + (b) * 2 + (h)) * HTB)
#define PG8_STAGE(bufoff, gbase, voff) do { _Pragma("unroll") for (int _i = 0; _i < 2; ++_i) \
        __builtin_amdgcn_global_load_lds((const unsigned*)((const char*)(gbase) + (voff)[_i]), (PG8_LAS unsigned*)(lds + (bufoff) + ldsw + _i * 8192), 16, 0, 0); } while (0)
#define PG8_LDA(dst, b, h) do { _Pragma("unroll") for (int m = 0; m < 4; ++m) _Pragma("unroll") for (int k = 0; k < 2; ++k) dst[m][k] = *(const PG8_LAS bf16x8*)(lds + PG8_SA(b, h) + aoff + m * 2048 + k * 1024); } while (0)
#define PG8_LDB(dst, b, h) do { _Pragma("unroll") for (int n = 0; n < 2; ++n) _Pragma("unroll") for (int k = 0; k < 2; ++k) dst[n][k] = *(const PG8_LAS bf16x8*)(lds + PG8_SB(b, h) + boff + n * 2048 + k * 1024); } while (0)
#define PG8_MMA(ai, bj, At, Bt) do { __builtin_amdgcn_s_setprio(1); _Pragma("unroll") for (int m = 0; m < 4; ++m) _Pragma("unroll") for (int n = 0; n < 2; ++n) _Pragma("unroll") for (int k = 0; k < 2; ++k) \
        acc[ai][bj][m][n] = __builtin_amdgcn_mfma_f32_16x16x32_bf16(Bt[n][k], At[m][k], acc[ai][bj][m][n], 0, 0, 0); __builtin_amdgcn_s_setprio(0); } while (0)
#define PG8_WAIT_V(n) asm volatile("s_waitcnt vmcnt(" #n ")" ::: "memory")
#define PG8_WAIT_L(n) asm volatile("s_waitcnt lgkmcnt(" #n ")" ::: "memory")
#define PG8_BAR __builtin_amdgcn_s_barrier()
#define PG8_SCHED __builtin_amdgcn_sched_barrier(0)
    Unit cur, nxt; int ui = 0;
    if (!S.next(0, cur)) return;
    f32x4 acc[2][2][4][2];
#pragma unroll
    for (int a = 0; a < 2; ++a)
#pragma unroll
        for (int b = 0; b < 2; ++b)
#pragma unroll
            for (int m = 0; m < 4; ++m)
#pragma unroll
                for (int n = 0; n < 2; ++n) acc[a][b][m][n] = (f32x4){0.f, 0.f, 0.f, 0.f};
    bf16x8 At[4][2], B0[2][2], B1[2][2];
    const char* cA = (const char*)g.A + (size_t)cur.pm * tstep; const char* cB = (const char*)g.Bt + (size_t)cur.pn * tstep;
    S.a_ready(cur);
    if constexpr (SP2) {
        PG8_STAGE(PG8_SB(0, 0), cB, voffB); PG8_STAGE(PG8_SB(0, 1), cB + hstep, voffB); PG8_STAGE(PG8_SA(0, 0), cA, voffA); PG8_STAGE(PG8_SA(0, 1), cA + hstep, voffA);
        if (wr == 1) PG8_BAR;
        PG8_WAIT_V(2); PG8_BAR;
        PG8_STAGE(PG8_SB(1, 0), cB + kstep, voffB); PG8_STAGE(PG8_SA(1, 0), cA + kstep, voffA); PG8_STAGE(PG8_SB(1, 1), cB + hstep + kstep, voffB);
        PG8_WAIT_V(6); PG8_BAR;
    } else {
        PG8_STAGE(PG8_SB(0, 0), cB, voffB); PG8_STAGE(PG8_SA(0, 0), cA, voffA); PG8_STAGE(PG8_SB(0, 1), cB + hstep, voffB); PG8_STAGE(PG8_SA(0, 1), cA + hstep, voffA);
        if (wr == 1) PG8_BAR;
        PG8_WAIT_V(4); PG8_BAR;
        PG8_STAGE(PG8_SB(1, 0), cB + kstep, voffB); PG8_STAGE(PG8_SA(1, 0), cA + kstep, voffA); PG8_STAGE(PG8_SB(1, 1), cB + hstep + kstep, voffB);
        PG8_WAIT_V(6); PG8_BAR;
    }
    for (;;) {
        const bool has_next = S.next(ui + 1, nxt);
        const char* nA = has_next ? (const char*)g.A + (size_t)nxt.pm * tstep : cA; const char* nB = has_next ? (const char*)g.Bt + (size_t)nxt.pn * tstep : cB;
        for (int t = 0; t < nt; t += 2) {
            const bool last = (t == nt - 2);
            const char* a1 = cA + (size_t)(t + 1) * kstep;
            const char* a2 = last ? nA : cA + (size_t)(t + 2) * kstep; const char* b2 = last ? nB : cB + (size_t)(t + 2) * kstep;
            const char* a3 = a2 + kstep; const char* b3 = b2 + kstep;
            if (last && has_next) S.a_ready(nxt);
            if constexpr (SP2) {
            PG8_LDB(B0, 0, 0); PG8_LDB(B1, 0, 1); PG8_SCHED; PG8_LDA(At, 0, 0); PG8_STAGE(PG8_SA(1, 1), a1 + hstep, voffA);
            PG8_WAIT_V(8); PG8_WAIT_L(0); PG8_BAR; PG8_MMA(0, 0, At, B0); PG8_MMA(0, 1, At, B1); PG8_BAR; PG8_SCHED;
            PG8_LDA(At, 0, 1); PG8_STAGE(PG8_SB(0, 0), b2, voffB); PG8_STAGE(PG8_SB(0, 1), b2 + hstep, voffB); PG8_STAGE(PG8_SA(0, 0), a2, voffA);
            PG8_WAIT_V(8); PG8_WAIT_L(0); PG8_BAR; PG8_MMA(1, 0, At, B0); PG8_MMA(1, 1, At, B1); PG8_BAR; PG8_SCHED;
            PG8_LDB(B0, 1, 0); PG8_LDB(B1, 1, 1); PG8_SCHED; PG8_LDA(At, 1, 0); PG8_STAGE(PG8_SA(0, 1), a2 + hstep, voffA);
            PG8_WAIT_V(8); PG8_WAIT_L(0); PG8_BAR; PG8_MMA(0, 0, At, B0); PG8_MMA(0, 1, At, B1); PG8_BAR; PG8_SCHED;
            PG8_LDA(At, 1, 1); PG8_STAGE(PG8_SB(1, 0), b3, voffB); PG8_STAGE(PG8_SB(1, 1), b3 + hstep, voffB); PG8_STAGE(PG8_SA(1, 0), a3, voffA);
            PG8_WAIT_V(8); PG8_WAIT_L(0); PG8_BAR; PG8_MMA(1, 0, At, B0); PG8_MMA(1, 1, At, B1); PG8_BAR; PG8_SCHED;
            } else {
            PG8_LDB(B0, 0, 0); PG8_SCHED; PG8_LDA(At, 0, 0); PG8_STAGE(PG8_SA(1, 1), a1 + hstep, voffA);
            PG8_WAIT_L(8); PG8_BAR; PG8_WAIT_L(0); PG8_MMA(0, 0, At, B0); PG8_BAR; PG8_SCHED;
            PG8_LDB(B1, 0, 1); PG8_STAGE(PG8_SB(0, 0), b2, voffB);
            PG8_BAR; PG8_WAIT_L(0); PG8_MMA(0, 1, At, B1); PG8_BAR;
            PG8_LDA(At, 0, 1); PG8_STAGE(PG8_SA(0, 0), a2, voffA);
            PG8_BAR; PG8_WAIT_L(0); PG8_MMA(1, 0, At, B0); PG8_BAR; PG8_SCHED;
            PG8_STAGE(PG8_SB(0, 1), b2 + hstep, voffB);
            PG8_WAIT_V(6); PG8_BAR; PG8_MMA(1, 1, At, B1); PG8_BAR;
            PG8_LDB(B0, 1, 0); PG8_SCHED; PG8_LDA(At, 1, 0); PG8_STAGE(PG8_SA(0, 1), a2 + hstep, voffA);
            PG8_WAIT_L(8); PG8_BAR; PG8_WAIT_L(0); PG8_MMA(0, 0, At, B0); PG8_BAR; PG8_SCHED;
            PG8_LDB(B1, 1, 1); PG8_STAGE(PG8_SB(1, 0), b3, voffB);
            PG8_BAR; PG8_WAIT_L(0); PG8_MMA(0, 1, At, B1); PG8_BAR;
            PG8_LDA(At, 1, 1); PG8_STAGE(PG8_SA(1, 0), a3, voffA);
            PG8_BAR; PG8_WAIT_L(0); PG8_MMA(1, 0, At, B0); PG8_BAR; PG8_SCHED;
            PG8_STAGE(PG8_SB(1, 1), b3 + hstep, voffB);
            PG8_WAIT_V(6); PG8_BAR; PG8_MMA(1, 1, At, B1); PG8_BAR;
            }
        }
        if constexpr (ALIGN_EPI) { if (wr == 0) PG8_BAR; }
        if constexpr (!Epi::AFTER_DRAIN) { E(acc, cur, wr, wc, fr, fq); S.done(cur); }
        if (!has_next) break;
#pragma unroll
        for (int a = 0; a < 2; ++a)
#pragma unroll
            for (int b = 0; b < 2; ++b)
#pragma unroll
                for (int m = 0; m < 4; ++m)
#pragma unroll
                    for (int n = 0; n < 2; ++n) acc[a][b][m][n] = (f32x4){0.f, 0.f, 0.f, 0.f};
        cur = nxt; cA = nA; cB = nB; ++ui;
        if constexpr (ALIGN_EPI) { if (wr == 1) PG8_BAR; }
    }
    PG8_WAIT_V(0);
    if constexpr (!ALIGN_EPI) { if (wr == 0) PG8_BAR; }
    PG8_BAR;
    if constexpr (Epi::AFTER_DRAIN) { E.fused(acc, cur, wr, wc, fr, fq, lds, wid, lane); S.done(cur); }
#undef PG8_SA
#undef PG8_SB
#undef PG8_STAGE
#undef PG8_LDA
#undef PG8_LDB
#undef PG8_MMA
#undef PG8_WAIT_V
#undef PG8_WAIT_L
#undef PG8_BAR
#undef PG8_SCHED
}
}

constexpr int BATCH = 8, SEQ = 8192, DM = 1024, DEPTH = 4, GWID = 256, NHEAD = 4, HDIM = 64, INW = 2816, CHUNK = 128, DFF = 2816;
constexpr int M = BATCH * SEQ;
constexpr int NCH = SEQ / CHUNK;
constexpr int NCHUNK = M / CHUNK;
constexpr float LN_EPS = 1e-5f;
constexpr float DN_ALPHA = 1.6817928305074290f;
constexpr int ZC_AU = 0, ZC_AV = 256, ZC_RQ = 512, ZC_RK = 768, ZC_RV = 1024, ZC_RG = 1280, ZC_CX = 1536, ZC_CG = 1792, ZC_DB = 2048, ZC_DC = 2304, ZC_DH = 2560;

#define LAS __attribute__((address_space(3)))
typedef unsigned short bf16;
typedef short bf16x8 __attribute__((ext_vector_type(8)));
typedef float f32x4 __attribute__((ext_vector_type(4)));
typedef unsigned u32x4 __attribute__((ext_vector_type(4)));
typedef unsigned u32x2 __attribute__((ext_vector_type(2)));

constexpr size_t SZ_WIN = (size_t)INW * DM * 2, SZ_WOUT = (size_t)DM * DM * 2, SZ_WGU = (size_t)2 * DFF * DM * 2, SZ_WD = (size_t)DM * DFF * 2, SZ_LRUW = (size_t)16 * 4096 * 2;
constexpr size_t OFF_WIN = 0;
constexpr size_t OFF_WOUT = OFF_WIN + DEPTH * SZ_WIN;
constexpr size_t OFF_WGU = OFF_WOUT + DEPTH * SZ_WOUT;
constexpr size_t OFF_WD = OFF_WGU + DEPTH * SZ_WGU;
constexpr size_t OFF_LRUW = OFF_WD + DEPTH * SZ_WD;
constexpr size_t OFF_XB = OFF_LRUW + DEPTH * SZ_LRUW;
constexpr size_t OFF_Z = OFF_XB + (size_t)M * DM * 2;
constexpr size_t OFF_Y = OFF_Z + (size_t)M * INW * 2;
constexpr size_t OFF_UF = OFF_Y + (size_t)M * DM * 2;
constexpr size_t USTRIDE = (size_t)BATCH * NHEAD * 4096;
constexpr size_t OFF_UB = OFF_UF + (size_t)NCH * USTRIDE * 4;
constexpr size_t OFF_CA = OFF_UB + (size_t)NCH * USTRIDE * 4;
constexpr size_t OFF_CH = OFF_CA + (size_t)BATCH * NCH * 512 * 4;
constexpr size_t OFF_SP = OFF_CH + (size_t)BATCH * NCH * 512 * 4;
constexpr size_t OFF_CTL = OFF_SP + (size_t)DEPTH * 2 * GWID * 4;
constexpr size_t CTL_BYTES = 16384;
constexpr size_t WS_END = OFF_CTL + CTL_BYTES;
constexpr int LDS_MISC_OFF = 131072, LDS_BYTES = 131072 + 256;

__device__ __forceinline__ float bflo(unsigned w) { return __uint_as_float(w << 16); }
__device__ __forceinline__ float bfhi(unsigned w) { return __uint_as_float(w & 0xffff0000u); }
__device__ __forceinline__ void unpack8(const u32x4 w, float* f) { f[0] = bflo(w.x); f[1] = bfhi(w.x); f[2] = bflo(w.y); f[3] = bfhi(w.y); f[4] = bflo(w.z); f[5] = bfhi(w.z); f[6] = bflo(w.w); f[7] = bfhi(w.w); }
__device__ __forceinline__ void unpack4(const u32x2 w, float* f) { f[0] = bflo(w.x); f[1] = bfhi(w.x); f[2] = bflo(w.y); f[3] = bfhi(w.y); }
__device__ __forceinline__ unsigned pk2(float lo, float hi) { return pg8::cvt_pk_bf16(lo, hi); }
__device__ __forceinline__ bf16 f2bf(float x) { return (bf16)(pg8::cvt_pk_bf16(x, 0.f) & 0xffffu); }
__device__ __forceinline__ u32x4 pack8(const float* f) { u32x4 w; w.x = pk2(f[0], f[1]); w.y = pk2(f[2], f[3]); w.z = pk2(f[4], f[5]); w.w = pk2(f[6], f[7]); return w; }
__device__ __forceinline__ float sigmoid_f(float x) { return __builtin_amdgcn_rcpf(1.0f + __expf(-x)); }
__device__ __forceinline__ float silu_f(float x) { return x * sigmoid_f(x); }
__device__ __forceinline__ float gelu_f(float x) { return x * sigmoid_f(1.5957691216057308f * (x + 0.044715f * x * x * x)); }
__device__ __forceinline__ float log_gamma_h(int h) { return h == 0 ? -0.0317486983145803f : (h == 1 ? -0.015748356968139168f : (h == 2 ? -0.007843177461025893f : -0.003913899321136329f)); }
__device__ __forceinline__ void rope_cs(float pos, int i, float& c, float& s) {
    const float invf = exp2f(-(float)i * 0.4152410118609203f);
    const float ang = pos * invf;
    const float n = rintf(ang * 0.15915494309189535f);
    float r = fmaf(-n, 6.2831854820251465f, ang); r = fmaf(-n, -1.7484555e-7f, r);
    const float rv = r * 0.15915494309189535f;
    s = __builtin_amdgcn_sinf(rv); c = __builtin_amdgcn_cosf(rv);
}
__device__ __forceinline__ float neg_expm1_f(float x) {
    const float p = -x * (1.0f + x * (0.5f + x * (0.16666667f + x * (0.041666668f + x * 0.0083333338f))));
    return x > -0.25f ? p : 1.0f - __expf(x);
}
#define MFMA16(a, b, c) __builtin_amdgcn_mfma_f32_16x16x32_bf16((a), (b), (c), 0, 0, 0)
template <int CTRL> __device__ __forceinline__ float dpp_f(float oldv, float src) { return __int_as_float(__builtin_amdgcn_update_dpp(__float_as_int(oldv), __float_as_int(src), CTRL, 0xf, 0xf, false)); }

struct EpiRes {
    static constexpr bool PERM = false, AFTER_DRAIN = false;
    const float* res; float* out; float alpha;
    __device__ __forceinline__ void operator()(const pg8::f32x4 (&acc)[2][2][4][2], const pg8::Unit& u, int wr, int wc, int fr, int fq) const {
        const int row0 = u.pm * 256 + wr * 64 + fr, col0 = u.pn * 256 + wc * 32 + 4 * fq;
#pragma unroll
        for (int ai = 0; ai < 2; ++ai)
#pragma unroll
            for (int m = 0; m < 4; ++m) { const size_t off = (size_t)(row0 + ai * 128 + m * 16) * DM + col0;
#pragma unroll
                for (int bj = 0; bj < 2; ++bj)
#pragma unroll
                    for (int n = 0; n < 2; ++n) { const f32x4 r = *(const f32x4*)(res + off + bj * 128 + n * 16); *(f32x4*)(out + off + bj * 128 + n * 16) = r * alpha + acc[ai][bj][m][n]; }
                asm volatile("" ::: "memory"); }
    }
};
struct EpiSwiGLU {
    static constexpr bool PERM = true, AFTER_DRAIN = false;
    bf16* O;
    __device__ __forceinline__ void operator()(const pg8::f32x4 (&acc)[2][2][4][2], const pg8::Unit& u, int wr, int wc, int fr, int fq) const {
        const int row0 = u.pm * 256 + wr * 64 + fr, col0 = u.pn * 128 + wc * 32 + 8 * fq;
#pragma unroll
        for (int ai = 0; ai < 2; ++ai)
#pragma unroll
            for (int m = 0; m < 4; ++m) { bf16* rowp = O + (size_t)(row0 + ai * 128 + m * 16) * DFF + col0;
                const f32x4 g0 = acc[ai][0][m][0], g1 = acc[ai][0][m][1], u0 = acc[ai][1][m][0], u1 = acc[ai][1][m][1];
                u32x4 w; w.x = pk2(silu_f(g0[0]) * u0[0], silu_f(g0[1]) * u0[1]); w.y = pk2(silu_f(g0[2]) * u0[2], silu_f(g0[3]) * u0[3]);
                w.z = pk2(silu_f(g1[0]) * u1[0], silu_f(g1[1]) * u1[1]); w.w = pk2(silu_f(g1[2]) * u1[2], silu_f(g1[3]) * u1[3]);
                *(u32x4*)rowp = w; }
    }
};

struct Args { const void* in[25]; float* out; unsigned char* ws; };
struct Ctx {
    const float* x; const int* pos; const float* w_in; const float* gmlp_ln_g; const float* gmlp_ln_b; const float* gmlp_ws; const float* gmlp_bs; const float* ret_gn_g; const float* ret_gn_b;
    const float* lru_conv_w; const float* lru_conv_b; const float* lru_wa; const float* lru_ba; const float* lru_wx; const float* lru_bx; const float* lru_lambda; const float* sc_conv_w;
    const float* w_out; const float* ln1_g; const float* ln1_b; const float* ffn_wg; const float* ffn_wu; const float* ffn_wd; const float* ln2_g; const float* ln2_b;
    float* out; bf16 *WIN, *WOUT, *WGU, *WD, *LRUW, *XB, *Z, *Y; float *UF, *UB, *CA, *CH, *SP;
};

__device__ __forceinline__ void tr_item(const float* W, int N, bf16* dst_rows, int ldt, int k0, int n0, LAS float* scr, int lane) {
#pragma unroll 8
    for (int i = 0; i < 32; ++i) { const int kk = 2 * i + (lane >> 5); scr[kk * 33 + (lane & 31)] = W[(size_t)(k0 + kk) * N + n0 + (lane & 31)]; }
    asm volatile("s_waitcnt lgkmcnt(0)" ::: "memory");
    const int c = lane & 7;
#pragma unroll
    for (int j = 0; j < 4; ++j) { const int n = (lane >> 3) + 8 * j; const LAS float* s = scr + (8 * c) * 33 + n;
        u32x4 o; o.x = pk2(s[0 * 33], s[1 * 33]); o.y = pk2(s[2 * 33], s[3 * 33]); o.z = pk2(s[4 * 33], s[5 * 33]); o.w = pk2(s[6 * 33], s[7 * 33]);
        *(u32x4*)(dst_rows + (size_t)n * ldt + k0 + 8 * c) = o; }
    asm volatile("s_waitcnt lgkmcnt(0)" ::: "memory");
}
__device__ __forceinline__ void prologue(const Ctx& C, LAS unsigned char* lds) {
    int tid_ = threadIdx.x; asm volatile("" : "+v"(tid_)); const int tid = tid_, lane = tid & 63, wave = tid >> 6;
    LAS float* scr = (LAS float*)(lds + wave * 16384);
    const int gw = blockIdx.x * 8 + wave, NGW = gridDim.x * 8;
    constexpr int I_IN = (DM / 64) * (INW / 32), I_OUT = (DM / 64) * (DM / 32), I_G = (DM / 64) * (DFF / 32), I_D = (DFF / 64) * (DM / 32), I_L = 8 * 2;
    constexpr int PER_LAYER = I_IN + I_OUT + 2 * I_G + I_D + 2 * I_L;
    for (int it = gw; it < DEPTH * PER_LAYER; it += NGW) {
        const int l = it / PER_LAYER; int r = it % PER_LAYER;
        if (r < I_IN) { const int nb = INW / 32, k0 = 64 * (r / nb), n0 = 32 * (r % nb); tr_item(C.w_in + (size_t)l * DM * INW, INW, C.WIN + (size_t)l * INW * DM + (size_t)n0 * DM, DM, k0, n0, scr, lane); continue; } r -= I_IN;
        if (r < I_OUT) { const int nb = DM / 32, k0 = 64 * (r / nb), n0 = 32 * (r % nb); tr_item(C.w_out + (size_t)l * DM * DM, DM, C.WOUT + (size_t)l * DM * DM + (size_t)n0 * DM, DM, k0, n0, scr, lane); continue; } r -= I_OUT;
        if (r < 2 * I_G) { const int up = r >= I_G; if (up) r -= I_G; const int nb = DFF / 32, k0 = 64 * (r / nb), n0 = 32 * (r % nb); const int drow = 256 * (n0 / 128) + (n0 % 128) + (up ? 128 : 0);
            tr_item((up ? C.ffn_wu : C.ffn_wg) + (size_t)l * DM * DFF, DFF, C.WGU + (size_t)l * 2 * DFF * DM + (size_t)drow * DM, DM, k0, n0, scr, lane); continue; } r -= 2 * I_G;
        if (r < I_D) { const int nb = DM / 32, k0 = 64 * (r / nb), n0 = 32 * (r % nb); tr_item(C.ffn_wd + (size_t)l * DFF * DM, DM, C.WD + (size_t)l * DM * DFF + (size_t)n0 * DFF, DFF, k0, n0, scr, lane); continue; } r -= I_D;
        { const int which = r >= I_L; if (which) r -= I_L; const int mat = r >> 1, n0 = 32 * (r & 1);
          tr_item((which ? C.lru_wx : C.lru_wa) + ((size_t)l * 8 + mat) * 4096, 64, C.LRUW + (((size_t)l * 2 + which) * 8 + mat) * 4096 + (size_t)n0 * 64, 64, 0, n0, scr, lane); }
    }
    if (blockIdx.x * 512 + tid < DEPTH * 2 * GWID) { const int i = blockIdx.x * 512 + tid; C.SP[i] = log1pf(expf(-C.lru_lambda[i])); }
    const size_t gt = (size_t)blockIdx.x * 512 + tid, NT = (size_t)gridDim.x * 512;
    for (size_t i = gt; i < (size_t)M * DM / 8; i += NT) { const f32x4 a = *(const f32x4*)(C.x + i * 8), b = *(const f32x4*)(C.x + i * 8 + 4);
        u32x4 o; o.x = pk2(a[0], a[1]); o.y = pk2(a[2], a[3]); o.z = pk2(b[0], b[1]); o.w = pk2(b[2], b[3]); *(u32x4*)(C.XB + i * 8) = o; }
}

__device__ __forceinline__ float wave_sum(float v) {
#pragma unroll
    for (int o = 1; o < 64; o <<= 1) v += __shfl_xor(v, o);
    return v;
}
__device__ __forceinline__ void ln_phase(float* X, bf16* XB, const float* g, const float* b, bool write_bf) {
    int tid_ = threadIdx.x; asm volatile("" : "+v"(tid_)); const int lane = tid_ & 63, wave = tid_ >> 6;
    const int gw = blockIdx.x * 8 + wave, NGW = gridDim.x * 8;
    f32x4 gv[4], bv[4];
#pragma unroll
    for (int j = 0; j < 4; ++j) { gv[j] = *((const f32x4*)g + lane + 64 * j); bv[j] = *((const f32x4*)b + lane + 64 * j); }
    for (int m = gw; m < M; m += NGW) {
        f32x4* xr = (f32x4*)(X + (size_t)m * DM) + lane;
        f32x4 v[4]; float s = 0.f;
#pragma unroll
        for (int j = 0; j < 4; ++j) { v[j] = xr[64 * j]; s += (v[j][0] + v[j][1]) + (v[j][2] + v[j][3]); }
        const float mean = wave_sum(s) * (1.f / DM); float s2 = 0.f;
#pragma unroll
        for (int j = 0; j < 4; ++j) { v[j] = v[j] - mean; s2 += (v[j][0] * v[j][0] + v[j][1] * v[j][1]) + (v[j][2] * v[j][2] + v[j][3] * v[j][3]); }
        const float rstd = 1.f / sqrtf(wave_sum(s2) * (1.f / DM) + LN_EPS);
#pragma unroll
        for (int j = 0; j < 4; ++j) { const f32x4 o = v[j] * rstd * gv[j] + bv[j]; xr[64 * j] = o;
            if (write_bf) { u32x2 w; w.x = pk2(o[0], o[1]); w.y = pk2(o[2], o[3]); *((u32x2*)(XB + (size_t)m * DM) + lane + 64 * j) = w; } }
    }
}

__device__ __forceinline__ void gmlp_chunk(const Ctx& C, int l, int chunk, LAS unsigned char* lds) {
    int tid_ = threadIdx.x; asm volatile("" : "+v"(tid_)); const int tid = tid_, lane = tid & 63, w = tid >> 6, fr = lane & 15, fq = lane >> 4;
    LAS bf16* vnT = (LAS bf16*)lds;
    const int row0 = chunk * CHUNK;
    {
        const int t = tid >> 2, q4 = tid & 3;
        const bf16* src = C.Z + (size_t)(row0 + t) * INW + ZC_AV + 64 * q4;
        float v[64]; float s = 0.f;
#pragma unroll
        for (int i = 0; i < 8; ++i) { const u32x4 wv = *(const u32x4*)(src + 8 * i); float f[8]; unpack8(wv, f);
#pragma unroll
            for (int j = 0; j < 8; ++j) { v[8 * i + j] = gelu_f(f[j]); s += v[8 * i + j]; } }
        s += __shfl_xor(s, 1); s += __shfl_xor(s, 2);
        const float mean = s * (1.f / 256.f); float q = 0.f;
#pragma unroll
        for (int i = 0; i < 64; ++i) { v[i] -= mean; q += v[i] * v[i]; }
        q += __shfl_xor(q, 1); q += __shfl_xor(q, 2);
        const float rstd = 1.f / sqrtf(q * (1.f / 256.f) + LN_EPS);
        const float* g = C.gmlp_ln_g + l * GWID + 64 * q4; const float* bb = C.gmlp_ln_b + l * GWID + 64 * q4;
#pragma unroll
        for (int i = 0; i < 64; ++i) vnT[(64 * q4 + i) * 136 + t] = f2bf(v[i] * rstd * g[i] + bb[i]);
    }
    __syncthreads();
    {
        const int p = 16 * w + fr;
#pragma unroll 1
        for (int h = 0; h < NHEAD; ++h) {
            f32x4 acc[4];
#pragma unroll
            for (int nt = 0; nt < 4; ++nt) acc[nt] = (f32x4){0.f, 0.f, 0.f, 0.f};
            const float* wsrow = C.gmlp_ws + ((size_t)(l * NHEAD + h) * CHUNK + p) * CHUNK;
#pragma unroll
            for (int ks = 0; ks < 4; ++ks) {
                const f32x4 a0 = *(const f32x4*)(wsrow + 32 * ks + 8 * fq), a1 = *(const f32x4*)(wsrow + 32 * ks + 8 * fq + 4);
                u32x4 aw; aw.x = pk2(a0[0], a0[1]); aw.y = pk2(a0[2], a0[3]); aw.z = pk2(a1[0], a1[1]); aw.w = pk2(a1[2], a1[3]);
                const bf16x8 af = __builtin_bit_cast(bf16x8, aw);
#pragma unroll
                for (int nt = 0; nt < 4; ++nt) { const bf16x8 bfg = *(const LAS bf16x8*)(vnT + (64 * h + 16 * nt + fr) * 136 + 32 * ks + 8 * fq); acc[nt] = MFMA16(bfg, af, acc[nt]); }
            }
            const float bias = C.gmlp_bs[(l * NHEAD + h) * CHUNK + p];
#pragma unroll
            for (int nt = 0; nt < 4; ++nt) { const int c = 64 * h + 16 * nt + 4 * fq;
                const u32x2 uw = *(const u32x2*)(C.Z + (size_t)(row0 + p) * INW + ZC_AU + c); float uf[4]; unpack4(uw, uf);
                u32x2 o; o.x = pk2(gelu_f(uf[0]) * (acc[nt][0] + bias), gelu_f(uf[1]) * (acc[nt][1] + bias)); o.y = pk2(gelu_f(uf[2]) * (acc[nt][2] + bias), gelu_f(uf[3]) * (acc[nt][3] + bias));
                *(u32x2*)(C.Y + (size_t)(row0 + p) * DM + 0 + c) = o; }
        }
    }
    __syncthreads();
}

__device__ __forceinline__ void ret_pass1(const Ctx& C, int chunk, LAS unsigned char* lds) {
    int tid_ = threadIdx.x; asm volatile("" : "+v"(tid_)); const int tid = tid_, lane = tid & 63, w = tid >> 6, fr = lane & 15, fq = lane >> 4;
    LAS bf16* vT = (LAS bf16*)lds; LAS bf16* kfT = vT + 64 * 136; LAS bf16* kbT = kfT + 64 * 136;
    const int b = chunk >> 6, n = chunk & 63, row0 = chunk * CHUNK;
#pragma unroll 1
    for (int h = 0; h < NHEAD; ++h) {
        {
            const int j = tid >> 2, sub = tid & 3;
            const bf16* zrow = C.Z + (size_t)(row0 + j) * INW;
            const u32x4 k1w = *(const u32x4*)(zrow + ZC_RK + 64 * h + 8 * sub), k2w = *(const u32x4*)(zrow + ZC_RK + 64 * h + 32 + 8 * sub);
            const u32x4 v1w = *(const u32x4*)(zrow + ZC_RV + 64 * h + 16 * sub), v2w = *(const u32x4*)(zrow + ZC_RV + 64 * h + 16 * sub + 8);
            const float pos = (float)C.pos[row0 + j];
            const float lgm = log_gamma_h(h);
            const float decf = __expf(lgm * (float)(CHUNK - 1 - j)) * 0.125f, decb = __expf(lgm * (float)j) * 0.125f;
            float k1[8], k2[8]; unpack8(k1w, k1); unpack8(k2w, k2);
#pragma unroll
            for (int ii = 0; ii < 8; ++ii) { const int i = 8 * sub + ii; float c, s; rope_cs(pos, i, c, s);
                const float r1 = k1[ii] * c - k2[ii] * s, r2 = k2[ii] * c + k1[ii] * s;
                kfT[i * 136 + j] = f2bf(r1 * decf); kfT[(32 + i) * 136 + j] = f2bf(r2 * decf);
                kbT[i * 136 + j] = f2bf(r1 * decb); kbT[(32 + i) * 136 + j] = f2bf(r2 * decb); }
            const unsigned vw[8] = {v1w.x, v1w.y, v1w.z, v1w.w, v2w.x, v2w.y, v2w.z, v2w.w};
#pragma unroll
            for (int ii = 0; ii < 8; ++ii) { vT[(16 * sub + 2 * ii) * 136 + j] = (bf16)(vw[ii] & 0xffffu); vT[(16 * sub + 2 * ii + 1) * 136 + j] = (bf16)(vw[ii] >> 16); }
        }
        __syncthreads();
        {
            const int z = w >> 2, mt = w & 3; LAS bf16* kT = z ? kbT : kfT;
            f32x4 acc[4];
#pragma unroll
            for (int nt = 0; nt < 4; ++nt) acc[nt] = (f32x4){0.f, 0.f, 0.f, 0.f};
#pragma unroll
            for (int ks = 0; ks < 4; ++ks) { const bf16x8 af = *(const LAS bf16x8*)(vT + (16 * mt + fr) * 136 + 32 * ks + 8 * fq);
#pragma unroll
                for (int nt = 0; nt < 4; ++nt) { const bf16x8 bfg = *(const LAS bf16x8*)(kT + (16 * nt + fr) * 136 + 32 * ks + 8 * fq); acc[nt] = MFMA16(bfg, af, acc[nt]); } }
            float* U = (z ? C.UB : C.UF) + (size_t)n * USTRIDE + (size_t)(b * NHEAD + h) * 4096;
#pragma unroll
            for (int nt = 0; nt < 4; ++nt) *(f32x4*)(U + (16 * mt + fr) * 64 + 16 * nt + 4 * fq) = acc[nt];
        }
        __syncthreads();
    }
}

__device__ __forceinline__ void ret_pass2(const Ctx& C, int l, int chunk, LAS unsigned char* lds) {
    int tid_ = threadIdx.x; asm volatile("" : "+v"(tid_)); const int tid = tid_, lane = tid & 63, w = tid >> 6, fr = lane & 15, fq = lane >> 4;
    LAS bf16* kr = (LAS bf16*)lds; LAS bf16* qr = kr + 128 * 72; LAS bf16* BT = qr + 128 * 72; LAS bf16* Ss = BT + 64 * 264;
    const int b = chunk >> 6, n = chunk & 63, row0 = chunk * CHUNK;
#pragma unroll 1
    for (int h = 0; h < NHEAD; ++h) {
        const float lgm = log_gamma_h(h);
        {
            const int j = tid >> 2, sub = tid & 3;
            const bf16* zrow = C.Z + (size_t)(row0 + j) * INW;
            const u32x4 q1w = *(const u32x4*)(zrow + ZC_RQ + 64 * h + 8 * sub), q2w = *(const u32x4*)(zrow + ZC_RQ + 64 * h + 32 + 8 * sub);
            const u32x4 k1w = *(const u32x4*)(zrow + ZC_RK + 64 * h + 8 * sub), k2w = *(const u32x4*)(zrow + ZC_RK + 64 * h + 32 + 8 * sub);
            const u32x4 v1w = *(const u32x4*)(zrow + ZC_RV + 64 * h + 16 * sub), v2w = *(const u32x4*)(zrow + ZC_RV + 64 * h + 16 * sub + 8);
            const float pos = (float)C.pos[row0 + j];
            float q1[8], q2[8], k1[8], k2[8]; unpack8(q1w, q1); unpack8(q2w, q2); unpack8(k1w, k1); unpack8(k2w, k2);
            float oq1[8], oq2[8], ok1[8], ok2[8];
#pragma unroll
            for (int ii = 0; ii < 8; ++ii) { float c, s; rope_cs(pos, 8 * sub + ii, c, s);
                oq1[ii] = q1[ii] * c - q2[ii] * s; oq2[ii] = q2[ii] * c + q1[ii] * s;
                ok1[ii] = (k1[ii] * c - k2[ii] * s) * 0.125f; ok2[ii] = (k2[ii] * c + k1[ii] * s) * 0.125f; }
            *(LAS u32x4*)(qr + j * 72 + 8 * sub) = pack8(oq1); *(LAS u32x4*)(qr + j * 72 + 32 + 8 * sub) = pack8(oq2);
            *(LAS u32x4*)(kr + j * 72 + 8 * sub) = pack8(ok1); *(LAS u32x4*)(kr + j * 72 + 32 + 8 * sub) = pack8(ok2);
            const unsigned vw[8] = {v1w.x, v1w.y, v1w.z, v1w.w, v2w.x, v2w.y, v2w.z, v2w.w};
#pragma unroll
            for (int ii = 0; ii < 8; ++ii) { BT[(16 * sub + 2 * ii) * 264 + j] = (bf16)(vw[ii] & 0xffffu); BT[(16 * sub + 2 * ii + 1) * 264 + j] = (bf16)(vw[ii] >> 16); }
            const int e = tid >> 3, d0 = 8 * (tid & 7);
            const size_t uo = (size_t)n * USTRIDE + (size_t)(b * NHEAD + h) * 4096 + e * 64 + d0;
            { const f32x4 a = *(const f32x4*)(C.UF + uo), c4 = *(const f32x4*)(C.UF + uo + 4); u32x4 o; o.x = pk2(a[0], a[1]); o.y = pk2(a[2], a[3]); o.z = pk2(c4[0], c4[1]); o.w = pk2(c4[2], c4[3]); *(LAS u32x4*)(BT + e * 264 + 128 + d0) = o; }
            { const f32x4 a = *(const f32x4*)(C.UB + uo), c4 = *(const f32x4*)(C.UB + uo + 4); u32x4 o; o.x = pk2(a[0], a[1]); o.y = pk2(a[2], a[3]); o.z = pk2(c4[0], c4[1]); o.w = pk2(c4[2], c4[3]); *(LAS u32x4*)(BT + e * 264 + 192 + d0) = o; }
        }
        __syncthreads();
        {
            const int i = 16 * w + fr;
            bf16x8 qf[2];
#pragma unroll
            for (int ks = 0; ks < 2; ++ks) qf[ks] = *(const LAS bf16x8*)(qr + i * 72 + 32 * ks + 8 * fq);
            LAS bf16* Sw = Ss + w * 16 * 136;
#pragma unroll
            for (int nt = 0; nt < 8; ++nt) { f32x4 s = (f32x4){0.f, 0.f, 0.f, 0.f};
#pragma unroll
                for (int ks = 0; ks < 2; ++ks) { const bf16x8 kf = *(const LAS bf16x8*)(kr + (16 * nt + fr) * 72 + 32 * ks + 8 * fq); s = MFMA16(kf, qf[ks], s); }
                float sv[4];
#pragma unroll
                for (int r = 0; r < 4; ++r) { const int jj = 16 * nt + 4 * fq + r; sv[r] = s[r] * __expf(lgm * fabsf((float)(i - jj))); }
                u32x2 o; o.x = pk2(sv[0], sv[1]); o.y = pk2(sv[2], sv[3]);
                *(LAS u32x2*)(Sw + fr * 136 + 16 * nt + 4 * fq) = o; }
            asm volatile("s_waitcnt lgkmcnt(0)" ::: "memory");
            f32x4 a1[4], a2[4], a3[4];
#pragma unroll
            for (int nt = 0; nt < 4; ++nt) { a1[nt] = (f32x4){0.f, 0.f, 0.f, 0.f}; a2[nt] = a1[nt]; a3[nt] = a1[nt]; }
#pragma unroll
            for (int ks = 0; ks < 4; ++ks) { const bf16x8 sf = *(const LAS bf16x8*)(Sw + fr * 136 + 32 * ks + 8 * fq);
#pragma unroll
                for (int nt = 0; nt < 4; ++nt) { const bf16x8 bfr = *(const LAS bf16x8*)(BT + (16 * nt + fr) * 264 + 32 * ks + 8 * fq); a1[nt] = MFMA16(bfr, sf, a1[nt]); } }
#pragma unroll
            for (int ks = 0; ks < 2; ++ks)
#pragma unroll
                for (int nt = 0; nt < 4; ++nt) { const bf16x8 b2 = *(const LAS bf16x8*)(BT + (16 * nt + fr) * 264 + 128 + 32 * ks + 8 * fq); a2[nt] = MFMA16(b2, qf[ks], a2[nt]);
                    const bf16x8 b3 = *(const LAS bf16x8*)(BT + (16 * nt + fr) * 264 + 192 + 32 * ks + 8 * fq); a3[nt] = MFMA16(b3, qf[ks], a3[nt]); }
            const float sfw = __expf(lgm * (float)(i + 1)), sbw = __expf(lgm * (float)(CHUNK - i));
            float sum = 0.f;
#pragma unroll
            for (int nt = 0; nt < 4; ++nt) { a1[nt] = a1[nt] + a2[nt] * sfw + a3[nt] * sbw; sum += (a1[nt][0] + a1[nt][1]) + (a1[nt][2] + a1[nt][3]); }
            sum += __shfl_xor(sum, 16); sum += __shfl_xor(sum, 32);
            const float mean = sum * (1.f / 64.f); float q = 0.f;
#pragma unroll
            for (int nt = 0; nt < 4; ++nt) { a1[nt] = a1[nt] - mean; q += (a1[nt][0] * a1[nt][0] + a1[nt][1] * a1[nt][1]) + (a1[nt][2] * a1[nt][2] + a1[nt][3] * a1[nt][3]); }
            q += __shfl_xor(q, 16); q += __shfl_xor(q, 32);
            const float rstd = 1.f / sqrtf(q * (1.f / 64.f) + LN_EPS);
#pragma unroll
            for (int nt = 0; nt < 4; ++nt) { const int e = 64 * h + 16 * nt + 4 * fq;
                const f32x4 gg = *(const f32x4*)(C.ret_gn_g + l * GWID + e), gb = *(const f32x4*)(C.ret_gn_b + l * GWID + e);
                const u32x2 gw = *(const u32x2*)(C.Z + (size_t)(row0 + i) * INW + ZC_RG + e); float gf[4]; unpack4(gw, gf);
                float o[4];
#pragma unroll
                for (int r = 0; r < 4; ++r) o[r] = silu_f(gf[r]) * (a1[nt][r] * rstd * gg[r] + gb[r]);
                u32x2 ow; ow.x = pk2(o[0], o[1]); ow.y = pk2(o[2], o[3]);
                *(u32x2*)(C.Y + (size_t)(row0 + i) * DM + 256 + e) = ow; }
        }
        __syncthreads();
    }
}

#define SCAN_STEP_F(OFF) { const float ap = dpp_f<0x110 + OFF>(1.0f, Av), bp = dpp_f<0x110 + OFF>(0.0f, Bv); Bv = Av * bp + Bv; Av = Av * ap; }
#define SCAN_STEP_B(OFF) { const float ap = dpp_f<0x100 + OFF>(1.0f, Av), bp = dpp_f<0x100 + OFF>(0.0f, Bv); Bv = Av * bp + Bv; Av = Av * ap; }
template <int MODE>
__device__ __forceinline__ void lru_pass(const Ctx& C, int l, int chunk, LAS unsigned char* lds) {
    int tid_ = threadIdx.x; asm volatile("" : "+v"(tid_)); const int tid = tid_, lane = tid & 63, w = tid >> 6, fr = lane & 15, fq = lane >> 4;
    LAS bf16* xa = (LAS bf16*)lds;
    LAS float* xf = (LAS float*)(lds + 18432);
    LAS float* SUM = (LAS float*)(lds + 18432 + 34816);
    const int b = chunk >> 6, n = chunk & 63, row0 = chunk * CHUNK;
#pragma unroll 1
    for (int h = 0; h < NHEAD; ++h) {
        {
            const int t = tid >> 2, sub = tid & 3, ch = 64 * h + 16 * sub;
            float acc[16];
#pragma unroll
            for (int ii = 0; ii < 16; ii += 4) { const f32x4 cb = *(const f32x4*)(C.lru_conv_b + l * GWID + ch + ii); acc[ii] = cb[0]; acc[ii + 1] = cb[1]; acc[ii + 2] = cb[2]; acc[ii + 3] = cb[3]; }
#pragma unroll
            for (int k = 0; k < 4; ++k) { const int s = n * CHUNK + t + k - 2;
                if (s >= 0 && s < SEQ) { const bf16* p = C.Z + (size_t)(b * SEQ + s) * INW + ZC_CX + ch;
                    const u32x4 x1 = *(const u32x4*)p, x2 = *(const u32x4*)(p + 8); float xv[16]; unpack8(x1, xv); unpack8(x2, xv + 8);
                    const float* wp = C.lru_conv_w + (size_t)(l * 4 + k) * GWID + ch;
#pragma unroll
                    for (int ii = 0; ii < 16; ii += 4) { const f32x4 wv = *(const f32x4*)(wp + ii); acc[ii] += wv[0] * xv[ii]; acc[ii + 1] += wv[1] * xv[ii + 1]; acc[ii + 2] += wv[2] * xv[ii + 2]; acc[ii + 3] += wv[3] * xv[ii + 3]; } } }
            *(LAS u32x4*)(xa + t * 72 + 16 * sub) = pack8(acc); *(LAS u32x4*)(xa + t * 72 + 16 * sub + 8) = pack8(acc + 8);
#pragma unroll
            for (int ii = 0; ii < 16; ii += 4) *(LAS f32x4*)(xf + t * 68 + 16 * sub + ii) = (f32x4){acc[ii], acc[ii + 1], acc[ii + 2], acc[ii + 3]};
        }
        __syncthreads();
        float Aa[2][4][4], Bb[2][4][4];
        {
            const int t = 16 * w + fr;
            bf16x8 af[2];
#pragma unroll
            for (int ks = 0; ks < 2; ++ks) af[ks] = *(const LAS bf16x8*)(xa + t * 72 + 32 * ks + 8 * fq);
            f32x4 acc[4][4];
#pragma unroll
            for (int pr = 0; pr < 4; ++pr)
#pragma unroll
                for (int nt = 0; nt < 4; ++nt) acc[pr][nt] = (f32x4){0.f, 0.f, 0.f, 0.f};
#pragma unroll
            for (int pr = 0; pr < 4; ++pr) { const int which = pr >> 1, z = pr & 1;
                const bf16* WT = C.LRUW + (((size_t)l * 2 + which) * 8 + z * 4 + h) * 4096;
#pragma unroll
                for (int nt = 0; nt < 4; ++nt)
#pragma unroll
                    for (int ks = 0; ks < 2; ++ks) { const bf16x8 wf = *(const bf16x8*)(WT + (16 * nt + fr) * 64 + 32 * ks + 8 * fq); acc[pr][nt] = MFMA16(wf, af[ks], acc[pr][nt]); } }
#pragma unroll
            for (int z = 0; z < 2; ++z)
#pragma unroll
                for (int nt = 0; nt < 4; ++nt) { const f32x4 xv = *(const LAS f32x4*)(xf + t * 68 + 16 * nt + 4 * fq);
                    const int j = 64 * h + 16 * nt + 4 * fq;
                    const f32x4 ba = *(const f32x4*)(C.lru_ba + (l * 2 + z) * GWID + j), bx = *(const f32x4*)(C.lru_bx + (l * 2 + z) * GWID + j), spv = *(const f32x4*)(C.SP + (l * 2 + z) * GWID + j);
#pragma unroll
                    for (int r = 0; r < 4; ++r) { const float rg = sigmoid_f(acc[z][nt][r] + ba[r]), ig = sigmoid_f(acc[2 + z][nt][r] + bx[r]);
                        const float la = -8.0f * spv[r] * rg;
                        Aa[z][nt][r] = __expf(la); Bb[z][nt][r] = xv[r] * ig * __builtin_amdgcn_sqrtf(neg_expm1_f(2.0f * la)); } }
#pragma unroll
            for (int nt = 0; nt < 4; ++nt)
#pragma unroll
                for (int r = 0; r < 4; ++r) {
                    { float Av = Aa[0][nt][r], Bv = Bb[0][nt][r]; SCAN_STEP_F(1) SCAN_STEP_F(2) SCAN_STEP_F(4) SCAN_STEP_F(8) Aa[0][nt][r] = Av; Bb[0][nt][r] = Bv; }
                    { float Av = Aa[1][nt][r], Bv = Bb[1][nt][r]; SCAN_STEP_B(1) SCAN_STEP_B(2) SCAN_STEP_B(4) SCAN_STEP_B(8) Aa[1][nt][r] = Av; Bb[1][nt][r] = Bv; }
                }
#pragma unroll
            for (int z = 0; z < 2; ++z)
                if (fr == (z ? 0 : 15)) {
#pragma unroll
                    for (int nt = 0; nt < 4; ++nt)
#pragma unroll
                        for (int r = 0; r < 4; ++r) { const int c = 16 * nt + 4 * fq + r; SUM[((w * 2 + z) * 64 + c) * 2] = Aa[z][nt][r]; SUM[((w * 2 + z) * 64 + c) * 2 + 1] = Bb[z][nt][r]; } }
        }
        __syncthreads();
        if (MODE == 0) {
            if (tid < 128) { const int z = tid >> 6, c = tid & 63; float Hh = 0.f, Ap = 1.f;
                for (int i = 0; i < 8; ++i) { const int ww = z ? 7 - i : i; const float a = SUM[((ww * 2 + z) * 64 + c) * 2], hh = SUM[((ww * 2 + z) * 64 + c) * 2 + 1]; Hh = a * Hh + hh; Ap *= a; }
                const size_t o = ((size_t)(b * NCH + n) * 2 + z) * GWID + 64 * h + c; C.CA[o] = Ap; C.CH[o] = Hh; }
        } else {
            const int t = 16 * w + fr;
#pragma unroll
            for (int nt = 0; nt < 4; ++nt) { const int cl = 16 * nt + 4 * fq;
                float hsum[4];
#pragma unroll
                for (int r = 0; r < 4; ++r) {
                    float c0 = C.CH[((size_t)(b * NCH + n) * 2 + 0) * GWID + 64 * h + cl + r];
                    for (int ww = 0; ww < w; ++ww) c0 = SUM[((ww * 2 + 0) * 64 + cl + r) * 2] * c0 + SUM[((ww * 2 + 0) * 64 + cl + r) * 2 + 1];
                    float c1 = C.CH[((size_t)(b * NCH + n) * 2 + 1) * GWID + 64 * h + cl + r];
                    for (int ww = 7; ww > w; --ww) c1 = SUM[((ww * 2 + 1) * 64 + cl + r) * 2] * c1 + SUM[((ww * 2 + 1) * 64 + cl + r) * 2 + 1];
                    hsum[r] = (Bb[0][nt][r] + Aa[0][nt][r] * c0) + (Bb[1][nt][r] + Aa[1][nt][r] * c1); }
                const u32x2 gw = *(const u32x2*)(C.Z + (size_t)(row0 + t) * INW + ZC_CG + 64 * h + cl); float gf[4]; unpack4(gw, gf);
                u32x2 ow; ow.x = pk2(hsum[0] * gelu_f(gf[0]), hsum[1] * gelu_f(gf[1])); ow.y = pk2(hsum[2] * gelu_f(gf[2]), hsum[3] * gelu_f(gf[3]));
                *(u32x2*)(C.Y + (size_t)(row0 + t) * DM + 512 + 64 * h + cl) = ow; }
        }
        __syncthreads();
    }
}

__device__ __forceinline__ void sc_chunk(const Ctx& C, int l, int chunk) {
    int tid_ = threadIdx.x; asm volatile("" : "+v"(tid_)); const int tid = tid_; const int b = chunk >> 6, n = chunk & 63, row0 = chunk * CHUNK;
#pragma unroll 1
    for (int u = tid; u < CHUNK * 32; u += 512) { const int t = u >> 5, c8 = (u & 31) * 8; const int s = n * CHUNK + t;
        float acc[8];
#pragma unroll
        for (int i = 0; i < 8; ++i) acc[i] = 0.f;
#pragma unroll
        for (int k = 0; k < 3; ++k) { const int ss = s + k - 1;
            if (ss >= 0 && ss < SEQ) { const bf16* zr = C.Z + (size_t)(b * SEQ + ss) * INW;
                const u32x4 cw = *(const u32x4*)(zr + ZC_DC + c8), hw = *(const u32x4*)(zr + ZC_DH + c8); float cf[8], hf[8]; unpack8(cw, cf); unpack8(hw, hf);
                const float* wp = C.sc_conv_w + (size_t)(l * 3 + k) * GWID + c8; const f32x4 w0 = *(const f32x4*)wp, w1 = *(const f32x4*)(wp + 4);
#pragma unroll
                for (int i = 0; i < 4; ++i) { acc[i] += w0[i] * (cf[i] * hf[i]); acc[4 + i] += w1[i] * (cf[4 + i] * hf[4 + i]); } } }
        const u32x4 bw = *(const u32x4*)(C.Z + (size_t)(row0 + t) * INW + ZC_DB + c8); float bf_[8]; unpack8(bw, bf_);
#pragma unroll
        for (int i = 0; i < 8; ++i) acc[i] *= bf_[i];
        *(u32x4*)(C.Y + (size_t)(row0 + t) * DM + 768 + c8) = pack8(acc); }
}

__device__ __forceinline__ void carry_phase(const Ctx& C) {
    int tid_ = threadIdx.x; asm volatile("" : "+v"(tid_)); const int gt = blockIdx.x * 512 + tid_, NT = gridDim.x * 512;
    for (int e = gt; e < 2 * (int)USTRIDE; e += NT) { const int dir = e >= (int)USTRIDE, idx = dir ? e - (int)USTRIDE : e; const int h = (idx >> 12) & 3;
        const float cd = __expf(log_gamma_h(h) * (float)CHUNK);
        float* base = (dir ? C.UB : C.UF) + idx; float st = 0.f;
#pragma unroll 1
        for (int n8 = 0; n8 < NCH; n8 += 8) { float u[8];
#pragma unroll
            for (int i = 0; i < 8; ++i) { const int n = dir ? NCH - 1 - (n8 + i) : n8 + i; u[i] = base[(size_t)n * USTRIDE]; }
#pragma unroll
            for (int i = 0; i < 8; ++i) { const int n = dir ? NCH - 1 - (n8 + i) : n8 + i; base[(size_t)n * USTRIDE] = st; st = cd * st + u[i]; } }
    }
    if (gt < BATCH * 512) { const int b = gt >> 9, zc = gt & 511, z = zc >> 8; float st = 0.f;
#pragma unroll 1
        for (int i = 0; i < NCH; ++i) { const int n = z ? NCH - 1 - i : i; const size_t o = (size_t)(b * NCH + n) * 512 + zc; const float a = C.CA[o], hh = C.CH[o]; C.CH[o] = st; st = a * st + hh; } }
}

#define RLX_AGENT __ATOMIC_RELAXED, __HIP_MEMORY_SCOPE_AGENT
#define XB_TMO      128
#define XB_XCNT(j)  (256  + 64 * (j))
#define XB_XSUB(j)  (1280 + 64 * (j))
#define XB_XGEN(j)  (2304 + 64 * (j))
#define XB_TOP      3328
#define XB_TOPGEN   3392
#define XCD_BAR_WORDS 3456
#define XB_SPIN_CAP (1u << 18)

__device__ __forceinline__ unsigned xb_ld(unsigned* p)              { return __hip_atomic_load(p, __ATOMIC_RELAXED, __HIP_MEMORY_SCOPE_AGENT); }
__device__ __forceinline__ unsigned xb_add(unsigned* p, unsigned v) { return __hip_atomic_fetch_add(p, v, __ATOMIC_RELAXED, __HIP_MEMORY_SCOPE_AGENT); }
__device__ __forceinline__ unsigned xb_xcc_id() { return (unsigned)__builtin_amdgcn_s_getreg((3 << 11) | 20) & 0xFu; }
#define XB_SPIN(cond, bar) do { unsigned _sp = 0; while (cond) { __builtin_amdgcn_s_sleep(1); \
    if ((++_sp & 255u) == 0u) { if (xb_ld(&(bar)[XB_TMO])) break; if (_sp > XB_SPIN_CAP) { atomicAdd(&(bar)[XB_TMO], 1u); break; } } } } while (0)

struct XcdBarrier {
    unsigned* bar; unsigned x;
    volatile LAS unsigned* st;
};

__device__ __forceinline__ XcdBarrier xcd_barrier_post(unsigned* bar, volatile LAS unsigned* st) {
    XcdBarrier b; b.bar = bar; b.x = xb_xcc_id(); b.st = st;
    if (threadIdx.x == 0) (void)xb_add(&bar[XB_XCNT(b.x)], 1u);
    return b;
}
__device__ __forceinline__ void xcd_barrier_complete(unsigned* bar, unsigned x, unsigned& nloc, unsigned& nx) {
    const unsigned G = gridDim.x * gridDim.y * gridDim.z;
    unsigned sum, cnt, mine, sp = 0u;
    for (;;) {
        sum = 0u; cnt = 0u; mine = 0u;
#pragma unroll
        for (unsigned j = 0; j < 16; ++j) { const unsigned c = xb_ld(&bar[XB_XCNT(j)]); sum += c; cnt += (c > 0u) ? 1u : 0u; mine = (j == x) ? c : mine; }
        if (sum == G) break;
        __builtin_amdgcn_s_sleep(1);
        if ((++sp & 255u) == 0u) { if (xb_ld(&bar[XB_TMO])) break; if (sp > XB_SPIN_CAP) { atomicAdd(&bar[XB_TMO], 1u); break; } }
    }
    nloc = mine > 0u ? mine : 1u; nx = cnt > 0u ? cnt : 1u;
}

__device__ __forceinline__ void xcd_barrier(const XcdBarrier& b) {
    asm volatile("s_waitcnt vmcnt(0)" ::: "memory");
    __syncthreads();
    if (threadIdx.x == 0) {
        unsigned* bar = b.bar;
        __builtin_amdgcn_s_waitcnt(0);
        unsigned nloc = b.st[0], nx = b.st[1];
        if (nloc == 0u) { xcd_barrier_complete(bar, b.x, nloc, nx); b.st[0] = nloc; b.st[1] = nx; }
        const unsigned old = xb_add(&bar[XB_XSUB(b.x)], 1u);
        const unsigned gen = old / nloc;
        if (old + 1u == (gen + 1u) * nloc) {
            __builtin_amdgcn_fence(__ATOMIC_RELEASE, "agent");
            asm volatile("s_waitcnt vmcnt(0)" ::: "memory");
            const unsigned og = xb_add(&bar[XB_TOP], 1u);
            const unsigned tg = og / nx;
            if (og + 1u == (tg + 1u) * nx) xb_add(&bar[XB_TOPGEN], 1u);
            else XB_SPIN(xb_ld(&bar[XB_TOPGEN]) == tg, bar);
            __builtin_amdgcn_fence(__ATOMIC_ACQUIRE, "agent");
            xb_add(&bar[XB_XGEN(b.x)], 1u);
            asm volatile("s_waitcnt vmcnt(0)" ::: "memory");
        } else {
            XB_SPIN(xb_ld(&bar[XB_XGEN(b.x)]) == gen, bar);
            __builtin_amdgcn_fence(__ATOMIC_ACQUIRE, "agent");
            asm volatile("s_waitcnt vmcnt(0)" ::: "memory");
        }
    }
    __syncthreads();
}

#ifndef DUP_MIX
#define DUP_MIX 0
#endif
#ifndef DUP_G13
#define DUP_G13 0
#endif
#define GRID_SYNC() do { asm volatile("s_waitcnt vmcnt(0) lgkmcnt(0)" ::: "memory"); grid.sync(); __builtin_amdgcn_fence(__ATOMIC_ACQUIRE, "agent"); asm volatile("s_waitcnt vmcnt(0)" ::: "memory"); } while (0)
typedef const __attribute__((address_space(4))) Args* KArgP;
__device__ __forceinline__ KArgP launder(KArgP p) { asm volatile("" : "+s"(p)); return p; }
__device__ __forceinline__ Ctx make_ctx(KArgP ap) {
    const __attribute__((address_space(4))) Args& args = *ap;
    Ctx C;
    C.x = (const float*)args.in[0]; C.pos = (const int*)args.in[1]; C.w_in = (const float*)args.in[2]; C.gmlp_ln_g = (const float*)args.in[3]; C.gmlp_ln_b = (const float*)args.in[4];
    C.gmlp_ws = (const float*)args.in[5]; C.gmlp_bs = (const float*)args.in[6]; C.ret_gn_g = (const float*)args.in[7]; C.ret_gn_b = (const float*)args.in[8];
    C.lru_conv_w = (const float*)args.in[9]; C.lru_conv_b = (const float*)args.in[10]; C.lru_wa = (const float*)args.in[11]; C.lru_ba = (const float*)args.in[12];
    C.lru_wx = (const float*)args.in[13]; C.lru_bx = (const float*)args.in[14]; C.lru_lambda = (const float*)args.in[15]; C.sc_conv_w = (const float*)args.in[16];
    C.w_out = (const float*)args.in[17]; C.ln1_g = (const float*)args.in[18]; C.ln1_b = (const float*)args.in[19]; C.ffn_wg = (const float*)args.in[20]; C.ffn_wu = (const float*)args.in[21];
    C.ffn_wd = (const float*)args.in[22]; C.ln2_g = (const float*)args.in[23]; C.ln2_b = (const float*)args.in[24];
    C.out = args.out; unsigned char* ws = args.ws;
    C.WIN = (bf16*)(ws + OFF_WIN); C.WOUT = (bf16*)(ws + OFF_WOUT); C.WGU = (bf16*)(ws + OFF_WGU); C.WD = (bf16*)(ws + OFF_WD); C.LRUW = (bf16*)(ws + OFF_LRUW);
    C.XB = (bf16*)(ws + OFF_XB); C.Z = (bf16*)(ws + OFF_Z); C.Y = (bf16*)(ws + OFF_Y); C.UF = (float*)(ws + OFF_UF); C.UB = (float*)(ws + OFF_UB); C.CA = (float*)(ws + OFF_CA); C.CH = (float*)(ws + OFF_CH); C.SP = (float*)(ws + OFF_SP);
    return C;
}
__global__ void __launch_bounds__(512) hybrid_fwd(Args args) {
    extern __shared__ __attribute__((aligned(16))) unsigned char lds_raw[];
    LAS unsigned char* lds = (LAS unsigned char*)lds_raw;
    cg::grid_group grid = cg::this_grid();
    (void)args; const KArgP ap0 = (KArgP)__builtin_amdgcn_kernarg_segment_ptr();
    unsigned char* const args_ws_ptr = ap0->ws;
    const int G = gridDim.x;
    if (threadIdx.x < 64) ((LAS unsigned*)(lds + LDS_MISC_OFF))[threadIdx.x] = 0u;
    __syncthreads();
    const XcdBarrier bar = xcd_barrier_post((unsigned*)(args_ws_ptr + OFF_CTL), (volatile LAS unsigned*)(lds + LDS_MISC_OFF));

    { const Ctx C = make_ctx(launder(ap0)); prologue(C, lds); }
    GRID_SYNC();
#pragma unroll 1
    for (int l = 0; l < DEPTH; ++l) {
        {
            const Ctx C = make_ctx(launder(ap0));
            pg8::Gemm g{C.XB, C.WIN + (size_t)l * INW * DM, M, INW, DM}; pg8::StaticOrder S; S.init(M, INW, G, (int)blockIdx.x);
            pg8::EpiBf16<0> E{C.Z, INW, nullptr, 0, 0, 1.f};
#pragma unroll 1
            for (int rep = 0; rep <= DUP_G13; ++rep)
            pg8::gemm_phase<pg8::EpiBf16<0>, pg8::StaticOrder, true, true>(lds, g, S, E);
        }
        xcd_barrier(bar);
#pragma unroll 1
        for (int rep = 0; rep <= DUP_MIX; ++rep)
#pragma unroll 1
        for (int c = blockIdx.x; c < NCHUNK; c += G) {
            { const Ctx C = make_ctx(launder(ap0)); gmlp_chunk(C, l, c, lds); }
            { const Ctx C = make_ctx(launder(ap0)); ret_pass1(C, c, lds); }
            { const Ctx C = make_ctx(launder(ap0)); lru_pass<0>(C, l, c, lds); }
            { const Ctx C = make_ctx(launder(ap0)); sc_chunk(C, l, c); } }
        xcd_barrier(bar);
        { const Ctx C = make_ctx(launder(ap0)); carry_phase(C); }
        xcd_barrier(bar);
#pragma unroll 1
        for (int rep = 0; rep <= DUP_MIX; ++rep)
#pragma unroll 1
        for (int c = blockIdx.x; c < NCHUNK; c += G) {
            { const Ctx C = make_ctx(launder(ap0)); ret_pass2(C, l, c, lds); }
            { const Ctx C = make_ctx(launder(ap0)); lru_pass<1>(C, l, c, lds); } }
        xcd_barrier(bar);
        {
            const Ctx C = make_ctx(launder(ap0));
            pg8::Gemm g{C.Y, C.WOUT + (size_t)l * DM * DM, M, DM, DM}; pg8::StaticOrder S; S.init(M, DM, G, (int)blockIdx.x);
            EpiRes E{l == 0 ? C.x : C.out, C.out, DN_ALPHA};
            pg8::gemm_phase<EpiRes, pg8::StaticOrder, true, true>(lds, g, S, E);
        }
        xcd_barrier(bar);
        { const Ctx C = make_ctx(launder(ap0)); ln_phase(C.out, C.XB, C.ln1_g + l * DM, C.ln1_b + l * DM, true); }
        xcd_barrier(bar);
        {
            const Ctx C = make_ctx(launder(ap0));
            pg8::Gemm g{C.XB, C.WGU + (size_t)l * 2 * DFF * DM, M, 2 * DFF, DM}; pg8::StaticOrder S; S.init(M, 2 * DFF, G, (int)blockIdx.x);
            EpiSwiGLU E{C.Z};
#pragma unroll 1
            for (int rep = 0; rep <= DUP_G13; ++rep)
            pg8::gemm_phase<EpiSwiGLU, pg8::StaticOrder, true, true>(lds, g, S, E);
        }
        xcd_barrier(bar);
        {
            const Ctx C = make_ctx(launder(ap0));
            pg8::Gemm g{C.Z, C.WD + (size_t)l * DM * DFF, M, DM, DFF}; pg8::StaticOrder S; S.init(M, DM, G, (int)blockIdx.x);
            EpiRes E{C.out, C.out, DN_ALPHA};
            pg8::gemm_phase<EpiRes, pg8::StaticOrder, true, true>(lds, g, S, E);
        }
        xcd_barrier(bar);
        { const Ctx C = make_ctx(launder(ap0)); ln_phase(C.out, C.XB, C.ln2_g + l * DM, C.ln2_b + l * DM, l + 1 < DEPTH); }
        if (l + 1 < DEPTH) xcd_barrier(bar);
    }
}

extern "C" void kernel_launch(void* const* d_in, const int* in_sizes, int n_in, void* d_out, int out_size, void* d_ws, size_t ws_size, hipStream_t stream) {
    static int grid = 0;
    if (grid == 0) {
        if (n_in != 25 || out_size != M * DM || ws_size < WS_END) { fprintf(stderr, "kernel_launch: unexpected shapes (n_in %d out %d ws %zu need %zu)\n", n_in, out_size, ws_size, (size_t)WS_END); grid = -1; return; }
        int dev = 0, cus = 0, per_cu = 0;
        (void)hipGetDevice(&dev); (void)hipDeviceGetAttribute(&cus, hipDeviceAttributeMultiprocessorCount, dev);
        if (hipFuncSetAttribute((const void*)hybrid_fwd, hipFuncAttributeMaxDynamicSharedMemorySize, LDS_BYTES) != hipSuccess) { fprintf(stderr, "kernel_launch: hipFuncSetAttribute failed\n"); grid = -1; return; }
        if (hipOccupancyMaxActiveBlocksPerMultiprocessor(&per_cu, (const void*)hybrid_fwd, 512, LDS_BYTES) != hipSuccess || per_cu < 1) { fprintf(stderr, "kernel_launch: occupancy query says %d\n", per_cu); per_cu = 1; }
        (void)hipGetLastError();
        grid = cus * per_cu; if (grid > 256) grid = 256; if (grid < 1) grid = 256;
    }
    if (grid < 0) return;
    if (hipMemsetAsync((char*)d_ws + OFF_CTL, 0, CTL_BYTES, stream) != hipSuccess) { fprintf(stderr, "kernel_launch: memset failed\n"); return; }
    Args a{};
    for (int i = 0; i < 25; ++i) a.in[i] = d_in[i];
    a.out = (float*)d_out; a.ws = (unsigned char*)d_ws;
    void* kargs[] = {&a};
    hipError_t e = hipLaunchCooperativeKernel((const void*)hybrid_fwd, dim3(grid), dim3(512), kargs, LDS_BYTES, stream);
    if (e != hipSuccess) fprintf(stderr, "cooperative launch failed: %s (grid %d)\n", hipGetErrorString(e), grid);
}
```

```cpp
#define EPI_RB 4
#include <hip/hip_runtime.h>
#include <hip/hip_cooperative_groups.h>
#include <cstdio>
#include <cstdint>
namespace cg = cooperative_groups;
namespace pg8 {
#define PG8_LAS __attribute__((address_space(3)))
typedef unsigned short bf16_t;
typedef short bf16x8 __attribute__((ext_vector_type(8)));
typedef float f32x4 __attribute__((ext_vector_type(4)));
typedef unsigned u32x4 __attribute__((ext_vector_type(4)));
constexpr int BM = 256, BK = 64, HALF = 128, HTB = HALF * BK * 2  , STAGE_BYTES = 8 * HTB, NXCD = 8, WGM = 8;

__host__ __device__ __forceinline__ int lds_byte(int r, int c) { const int st = (r >> 4) * 2 + (c >> 5), rr = r & 15, cc = c & 31, ob = rr * 64 + cc * 2; return st * 1024 + (ob ^ (((ob >> 9) & 1) << 5)); }
__host__ __device__ __forceinline__ void stage_rc(int b, int& R, int& C) { const int st = b / 1024, sb = b % 1024, swz = sb ^ (((sb >> 9) & 1) << 5); R = (st >> 1) * 16 + swz / 64; C = (st & 1) * 32 + (swz % 64) / 2; }
__host__ __device__ __forceinline__ int perm32(int rho) { const int n = rho >> 4, i = rho & 15; return 8 * (i >> 2) + 4 * n + (i & 3); }

struct Unit { int pm, pn; };
struct Gemm { const bf16_t* A; const bf16_t* Bt; int M, N, K; };

struct StaticOrder {
    int nM, nN, nwg, G, c, rev;
    __host__ __device__ void init(int M, int N, int G_, int c_, int rev_ = 0) { nM = M / BM; nN = N / BM; nwg = nM * nN; G = G_; c = c_; rev = (rev_ && nwg % G_ == 0) ? 1 : 0; }
    __host__ __device__ bool next(int i, Unit& u) const {
        if ((long)i * G + c >= nwg) return false;
        const long L = (long)(rev ? nwg / G - 1 - i : i) * G + c;
        int wgid = (int)L; { const int q = nwg / NXCD, r = nwg % NXCD, xcd = wgid % NXCD, off = wgid / NXCD; wgid = (xcd < r ? xcd * (q + 1) : r * (q + 1) + (xcd - r) * q) + off; }
        const int nig = WGM * nN, gid = wgid / nig, fm = gid * WGM, gsz = (nM - fm) < WGM ? (nM - fm) : WGM;
        u.pm = fm + ((wgid % nig) % gsz); u.pn = (wgid % nig) / gsz; return true;
    }
    __device__ __forceinline__ void a_ready(const Unit&) const {}
    __device__ __forceinline__ void done(const Unit&) const {}
};

__device__ __forceinline__ unsigned cvt_pk_bf16(float lo, float hi) { unsigned r; asm volatile("v_cvt_pk_bf16_f32 %0, %1, %2" : "=v"(r) : "v"(lo), "v"(hi)); return r; }
typedef float f32x2 __attribute__((ext_vector_type(2)));
__device__ __forceinline__ f32x2 gelu_pk(f32x2 v) {
    const f32x2 av = __builtin_elementwise_abs(v), d = av * 0.2316418882f + 1.0f;
    f32x2 t; t.x = __builtin_amdgcn_rcpf(d.x); t.y = __builtin_amdgcn_rcpf(d.y);
    f32x2 q = t * 0.5307027145f + (-0.7265760135f); q = q * t + 0.7107068705f; q = q * t + (-0.142248368f); q = q * t + 0.127414796f; q = q * t;
    const f32x2 s = (v * v) * (-0.72134752044f);
    f32x2 e; e.x = __builtin_amdgcn_exp2f(s.x); e.y = __builtin_amdgcn_exp2f(s.y);
    const f32x2 m = v * (q * e), r = v - m;
    f32x2 o; o.x = v.x < 0.f ? m.x : r.x; o.y = v.y < 0.f ? m.y : r.y; return o;
}

template <int ACT  > struct EpiBf16 {
    static constexpr bool PERM = true, AFTER_DRAIN = false; static_assert(ACT == 0 || ACT == 1, "EpiBf16: ACT is 0 (none) or 1 (gelu_pk)");
    bf16_t* O; int ldc; const float* bias; int split_cols; size_t split_stride; float scale0;
    __device__ __forceinline__ void operator()(const f32x4 (&acc)[2][2][4][2], const Unit& u, int wr, int wc, int fr, int fq) const {
        const int row0 = u.pm * BM + wr * 64 + fr; int colt = u.pn * BM; bf16_t* base = O;
        float sc = 1.f; if (split_cols) { const int t = colt / split_cols; base += (size_t)t * split_stride; colt -= t * split_cols; if (t == 0) sc = scale0; }
        const int col0 = colt + wc * 32 + 8 * fq, bcol0 = u.pn * BM + wc * 32 + 8 * fq;
        f32x4 bv[2][2];
#pragma unroll
        for (int bj = 0; bj < 2; ++bj)
#pragma unroll
            for (int n = 0; n < 2; ++n) bv[bj][n] = bias ? *(const f32x4*)(bias + bcol0 + bj * HALF + 4 * n) : (f32x4){0.f, 0.f, 0.f, 0.f};
#pragma unroll
        for (int ai = 0; ai < 2; ++ai)
#pragma unroll
            for (int m = 0; m < 4; ++m) { bf16_t* rowp = base + (size_t)(row0 + ai * HALF + m * 16) * ldc + col0;
#pragma unroll
                for (int bj = 0; bj < 2; ++bj) { f32x4 v0 = acc[ai][bj][m][0] + bv[bj][0], v1 = acc[ai][bj][m][1] + bv[bj][1];
                    if (ACT == 1) { f32x2 a = gelu_pk((f32x2){v0[0], v0[1]}), b = gelu_pk((f32x2){v0[2], v0[3]}), c = gelu_pk((f32x2){v1[0], v1[1]}), d = gelu_pk((f32x2){v1[2], v1[3]});
                        v0 = (f32x4){a.x, a.y, b.x, b.y}; v1 = (f32x4){c.x, c.y, d.x, d.y}; }
                    v0 = v0 * sc; v1 = v1 * sc; u32x4 w; w.x = cvt_pk_bf16(v0[0], v0[1]); w.y = cvt_pk_bf16(v0[2], v0[3]); w.z = cvt_pk_bf16(v1[0], v1[1]); w.w = cvt_pk_bf16(v1[2], v1[3]);
                    *(u32x4*)(rowp + bj * HALF) = w; } }
    }
};
template <class Epi, class Sched, bool ALIGN_EPI = false, bool SP2 = false>
__device__ __forceinline__ void gemm_phase(PG8_LAS unsigned char* lds, const Gemm g, const Sched& S, const Epi& E) {
    int tid_ = threadIdx.x; asm volatile("" : "+v"(tid_)); const int tid = tid_, wid = __builtin_amdgcn_readfirstlane(tid >> 6), lane = tid & 63, wr = wid >> 2, wc = wid & 3, fr = lane & 15, fq = lane >> 4;
    const int K = g.K, nt = K / BK;
    unsigned voffA[2], voffB[2];
#pragma unroll
    for (int i = 0; i < 2; ++i) { int R, C; stage_rc(tid * 16 + i * 8192, R, C); const int Rb = Epi::PERM ? ((R & ~31) + perm32(R & 31)) : R;
        voffA[i] = (unsigned)(R * K + C) * 2u; voffB[i] = (unsigned)(Rb * K + C) * 2u; }
    const size_t kstep = (size_t)(BK * 2);
    const size_t hstep = (size_t)HALF * K * 2;
    const size_t tstep = 2 * hstep;
    const unsigned ldsw = (unsigned)wid * 1024u;
    const int aoff = lds_byte(wr * 64 + fr, fq * 8), boff = lds_byte(wc * 32 + fr, fq * 8);
#define PG8_SA(b, h) (((b) * 2 + (h)) * HTB)
#define PG8_SB(b, h) ((4 + (b) * 2 + (h)) * HTB)
#define PG8_STAGE(bufoff, gbase, voff) do { _Pragma("unroll") for (int _i = 0; _i < 2; ++_i) \
        __builtin_amdgcn_global_load_lds((const unsigned*)((const char*)(gbase) + (voff)[_i]), (PG8_LAS unsigned*)(lds + (bufoff) + ldsw + _i * 8192), 16, 0, 0); } while (0)
#define PG8_LDA(dst, b, h) do { _Pragma("unroll") for (int m = 0; m < 4; ++m) _Pragma("unroll") for (int k = 0; k < 2; ++k) dst[m][k] = *(const PG8_LAS bf16x8*)(lds + PG8_SA(b, h) + aoff + m * 2048 + k * 1024); } while (0)
#define PG8_LDB(dst, b, h) do { _Pragma("unroll") for (int n = 0; n < 2; ++n) _Pragma("unroll") for (int k = 0; k < 2; ++k) dst[n][k] = *(const PG8_LAS bf16x8*)(lds + PG8_SB(b, h) + boff + n * 2048 + k * 1024); } while (0)
#define PG8_MMA(ai, bj, At, Bt) do { __builtin_amdgcn_s_setprio(1); _Pragma("unroll") for (int m = 0; m < 4; ++m) _Pragma("unroll") for (int n = 0; n < 2; ++n) _Pragma("unroll") for (int k = 0; k < 2; ++k) \
        acc[ai][bj][m][n] = __builtin_amdgcn_mfma_f32_16x16x32_bf16(Bt[n][k], At[m][k], acc[ai][bj][m][n], 0, 0, 0); __builtin_amdgcn_s_setprio(0); } while (0)
#define PG8_WAIT_V(n) asm volatile("s_waitcnt vmcnt(" #n ")" ::: "memory")
#define PG8_WAIT_L(n) asm volatile("s_waitcnt lgkmcnt(" #n ")" ::: "memory")
#define PG8_BAR __builtin_amdgcn_s_barrier()
#define PG8_SCHED __builtin_amdgcn_sched_barrier(0)
    Unit cur, nxt; int ui = 0;
    if (!S.next(0, cur)) return;
    f32x4 acc[2][2][4][2];
#pragma unroll
    for (int a = 0; a < 2; ++a)
#pragma unroll
        for (int b = 0; b < 2; ++b)
#pragma unroll
            for (int m = 0; m < 4; ++m)
#pragma unroll
                for (int n = 0; n < 2; ++n) acc[a][b][m][n] = (f32x4){0.f, 0.f, 0.f, 0.f};
    bf16x8 At[4][2], B0[2][2], B1[2][2];
    const char* cA = (const char*)g.A + (size_t)cur.pm * tstep; const char* cB = (const char*)g.Bt + (size_t)cur.pn * tstep;
    S.a_ready(cur);
    if constexpr (SP2) {
        PG8_STAGE(PG8_SB(0, 0), cB, voffB); PG8_STAGE(PG8_SB(0, 1), cB + hstep, voffB); PG8_STAGE(PG8_SA(0, 0), cA, voffA); PG8_STAGE(PG8_SA(0, 1), cA + hstep, voffA);
        if (wr == 1) PG8_BAR;
        PG8_WAIT_V(2); PG8_BAR;
        PG8_STAGE(PG8_SB(1, 0), cB + kstep, voffB); PG8_STAGE(PG8_SA(1, 0), cA + kstep, voffA); PG8_STAGE(PG8_SB(1, 1), cB + hstep + kstep, voffB);
        PG8_WAIT_V(6); PG8_BAR;
    } else {
        PG8_STAGE(PG8_SB(0, 0), cB, voffB); PG8_STAGE(PG8_SA(0, 0), cA, voffA); PG8_STAGE(PG8_SB(0, 1), cB + hstep, voffB); PG8_STAGE(PG8_SA(0, 1), cA + hstep, voffA);
        if (wr == 1) PG8_BAR;
        PG8_WAIT_V(4); PG8_BAR;
        PG8_STAGE(PG8_SB(1, 0), cB + kstep, voffB); PG8_STAGE(PG8_SA(1, 0), cA + kstep, voffA); PG8_STAGE(PG8_SB(1, 1), cB + hstep + kstep, voffB);
        PG8_WAIT_V(6); PG8_BAR;
    }
    for (;;) {
        const bool has_next = S.next(ui + 1, nxt);
        const char* nA = has_next ? (const char*)g.A + (size_t)nxt.pm * tstep : cA; const char* nB = has_next ? (const char*)g.Bt + (size_t)nxt.pn * tstep : cB;
        for (int t = 0; t < nt; t += 2) {
            const bool last = (t == nt - 2);
            const char* a1 = cA + (size_t)(t + 1) * kstep;
            const char* a2 = last ? nA : cA + (size_t)(t + 2) * kstep; const char* b2 = last ? nB : cB + (size_t)(t + 2) * kstep;
            const char* a3 = a2 + kstep; const char* b3 = b2 + kstep;
            if (last && has_next) S.a_ready(nxt);
            if constexpr (SP2) {
            PG8_LDB(B0, 0, 0); PG8_LDB(B1, 0, 1); PG8_SCHED; PG8_LDA(At, 0, 0); PG8_STAGE(PG8_SA(1, 1), a1 + hstep, voffA);
            PG8_WAIT_V(8); PG8_WAIT_L(0); PG8_BAR; PG8_MMA(0, 0, At, B0); PG8_MMA(0, 1, At, B1); PG8_BAR; PG8_SCHED;
            PG8_LDA(At, 0, 1); PG8_STAGE(PG8_SB(0, 0), b2, voffB); PG8_STAGE(PG8_SB(0, 1), b2 + hstep, voffB); PG8_STAGE(PG8_SA(0, 0), a2, voffA);
            PG8_WAIT_V(8); PG8_WAIT_L(0); PG8_BAR; PG8_MMA(1, 0, At, B0); PG8_MMA(1, 1, At, B1); PG8_BAR; PG8_SCHED;
            PG8_LDB(B0, 1, 0); PG8_LDB(B1, 1, 1); PG8_SCHED; PG8_LDA(At, 1, 0); PG8_STAGE(PG8_SA(0, 1), a2 + hstep, voffA);
            PG8_WAIT_V(8); PG8_WAIT_L(0); PG8_BAR; PG8_MMA(0, 0, At, B0); PG8_MMA(0, 1, At, B1); PG8_BAR; PG8_SCHED;
            PG8_LDA(At, 1, 1); PG8_STAGE(PG8_SB(1, 0), b3, voffB); PG8_STAGE(PG8_SB(1, 1), b3 + hstep, voffB); PG8_STAGE(PG8_SA(1, 0), a3, voffA);
            PG8_WAIT_V(8); PG8_WAIT_L(0); PG8_BAR; PG8_MMA(1, 0, At, B0); PG8_MMA(1, 1, At, B1); PG8_BAR; PG8_SCHED;
            } else {
            PG8_LDB(B0, 0, 0); PG8_SCHED; PG8_LDA(At, 0, 0); PG8_STAGE(PG8_SA(1, 1), a1 + hstep, voffA);
            PG8_WAIT_L(8); PG8_BAR; PG8_WAIT_L(0); PG8_MMA(0, 0, At, B0); PG8_BAR; PG8_SCHED;
            PG8_LDB(B1, 0, 1); PG8_STAGE(PG8_SB(0, 0), b2, voffB);
            PG8_BAR; PG8_WAIT_L(0); PG8_MMA(0, 1, At, B1); PG8_BAR;
            PG8_LDA(At, 0, 1); PG8_STAGE(PG8_SA(0, 0), a2, voffA);
            PG8_BAR; PG8_WAIT_L(0); PG8_MMA(1, 0, At, B0); PG8_BAR; PG8_SCHED;
            PG8_STAGE(PG8_SB(0, 1), b2 + hstep, voffB);
            PG8_WAIT_V(6); PG8_BAR; PG8_MMA(1, 1, At, B1); PG8_BAR;
            PG8_LDB(B0, 1, 0); PG8_SCHED; PG8_LDA(At, 1, 0); PG8_STAGE(PG8_SA(0, 1), a2 + hstep, voffA);
            PG8_WAIT_L(8); PG8_BAR; PG8_WAIT_L(0); PG8_MMA(0, 0, At, B0); PG8_BAR; PG8_SCHED;
            PG8_LDB(B1, 1, 1); PG8_STAGE(PG8_SB(1, 0), b3, voffB);
            PG8_BAR; PG8_WAIT_L(0); PG8_MMA(0, 1, At, B1); PG8_BAR;
            PG8_LDA(At, 1, 1); PG8_STAGE(PG8_SA(1, 0), a3, voffA);
            PG8_BAR; PG8_WAIT_L(0); PG8_MMA(1, 0, At, B0); PG8_BAR; PG8_SCHED;
            PG8_STAGE(PG8_SB(1, 1), b3 + hstep, voffB);
            PG8_WAIT_V(6); PG8_BAR; PG8_MMA(1, 1, At, B1); PG8_BAR;
            }
        }
        if constexpr (ALIGN_EPI) { if (wr == 0) PG8_BAR; }
        if constexpr (!Epi::AFTER_DRAIN) { E(acc, cur, wr, wc, fr, fq); S.done(cur); }
        if (!has_next) break;
#pragma unroll
        for (int a = 0; a < 2; ++a)
#pragma unroll
            for (int b = 0; b < 2; ++b)
#pragma unroll
                for (int m = 0; m < 4; ++m)
#pragma unroll
                    for (int n = 0; n < 2; ++n) acc[a][b][m][n] = (f32x4){0.f, 0.f, 0.f, 0.f};
        cur = nxt; cA = nA; cB = nB; ++ui;
        if constexpr (ALIGN_EPI) { if (wr == 1) PG8_BAR; }
    }
    PG8_WAIT_V(0);
    if constexpr (!ALIGN_EPI) { if (wr == 0) PG8_BAR; }
    PG8_BAR;
    if constexpr (Epi::AFTER_DRAIN) { E.fused(acc, cur, wr, wc, fr, fq, lds, wid, lane); S.done(cur); }
#undef PG8_SA
#undef PG8_SB
#undef PG8_STAGE
#undef PG8_LDA
#undef PG8_LDB
#undef PG8_MMA
#undef PG8_WAIT_V
#undef PG8_WAIT_L
#undef PG8_BAR
#undef PG8_SCHED
}
}

constexpr int BATCH = 8, SEQ = 8192, DM = 1024, DEPTH = 4, GWID = 256, NHEAD = 4, HDIM = 64, INW = 2816, CHUNK = 128, DFF = 2816;
constexpr int M = BATCH * SEQ;
constexpr int NCH = SEQ / CHUNK;
constexpr int NCHUNK = M / CHUNK;
constexpr float LN_EPS = 1e-5f;
constexpr float DN_ALPHA = 1.6817928305074290f;
constexpr int ZC_AU = 0, ZC_AV = 256, ZC_RQ = 512, ZC_RK = 768, ZC_RV = 1024, ZC_RG = 1280, ZC_CX = 1536, ZC_CG = 1792, ZC_DB = 2048, ZC_DC = 2304, ZC_DH = 2560;

#define LAS __attribute__((address_space(3)))
typedef unsigned short bf16;
typedef short bf16x8 __attribute__((ext_vector_type(8)));
typedef float f32x4 __attribute__((ext_vector_type(4)));
typedef unsigned u32x4 __attribute__((ext_vector_type(4)));
typedef unsigned u32x2 __attribute__((ext_vector_type(2)));

constexpr size_t SZ_WIN = (size_t)INW * DM * 2, SZ_WOUT = (size_t)DM * DM * 2, SZ_WGU = (size_t)2 * DFF * DM * 2, SZ_WD = (size_t)DM * DFF * 2, SZ_LRUW = (size_t)16 * 4096 * 2;
constexpr size_t OFF_WIN = 0;
constexpr size_t OFF_WOUT = OFF_WIN + DEPTH * SZ_WIN;
constexpr size_t OFF_WGU = OFF_WOUT + DEPTH * SZ_WOUT;
constexpr size_t OFF_WD = OFF_WGU + DEPTH * SZ_WGU;
constexpr size_t OFF_LRUW = OFF_WD + DEPTH * SZ_WD;
constexpr size_t OFF_XB = OFF_LRUW + DEPTH * SZ_LRUW;
constexpr size_t OFF_Z = OFF_XB + (size_t)M * DM * 2;
constexpr size_t OFF_Y = OFF_Z + (size_t)M * INW * 2;
constexpr size_t OFF_UF = OFF_Y + (size_t)M * DM * 2;
constexpr size_t USTRIDE = (size_t)BATCH * NHEAD * 4096;
constexpr size_t OFF_UB = OFF_UF + (size_t)NCH * USTRIDE * 2;
constexpr size_t OFF_CA = OFF_UB + (size_t)NCH * USTRIDE * 2;
constexpr size_t OFF_CH = OFF_CA + (size_t)BATCH * NCH * 512 * 4;
constexpr size_t OFF_SP = OFF_CH + (size_t)BATCH * NCH * 512 * 4;
constexpr size_t OFF_S1 = OFF_SP + (size_t)3 * DEPTH * 2 * GWID * 4;
constexpr size_t OFF_T1 = OFF_S1 + (size_t)DEPTH * INW * 4;
constexpr size_t OFF_S3 = OFF_T1 + (size_t)DEPTH * INW * 4;
constexpr size_t OFF_T3 = OFF_S3 + (size_t)DEPTH * 2 * DFF * 4;
constexpr size_t OFF_WSB = OFF_T3 + (size_t)DEPTH * 2 * DFF * 4;
constexpr size_t OFF_P0 = OFF_WSB + (size_t)DEPTH * NHEAD * CHUNK * CHUNK * 2;
constexpr size_t OFF_P1 = OFF_P0 + (size_t)M * 2 * 8;
constexpr size_t OFF_CTL = OFF_P1 + (size_t)M * 2 * 8;
constexpr size_t CTL_BYTES = 16384;
constexpr size_t WS_END = OFF_CTL + CTL_BYTES;
constexpr int LDS_MISC_OFF = 131072, LDS_GB_OFF = 131072 + 256, LDS_BYTES = 131072 + 256 + 8192;

__device__ __forceinline__ float bflo(unsigned w) { return __uint_as_float(w << 16); }
__device__ __forceinline__ float bfhi(unsigned w) { return __uint_as_float(w & 0xffff0000u); }
__device__ __forceinline__ void unpack8(const u32x4 w, float* f) { f[0] = bflo(w.x); f[1] = bfhi(w.x); f[2] = bflo(w.y); f[3] = bfhi(w.y); f[4] = bflo(w.z); f[5] = bfhi(w.z); f[6] = bflo(w.w); f[7] = bfhi(w.w); }
__device__ __forceinline__ void unpack4(const u32x2 w, float* f) { f[0] = bflo(w.x); f[1] = bfhi(w.x); f[2] = bflo(w.y); f[3] = bfhi(w.y); }
__device__ __forceinline__ unsigned pk2(float lo, float hi) { return pg8::cvt_pk_bf16(lo, hi); }
__device__ __forceinline__ bf16 f2bf(float x) { return (bf16)(pg8::cvt_pk_bf16(x, 0.f) & 0xffffu); }
__device__ __forceinline__ u32x4 pack8(const float* f) { u32x4 w; w.x = pk2(f[0], f[1]); w.y = pk2(f[2], f[3]); w.z = pk2(f[4], f[5]); w.w = pk2(f[6], f[7]); return w; }
__device__ __forceinline__ float sigmoid_f(float x) { return __builtin_amdgcn_rcpf(1.0f + __expf(-x)); }
__device__ __forceinline__ float silu_f(float x) { return x * sigmoid_f(x); }
__device__ __forceinline__ float gelu_f(float x) { return x * sigmoid_f(1.5957691216057308f * (x + 0.044715f * x * x * x)); }
__device__ __forceinline__ float log_gamma_h(int h) { return h == 0 ? -0.0317486983145803f : (h == 1 ? -0.015748356968139168f : (h == 2 ? -0.007843177461025893f : -0.003913899321136329f)); }
__device__ __forceinline__ void rope_cs(float pos, int i, float& c, float& s) {
    const float invf = exp2f(-(float)i * 0.4152410118609203f);
    const float ang = pos * invf;
    const float n = rintf(ang * 0.15915494309189535f);
    float r = fmaf(-n, 6.2831854820251465f, ang); r = fmaf(-n, -1.7484555e-7f, r);
    const float rv = r * 0.15915494309189535f;
    s = __builtin_amdgcn_sinf(rv); c = __builtin_amdgcn_cosf(rv);
}
__device__ __forceinline__ float neg_expm1_f(float x) {
    const float p = -x * (1.0f + x * (0.5f + x * (0.16666667f + x * (0.041666668f + x * 0.0083333338f))));
    return x > -0.25f ? p : 1.0f - __expf(x);
}
#define MFMA16(a, b, c) __builtin_amdgcn_mfma_f32_16x16x32_bf16((a), (b), (c), 0, 0, 0)
template <int CTRL> __device__ __forceinline__ float dpp_f(float oldv, float src) { return __int_as_float(__builtin_amdgcn_update_dpp(__float_as_int(oldv), __float_as_int(src), CTRL, 0xf, 0xf, false)); }

#ifndef EPI_RB
#define EPI_RB 4
#endif
typedef long long i64x2 __attribute__((ext_vector_type(2)));
__device__ __forceinline__ float fx2f(long long v) { return (float)(int)(v >> 32) + (float)(unsigned)v * 2.3283064365386963e-10f; }
__device__ __forceinline__ void row_stats_fin(const i64x2 v, float& mu, float& rs) { mu = fx2f(v.x) * (1.f / DM); const float var = fmaxf(fx2f(v.y) * (1.f / DM) - mu * mu, 0.f); rs = __builtin_amdgcn_rsqf(var + LN_EPS); }
__device__ __forceinline__ void row_stats8(const long long* P, int row0, float (&mu8)[8], float (&rs8)[8]) {
    i64x2 raw[8];
#pragma unroll
    for (int q = 0; q < 8; ++q) raw[q] = *(const i64x2*)(P + 2 * (size_t)(row0 + (q >> 2) * 128 + (q & 3) * 16));
    asm volatile("" ::: "memory");
#pragma unroll
    for (int q = 0; q < 8; ++q) row_stats_fin(raw[q], mu8[q], rs8[q]);
}
__device__ __forceinline__ void row_stats(const long long* P, int row, float& mu, float& rs) {
    const i64x2 v = *(const i64x2*)(P + 2 * (size_t)row); mu = fx2f(v.x) * (1.f / DM); const float var = fmaxf(fx2f(v.y) * (1.f / DM) - mu * mu, 0.f); rs = __builtin_amdgcn_rsqf(var + LN_EPS);
}
struct EpiLnBf16 {
    static constexpr bool PERM = true, AFTER_DRAIN = false;
    bf16* O; int ldc; const long long* P; const float* S; const float* T; int fold;
    __device__ __forceinline__ void operator()(const pg8::f32x4 (&acc)[2][2][4][2], const pg8::Unit& u, int wr, int wc, int fr, int fq) const {
        const int row0 = u.pm * 256 + wr * 64 + fr, col0 = u.pn * 256 + wc * 32 + 8 * fq;
        f32x4 sv[2][2], tv[2][2];
#pragma unroll
        for (int bj = 0; bj < 2; ++bj)
#pragma unroll
            for (int n = 0; n < 2; ++n) { sv[bj][n] = fold ? *(const f32x4*)(S + col0 + bj * 128 + 4 * n) : (f32x4){0.f, 0.f, 0.f, 0.f}; tv[bj][n] = fold ? *(const f32x4*)(T + col0 + bj * 128 + 4 * n) : (f32x4){0.f, 0.f, 0.f, 0.f}; }
        float mu8[8], rs8[8];
#pragma unroll
        for (int q = 0; q < 8; ++q) { mu8[q] = 0.f; rs8[q] = 1.f; }
        if (fold) row_stats8(P, row0, mu8, rs8);
#pragma unroll
        for (int ai = 0; ai < 2; ++ai)
#pragma unroll
            for (int m = 0; m < 4; ++m) { const int row = row0 + ai * 128 + m * 16; const float mu = mu8[ai * 4 + m], rs = rs8[ai * 4 + m];
                bf16* rowp = O + (size_t)row * ldc + col0;
#pragma unroll
                for (int bj = 0; bj < 2; ++bj) { const f32x4 v0 = (acc[ai][bj][m][0] - sv[bj][0] * mu) * rs + tv[bj][0], v1 = (acc[ai][bj][m][1] - sv[bj][1] * mu) * rs + tv[bj][1];
                    u32x4 w; w.x = pk2(v0[0], v0[1]); w.y = pk2(v0[2], v0[3]); w.z = pk2(v1[0], v1[1]); w.w = pk2(v1[2], v1[3]);
                    *(u32x4*)(rowp + bj * 128) = w; } }
    }
};
struct EpiSwiGLU {
    static constexpr bool PERM = true, AFTER_DRAIN = false;
    bf16* O; const long long* P; const float* S; const float* T;
    __device__ __forceinline__ void operator()(const pg8::f32x4 (&acc)[2][2][4][2], const pg8::Unit& u, int wr, int wc, int fr, int fq) const {
        const int row0 = u.pm * 256 + wr * 64 + fr, col0 = u.pn * 128 + wc * 32 + 8 * fq, gcol0 = u.pn * 256 + wc * 32 + 8 * fq;
        f32x4 sv[2][2], tv[2][2];
#pragma unroll
        for (int bj = 0; bj < 2; ++bj)
#pragma unroll
            for (int n = 0; n < 2; ++n) { sv[bj][n] = *(const f32x4*)(S + gcol0 + bj * 128 + 4 * n); tv[bj][n] = *(const f32x4*)(T + gcol0 + bj * 128 + 4 * n); }
        float mu8[8], rs8[8];
        row_stats8(P, row0, mu8, rs8);
#pragma unroll
        for (int ai = 0; ai < 2; ++ai)
#pragma unroll
            for (int m = 0; m < 4; ++m) { const int row = row0 + ai * 128 + m * 16; const float mu = mu8[ai * 4 + m], rs = rs8[ai * 4 + m];
                bf16* rowp = O + (size_t)row * DFF + col0;
                const f32x4 g0 = (acc[ai][0][m][0] - sv[0][0] * mu) * rs + tv[0][0], g1 = (acc[ai][0][m][1] - sv[0][1] * mu) * rs + tv[0][1];
                const f32x4 u0 = (acc[ai][1][m][0] - sv[1][0] * mu) * rs + tv[1][0], u1 = (acc[ai][1][m][1] - sv[1][1] * mu) * rs + tv[1][1];
#define SWG(gv, uv, j) ((gv[j] * uv[j]) * __builtin_amdgcn_rcpf(1.0f + __builtin_amdgcn_exp2f(gv[j])))
                u32x4 w; w.x = pk2(SWG(g0, u0, 0), SWG(g0, u0, 1)); w.y = pk2(SWG(g0, u0, 2), SWG(g0, u0, 3));
                w.z = pk2(SWG(g1, u1, 0), SWG(g1, u1, 1)); w.w = pk2(SWG(g1, u1, 2), SWG(g1, u1, 3));
#undef SWG
                *(u32x4*)rowp = w; }
    }
};
struct EpiResLn {
    static constexpr bool PERM = true, AFTER_DRAIN = false;
    const float* resf; float* outf; const bf16* xb; bf16* xbo; const long long* Pin; const LAS float* gb; long long* Pout; int raw; int wf32; float alpha;
    __device__ __forceinline__ void operator()(const pg8::f32x4 (&acc)[2][2][4][2], const pg8::Unit& u, int wr, int wc, int fr, int fq) const {
        const int row0 = u.pm * 256 + wr * 64 + fr, col0 = u.pn * 256 + wc * 32 + 8 * fq;
#pragma unroll
        for (int gq = 0; gq < 8 / EPI_RB; ++gq) {
            u32x4 sw[EPI_RB][2]; float mu[EPI_RB], rs[EPI_RB];
#pragma unroll
            for (int mm = 0; mm < EPI_RB; ++mm) { const int q = gq * EPI_RB + mm, row = row0 + (q >> 2) * 128 + (q & 3) * 16;
                mu[mm] = 0.f; rs[mm] = 1.f;
                if (!raw) { row_stats(Pin, row, mu[mm], rs[mm]);
#pragma unroll
                    for (int bj = 0; bj < 2; ++bj) sw[mm][bj] = *(const u32x4*)(xb + (size_t)row * DM + col0 + bj * 128); } }
#pragma unroll
            for (int mm = 0; mm < EPI_RB; ++mm) { const int q = gq * EPI_RB + mm, ai = q >> 2, m = q & 3; const int row = row0 + ai * 128 + m * 16; const size_t off = (size_t)row * DM + col0;
                float sm = 0.f, sq = 0.f;
#pragma unroll
                for (int bj = 0; bj < 2; ++bj) { f32x4 v[2];
#pragma unroll
                    for (int n = 0; n < 2; ++n) { f32x4 r;
                        if (raw) r = *(const f32x4*)(resf + off + bj * 128 + 4 * n);
                        else { const u32x4 w = sw[mm][bj]; r = n ? (f32x4){bflo(w.z), bfhi(w.z), bflo(w.w), bfhi(w.w)} : (f32x4){bflo(w.x), bfhi(w.x), bflo(w.y), bfhi(w.y)}; }
                        const f32x4 gvv = *(const LAS f32x4*)(gb + col0 + bj * 128 + 4 * n), bvv = *(const LAS f32x4*)(gb + DM + col0 + bj * 128 + 4 * n);
                        const f32x4 rr = (r - mu[mm]) * rs[mm] * gvv + bvv;
                        v[n] = rr * alpha + acc[ai][bj][m][n];
                        if (wf32) *(f32x4*)(outf + off + bj * 128 + 4 * n) = v[n];
                        sm += (v[n][0] + v[n][1]) + (v[n][2] + v[n][3]); sq += (v[n][0] * v[n][0] + v[n][1] * v[n][1]) + (v[n][2] * v[n][2] + v[n][3] * v[n][3]); }
                    u32x4 w; w.x = pk2(v[0][0], v[0][1]); w.y = pk2(v[0][2], v[0][3]); w.z = pk2(v[1][0], v[1][1]); w.w = pk2(v[1][2], v[1][3]);
                    if (!wf32) *(u32x4*)(xbo + off + bj * 128) = w; }
                sm += __shfl_xor(sm, 16); sm += __shfl_xor(sm, 32); sq += __shfl_xor(sq, 16); sq += __shfl_xor(sq, 32);
                if (fq == 0) { __hip_atomic_fetch_add(Pout + 2 * (size_t)row, (long long)(sm * 4294967296.0f), __ATOMIC_RELAXED, __HIP_MEMORY_SCOPE_AGENT); __hip_atomic_fetch_add(Pout + 2 * (size_t)row + 1, (long long)(sq * 4294967296.0f), __ATOMIC_RELAXED, __HIP_MEMORY_SCOPE_AGENT); } }
            asm volatile("" ::: "memory");
        }
    }
};
__device__ __forceinline__ void stage_gain_bias(LAS float* gb, const float* g, const float* b, int raw) {
    int tid_ = threadIdx.x; asm volatile("" : "+v"(tid_));
    const int i = tid_ & 255; const bool isb = tid_ >= 256;
    f32x4 v = raw ? (isb ? (f32x4){0.f, 0.f, 0.f, 0.f} : (f32x4){1.f, 1.f, 1.f, 1.f}) : *((const f32x4*)(isb ? b : g) + i);
    *((LAS f32x4*)(gb + (isb ? DM : 0)) + i) = v;
    __syncthreads();
}

struct Args { const void* in[25]; float* out; unsigned char* ws; };
struct Ctx {
    const float* x; const int* pos; const float* w_in; const float* gmlp_ln_g; const float* gmlp_ln_b; const float* gmlp_ws; const float* gmlp_bs; const float* ret_gn_g; const float* ret_gn_b;
    const float* lru_conv_w; const float* lru_conv_b; const float* lru_wa; const float* lru_ba; const float* lru_wx; const float* lru_bx; const float* lru_lambda; const float* sc_conv_w;
    const float* w_out; const float* ln1_g; const float* ln1_b; const float* ffn_wg; const float* ffn_wu; const float* ffn_wd; const float* ln2_g; const float* ln2_b;
    float* out; bf16 *WIN, *WOUT, *WGU, *WD, *LRUW, *XB, *Z, *Y, *UF, *UB; float *CA, *CH, *SP, *BA2, *BX2, *S1, *T1, *S3, *T3; long long *P0, *P1; bf16* WSB;
};

__device__ __forceinline__ void tr_item(const float* W, int N, bf16* dst_rows, int ldt, int k0, int n0, LAS float* scr, int lane, const float* gs = nullptr, float sc = 1.0f) {
#pragma unroll 16
    for (int i = 0; i < 32; ++i) { const int kk = 2 * i + (lane >> 5); scr[kk * 33 + (lane & 31)] = W[(size_t)(k0 + kk) * N + n0 + (lane & 31)] * (gs ? gs[k0 + kk] * sc : sc); }
    asm volatile("s_waitcnt lgkmcnt(0)" ::: "memory");
    const int c = lane & 7;
#pragma unroll
    for (int j = 0; j < 4; ++j) { const int n = (lane >> 3) + 8 * j; const LAS float* s = scr + (8 * c) * 33 + n;
        u32x4 o; o.x = pk2(s[0 * 33], s[1 * 33]); o.y = pk2(s[2 * 33], s[3 * 33]); o.z = pk2(s[4 * 33], s[5 * 33]); o.w = pk2(s[6 * 33], s[7 * 33]);
        *(u32x4*)(dst_rows + (size_t)n * ldt + k0 + 8 * c) = o; }
    asm volatile("s_waitcnt lgkmcnt(0)" ::: "memory");
}
__device__ __forceinline__ void prologue(const Ctx& C, LAS unsigned char* lds) {
    int tid_ = threadIdx.x; asm volatile("" : "+v"(tid_)); const int tid = tid_, lane = tid & 63, wave = tid >> 6;
    LAS float* scr = (LAS float*)(lds + wave * 16384);
    const int gw = blockIdx.x * 8 + wave, NGW = gridDim.x * 8;
    constexpr int I_IN = (DM / 64) * (INW / 32), I_OUT = (DM / 64) * (DM / 32), I_G = (DM / 64) * (DFF / 32), I_D = (DFF / 64) * (DM / 32), I_L = 8 * 2;
    constexpr int PER_LAYER = I_IN + I_OUT + 2 * I_G + I_D + 2 * I_L;
    for (int it = gw; it < DEPTH * PER_LAYER; it += NGW) {
        const int l = it / PER_LAYER; int r = it % PER_LAYER;
        if (r < I_IN) { const int nb = INW / 32, k0 = 64 * (r / nb), n0 = 32 * (r % nb); tr_item(C.w_in + (size_t)l * DM * INW, INW, C.WIN + (size_t)l * INW * DM + (size_t)n0 * DM, DM, k0, n0, scr, lane, l ? C.ln2_g + (l - 1) * DM : nullptr); continue; } r -= I_IN;
        if (r < I_OUT) { const int nb = DM / 32, k0 = 64 * (r / nb), n0 = 32 * (r % nb); tr_item(C.w_out + (size_t)l * DM * DM, DM, C.WOUT + (size_t)l * DM * DM + (size_t)n0 * DM, DM, k0, n0, scr, lane); continue; } r -= I_OUT;
        if (r < 2 * I_G) { const int up = r >= I_G; if (up) r -= I_G; const int nb = DFF / 32, k0 = 64 * (r / nb), n0 = 32 * (r % nb); const int drow = 256 * (n0 / 128) + (n0 % 128) + (up ? 128 : 0);
            tr_item((up ? C.ffn_wu : C.ffn_wg) + (size_t)l * DM * DFF, DFF, C.WGU + (size_t)l * 2 * DFF * DM + (size_t)drow * DM, DM, k0, n0, scr, lane, C.ln1_g + l * DM, up ? -0.6931471805599453f : -1.4426950408889634f); continue; } r -= 2 * I_G;
        if (r < I_D) { const int nb = DM / 32, k0 = 64 * (r / nb), n0 = 32 * (r % nb); tr_item(C.ffn_wd + (size_t)l * DFF * DM, DM, C.WD + (size_t)l * DM * DFF + (size_t)n0 * DFF, DFF, k0, n0, scr, lane); continue; } r -= I_D;
        { const int which = r >= I_L; if (which) r -= I_L; const int mat = r >> 1, n0 = 32 * (r & 1);
          tr_item((which ? C.lru_wx : C.lru_wa) + ((size_t)l * 8 + mat) * 4096, 64, C.LRUW + (((size_t)l * 2 + which) * 8 + mat) * 4096 + (size_t)n0 * 64, 64, 0, n0, scr, lane, nullptr, -1.4426950408889634f); }
    }
    __syncthreads();
    {
        LAS float* red = (LAS float*)lds;
#pragma unroll 1
        for (int task = blockIdx.x; task < DEPTH * 66; task += gridDim.x) {
            const int l = task / 66, r = task % 66, kind = r / 22, cb = r % 22;
            if (kind == 0 && l == 0) continue;
            const float *pw0 = C.w_in, *pw1 = C.ffn_wg, *pw2 = C.ffn_wu, *pg0 = C.ln2_g, *pg1 = C.ln1_g, *pb0 = C.ln2_b, *pb1 = C.ln1_b;
            asm volatile("" : "+s"(pw0), "+s"(pw1), "+s"(pw2), "+s"(pg0), "+s"(pg1), "+s"(pb0), "+s"(pb1));
            const float* W = (kind == 0 ? pw0 : (kind == 1 ? pw1 : pw2)) + (size_t)l * DM * INW;
            const float* gk = kind == 0 ? pg0 + (l - 1) * DM : pg1 + l * DM; const float* bk = kind == 0 ? pb0 + (l - 1) * DM : pb1 + l * DM;
            const int col = cb * 128 + (tid & 127), slice = tid >> 7;
            const float wsc = kind == 0 ? 1.0f : (kind == 1 ? -1.4426950408889634f : -0.6931471805599453f);
            float sa = 0.f, ta = 0.f;
#pragma unroll 16
            for (int k = slice * 256; k < slice * 256 + 256; ++k) { const float wv = W[(size_t)k * INW + col] * wsc; sa += bflo(pk2(gk[k] * wv, 0.f)); ta += bk[k] * wv; }
            red[tid * 2] = sa; red[tid * 2 + 1] = ta;
            __syncthreads();
            if (tid < 128) { const float ss = (red[tid * 2] + red[(tid + 128) * 2]) + (red[(tid + 256) * 2] + red[(tid + 384) * 2]);
                const float tt = (red[tid * 2 + 1] + red[(tid + 128) * 2 + 1]) + (red[(tid + 256) * 2 + 1] + red[(tid + 384) * 2 + 1]);
                if (kind == 0) { C.S1[l * INW + cb * 128 + tid] = ss; C.T1[l * INW + cb * 128 + tid] = tt; }
                else { const int d = l * 2 * DFF + 256 * cb + (kind == 2 ? 128 : 0) + tid; C.S3[d] = ss; C.T3[d] = tt; } }
            __syncthreads();
        }
    }
    if (blockIdx.x * 512 + tid < DEPTH * 2 * GWID) { const int i = blockIdx.x * 512 + tid;
        C.SP[i] = -8.0f * 1.4426950408889634f * log1pf(expf(-C.lru_lambda[i])); C.BA2[i] = -1.4426950408889634f * C.lru_ba[i]; C.BX2[i] = -1.4426950408889634f * C.lru_bx[i]; }
    for (size_t i = (size_t)blockIdx.x * 512 + tid; i < (size_t)DEPTH * NHEAD * CHUNK * CHUNK / 8; i += (size_t)gridDim.x * 512) { const f32x4 a = *(const f32x4*)(C.gmlp_ws + i * 8), b4 = *(const f32x4*)(C.gmlp_ws + i * 8 + 4);
        u32x4 o; o.x = pk2(a[0], a[1]); o.y = pk2(a[2], a[3]); o.z = pk2(b4[0], b4[1]); o.w = pk2(b4[2], b4[3]); *(u32x4*)(C.WSB + i * 8) = o; }
    const size_t gt = (size_t)blockIdx.x * 512 + tid, NT = (size_t)gridDim.x * 512;
#pragma unroll 4
    for (size_t i = gt; i < (size_t)M * DM / 8; i += NT) { const f32x4 a = *(const f32x4*)(C.x + i * 8), b = *(const f32x4*)(C.x + i * 8 + 4);
        u32x4 o; o.x = pk2(a[0], a[1]); o.y = pk2(a[2], a[3]); o.z = pk2(b[0], b[1]); o.w = pk2(b[2], b[3]); *(u32x4*)(C.XB + i * 8) = o; }
}

__device__ __forceinline__ float wave_sum(float v) {
#pragma unroll
    for (int o = 1; o < 64; o <<= 1) v += __shfl_xor(v, o);
    return v;
}
__device__ __forceinline__ void final_ln(float* X, const long long* P, const float* g, const float* b) {
    int tid_ = threadIdx.x; asm volatile("" : "+v"(tid_)); const int lane = tid_ & 63, wave = tid_ >> 6;
    const int gw = blockIdx.x * 8 + wave, NGW = gridDim.x * 8;
    f32x4 gv[4], bv[4];
#pragma unroll
    for (int j = 0; j < 4; ++j) { gv[j] = *((const f32x4*)g + lane + 64 * j); bv[j] = *((const f32x4*)b + lane + 64 * j); }
    for (int m = gw; m < M; m += 4 * NGW) {
        f32x4 v[4][4]; i64x2 pr[4];
#pragma unroll
        for (int r = 0; r < 4; ++r) { const int mr = m + r * NGW; pr[r] = *(const i64x2*)(P + 2 * (size_t)mr); const f32x4* xr = (const f32x4*)(X + (size_t)mr * DM) + lane;
#pragma unroll
            for (int j = 0; j < 4; ++j) v[r][j] = xr[64 * j]; }
        asm volatile("" ::: "memory");
#pragma unroll
        for (int r = 0; r < 4; ++r) { const int mr = m + r * NGW; float mu, rs; row_stats_fin(pr[r], mu, rs); f32x4* xr = (f32x4*)(X + (size_t)mr * DM) + lane;
#pragma unroll
            for (int j = 0; j < 4; ++j) xr[64 * j] = (v[r][j] - mu) * rs * gv[j] + bv[j]; }
    }
}
__device__ __forceinline__ void zero_rows(long long* P) {
    int tid_ = threadIdx.x; asm volatile("" : "+v"(tid_));
    for (int i = blockIdx.x * 512 + tid_; i < M * 2 * 8 / 16; i += gridDim.x * 512) *((f32x4*)P + i) = (f32x4){0.f, 0.f, 0.f, 0.f};
    asm volatile("s_waitcnt vmcnt(0)" ::: "memory");
}

__device__ __forceinline__ void gmlp_chunk(const Ctx& C, int l, int chunk, LAS unsigned char* lds) {
    int tid_ = threadIdx.x; asm volatile("" : "+v"(tid_)); const int tid = tid_, lane = tid & 63, w = tid >> 6, fr = lane & 15, fq = lane >> 4;
    LAS bf16* vnT = (LAS bf16*)lds;
    const int row0 = chunk * CHUNK;
    {
        const int t = tid >> 2, q4 = tid & 3;
        const bf16* src = C.Z + (size_t)(row0 + t) * INW + ZC_AV + 64 * q4;
        float v[64]; float s = 0.f;
#pragma unroll
        for (int i = 0; i < 8; ++i) { const u32x4 wv = *(const u32x4*)(src + 8 * i); float f[8]; unpack8(wv, f);
#pragma unroll
            for (int j = 0; j < 8; ++j) { v[8 * i + j] = gelu_f(f[j]); s += v[8 * i + j]; } }
        s += __shfl_xor(s, 1); s += __shfl_xor(s, 2);
        const float mean = s * (1.f / 256.f); float q = 0.f;
#pragma unroll
        for (int i = 0; i < 64; ++i) { v[i] -= mean; q += v[i] * v[i]; }
        q += __shfl_xor(q, 1); q += __shfl_xor(q, 2);
        const float rstd = 1.f / sqrtf(q * (1.f / 256.f) + LN_EPS);
        const f32x4* g4 = (const f32x4*)(C.gmlp_ln_g + l * GWID + 64 * q4); const f32x4* b4 = (const f32x4*)(C.gmlp_ln_b + l * GWID + 64 * q4);
        f32x4 gg[16], bv[16];
#pragma unroll
        for (int i4 = 0; i4 < 16; ++i4) { gg[i4] = g4[i4]; bv[i4] = b4[i4]; }
        const int tt = t ^ (16 * q4);
#pragma unroll
        for (int i4 = 0; i4 < 16; ++i4) {
            const unsigned w0 = pk2(v[4 * i4] * rstd * gg[i4][0] + bv[i4][0], v[4 * i4 + 1] * rstd * gg[i4][1] + bv[i4][1]), w1 = pk2(v[4 * i4 + 2] * rstd * gg[i4][2] + bv[i4][2], v[4 * i4 + 3] * rstd * gg[i4][3] + bv[i4][3]);
            LAS bf16* dst = vnT + (64 * q4 + 4 * i4) * 136 + tt;
            dst[0] = (bf16)(w0 & 0xffffu); dst[136] = (bf16)(w0 >> 16); dst[2 * 136] = (bf16)(w1 & 0xffffu); dst[3 * 136] = (bf16)(w1 >> 16); }
    }
    __syncthreads();
    {
        const int p = 16 * w + fr;
        u32x2 uw[NHEAD][4];
#pragma unroll
        for (int h = 0; h < NHEAD; ++h)
#pragma unroll
            for (int nt = 0; nt < 4; ++nt) uw[h][nt] = *(const u32x2*)(C.Z + (size_t)(row0 + p) * INW + ZC_AU + 64 * h + 16 * nt + 4 * fq);
#pragma unroll
        for (int h = 0; h < NHEAD; ++h) {
            f32x4 acc[4];
#pragma unroll
            for (int nt = 0; nt < 4; ++nt) acc[nt] = (f32x4){0.f, 0.f, 0.f, 0.f};
            const bf16* wsrow = C.WSB + ((size_t)(l * NHEAD + h) * CHUNK + p) * CHUNK;
            bf16x8 af[4];
#pragma unroll
            for (int ks = 0; ks < 4; ++ks) af[ks] = *(const bf16x8*)(wsrow + 32 * ks + 8 * fq);
#pragma unroll
            for (int ks = 0; ks < 4; ++ks)
#pragma unroll
                for (int nt = 0; nt < 4; ++nt) { const bf16x8 bfg = *(const LAS bf16x8*)(vnT + (64 * h + 16 * nt + fr) * 136 + 8 * ((4 * ks + fq) ^ (2 * h))); acc[nt] = MFMA16(bfg, af[ks], acc[nt]); }
            const float bias = C.gmlp_bs[(l * NHEAD + h) * CHUNK + p];
#pragma unroll
            for (int nt = 0; nt < 4; ++nt) { const int c = 64 * h + 16 * nt + 4 * fq;
                float uf[4]; unpack4(uw[h][nt], uf);
                u32x2 o; o.x = pk2(gelu_f(uf[0]) * (acc[nt][0] + bias), gelu_f(uf[1]) * (acc[nt][1] + bias)); o.y = pk2(gelu_f(uf[2]) * (acc[nt][2] + bias), gelu_f(uf[3]) * (acc[nt][3] + bias));
                *(u32x2*)(C.Y + (size_t)(row0 + p) * DM + 0 + c) = o; }
        }
    }
    __syncthreads();
}

__device__ __forceinline__ void ret_pass1(const Ctx& C, int chunk, LAS unsigned char* lds) {
    int tid_ = threadIdx.x; asm volatile("" : "+v"(tid_)); const int tid = tid_, lane = tid & 63, w = tid >> 6, fr = lane & 15, fq = lane >> 4;
    LAS bf16* vT = (LAS bf16*)lds; LAS bf16* kfT = vT + 64 * 136; LAS bf16* kbT = kfT + 64 * 136;
    const int b = chunk >> 6, n = chunk & 63, row0 = chunk * CHUNK;
    const int j = tid >> 2, sub = tid & 3;
    const bf16* zrow = C.Z + (size_t)(row0 + j) * INW;
    u32x4 k1w = *(const u32x4*)(zrow + ZC_RK + 8 * sub), k2w = *(const u32x4*)(zrow + ZC_RK + 32 + 8 * sub);
    u32x4 v1w = *(const u32x4*)(zrow + ZC_RV + 16 * sub), v2w = *(const u32x4*)(zrow + ZC_RV + 16 * sub + 8);
    float cs[8], sn[8];
    { const float pos = (float)C.pos[row0 + j];
#pragma unroll
      for (int ii = 0; ii < 8; ++ii) rope_cs(pos, 8 * sub + ii, cs[ii], sn[ii]); }
#pragma unroll 1
    for (int h = 0; h < NHEAD; ++h) {
        {
            const float lgm = log_gamma_h(h);
            const float decf = __expf(lgm * (float)(CHUNK - 1 - j)) * 0.125f, decb = __expf(lgm * (float)j) * 0.125f;
            float k1[8], k2[8]; unpack8(k1w, k1); unpack8(k2w, k2);
#pragma unroll
            for (int ii = 0; ii < 8; ++ii) { const int i = 8 * sub + ii;
                const float r1 = k1[ii] * cs[ii] - k2[ii] * sn[ii], r2 = k2[ii] * cs[ii] + k1[ii] * sn[ii];
                kfT[i * 136 + j] = f2bf(r1 * decf); kfT[(32 + i) * 136 + j] = f2bf(r2 * decf);
                kbT[i * 136 + j] = f2bf(r1 * decb); kbT[(32 + i) * 136 + j] = f2bf(r2 * decb); }
            const unsigned vw[8] = {v1w.x, v1w.y, v1w.z, v1w.w, v2w.x, v2w.y, v2w.z, v2w.w};
#pragma unroll
            for (int ii = 0; ii < 8; ++ii) { vT[(16 * sub + 2 * ii) * 136 + j] = (bf16)(vw[ii] & 0xffffu); vT[(16 * sub + 2 * ii + 1) * 136 + j] = (bf16)(vw[ii] >> 16); }
        }
        __syncthreads();
        if (h + 1 < NHEAD) {
            k1w = *(const u32x4*)(zrow + ZC_RK + 64 * (h + 1) + 8 * sub); k2w = *(const u32x4*)(zrow + ZC_RK + 64 * (h + 1) + 32 + 8 * sub);
            v1w = *(const u32x4*)(zrow + ZC_RV + 64 * (h + 1) + 16 * sub); v2w = *(const u32x4*)(zrow + ZC_RV + 64 * (h + 1) + 16 * sub + 8); }
        {
            const int z = w >> 2, mt = w & 3; LAS bf16* kT = z ? kbT : kfT;
            f32x4 acc[4];
#pragma unroll
            for (int nt = 0; nt < 4; ++nt) acc[nt] = (f32x4){0.f, 0.f, 0.f, 0.f};
#pragma unroll
            for (int ks = 0; ks < 4; ++ks) { const bf16x8 af = *(const LAS bf16x8*)(vT + (16 * mt + fr) * 136 + 32 * ks + 8 * fq);
#pragma unroll
                for (int nt = 0; nt < 4; ++nt) { const bf16x8 bfg = *(const LAS bf16x8*)(kT + (16 * nt + fr) * 136 + 32 * ks + 8 * fq); acc[nt] = MFMA16(bfg, af, acc[nt]); } }
            bf16* U = (z ? C.UB : C.UF) + (size_t)n * USTRIDE + (size_t)(b * NHEAD + h) * 4096;
#pragma unroll
            for (int nt = 0; nt < 4; ++nt) { u32x2 o; o.x = pk2(acc[nt][0], acc[nt][1]); o.y = pk2(acc[nt][2], acc[nt][3]); *(u32x2*)(U + (16 * mt + fr) * 64 + 16 * nt + 4 * fq) = o; }
        }
        __syncthreads();
    }
}

__device__ __forceinline__ void ret_pass2(const Ctx& C, int l, int chunk, LAS unsigned char* lds) {
    int tid_ = threadIdx.x; asm volatile("" : "+v"(tid_)); const int tid = tid_, lane = tid & 63, w = tid >> 6, fr = lane & 15, fq = lane >> 4;
    LAS bf16* kr = (LAS bf16*)lds; LAS bf16* qr = kr + 128 * 72; LAS bf16* BT = qr + 128 * 72; LAS bf16* Ss = BT + 64 * 264;
    const int b = chunk >> 6, n = chunk & 63, row0 = chunk * CHUNK;
    const int j = tid >> 2, sub = tid & 3, e = tid >> 3, d0 = 8 * (tid & 7);
    const bf16* zrow = C.Z + (size_t)(row0 + j) * INW;
    const size_t uo0 = (size_t)n * USTRIDE + (size_t)(b * NHEAD) * 4096 + e * 64 + d0;
    u32x4 q1w = *(const u32x4*)(zrow + ZC_RQ + 8 * sub), q2w = *(const u32x4*)(zrow + ZC_RQ + 32 + 8 * sub);
    u32x4 k1w = *(const u32x4*)(zrow + ZC_RK + 8 * sub), k2w = *(const u32x4*)(zrow + ZC_RK + 32 + 8 * sub);
    u32x4 v1w = *(const u32x4*)(zrow + ZC_RV + 16 * sub), v2w = *(const u32x4*)(zrow + ZC_RV + 16 * sub + 8);
    u32x4 rfw = *(const u32x4*)(C.UF + uo0), rbw = *(const u32x4*)(C.UB + uo0);
    float cs[8], sn[8];
    { const float pos = (float)C.pos[row0 + j];
#pragma unroll
      for (int ii = 0; ii < 8; ++ii) rope_cs(pos, 8 * sub + ii, cs[ii], sn[ii]); }
#pragma unroll 1
    for (int h = 0; h < NHEAD; ++h) {
        const float lgm = log_gamma_h(h);
        {
            float q1[8], q2[8], k1[8], k2[8]; unpack8(q1w, q1); unpack8(q2w, q2); unpack8(k1w, k1); unpack8(k2w, k2);
            float oq1[8], oq2[8], ok1[8], ok2[8];
#pragma unroll
            for (int ii = 0; ii < 8; ++ii) { const float c = cs[ii], s = sn[ii];
                oq1[ii] = q1[ii] * c - q2[ii] * s; oq2[ii] = q2[ii] * c + q1[ii] * s;
                ok1[ii] = (k1[ii] * c - k2[ii] * s) * 0.125f; ok2[ii] = (k2[ii] * c + k1[ii] * s) * 0.125f; }
            *(LAS u32x4*)(qr + j * 72 + 8 * sub) = pack8(oq1); *(LAS u32x4*)(qr + j * 72 + 32 + 8 * sub) = pack8(oq2);
            *(LAS u32x4*)(kr + j * 72 + 8 * sub) = pack8(ok1); *(LAS u32x4*)(kr + j * 72 + 32 + 8 * sub) = pack8(ok2);
            const unsigned vw[8] = {v1w.x, v1w.y, v1w.z, v1w.w, v2w.x, v2w.y, v2w.z, v2w.w};
#pragma unroll
            for (int ii = 0; ii < 8; ++ii) { BT[(16 * sub + 2 * ii) * 264 + j] = (bf16)(vw[ii] & 0xffffu); BT[(16 * sub + 2 * ii + 1) * 264 + j] = (bf16)(vw[ii] >> 16); }
            *(LAS u32x4*)(BT + e * 264 + 128 + d0) = rfw; *(LAS u32x4*)(BT + e * 264 + 192 + d0) = rbw;
        }
        __syncthreads();
        if (h + 1 < NHEAD) {
            const int hn = h + 1; const size_t uo = uo0 + (size_t)hn * 4096;
            q1w = *(const u32x4*)(zrow + ZC_RQ + 64 * hn + 8 * sub); q2w = *(const u32x4*)(zrow + ZC_RQ + 64 * hn + 32 + 8 * sub);
            k1w = *(const u32x4*)(zrow + ZC_RK + 64 * hn + 8 * sub); k2w = *(const u32x4*)(zrow + ZC_RK + 64 * hn + 32 + 8 * sub);
            v1w = *(const u32x4*)(zrow + ZC_RV + 64 * hn + 16 * sub); v2w = *(const u32x4*)(zrow + ZC_RV + 64 * hn + 16 * sub + 8);
            rfw = *(const u32x4*)(C.UF + uo); rbw = *(const u32x4*)(C.UB + uo); }
        {
            const int i = 16 * w + fr;
            u32x2 gwv[4];
#pragma unroll
            for (int nt = 0; nt < 4; ++nt) gwv[nt] = *(const u32x2*)(C.Z + (size_t)(row0 + i) * INW + ZC_RG + 64 * h + 16 * nt + 4 * fq);
            bf16x8 qf[2];
#pragma unroll
            for (int ks = 0; ks < 2; ++ks) qf[ks] = *(const LAS bf16x8*)(qr + i * 72 + 32 * ks + 8 * fq);
            LAS bf16* Sw = Ss + w * 16 * 136;
#pragma unroll
            for (int nt = 0; nt < 8; ++nt) { f32x4 s = (f32x4){0.f, 0.f, 0.f, 0.f};
#pragma unroll
                for (int ks = 0; ks < 2; ++ks) { const bf16x8 kf = *(const LAS bf16x8*)(kr + (16 * nt + fr) * 72 + 32 * ks + 8 * fq); s = MFMA16(kf, qf[ks], s); }
                float sv[4];
#pragma unroll
                for (int r = 0; r < 4; ++r) { const int jj = 16 * nt + 4 * fq + r; sv[r] = s[r] * __expf(lgm * fabsf((float)(i - jj))); }
                u32x2 o; o.x = pk2(sv[0], sv[1]); o.y = pk2(sv[2], sv[3]);
                *(LAS u32x2*)(Sw + fr * 136 + 16 * nt + 4 * fq) = o; }
            asm volatile("s_waitcnt lgkmcnt(0)" ::: "memory");
            f32x4 a1[4], a2[4], a3[4];
#pragma unroll
            for (int nt = 0; nt < 4; ++nt) { a1[nt] = (f32x4){0.f, 0.f, 0.f, 0.f}; a2[nt] = a1[nt]; a3[nt] = a1[nt]; }
#pragma unroll
            for (int ks = 0; ks < 4; ++ks) { const bf16x8 sf = *(const LAS bf16x8*)(Sw + fr * 136 + 32 * ks + 8 * fq);
#pragma unroll
                for (int nt = 0; nt < 4; ++nt) { const bf16x8 bfr = *(const LAS bf16x8*)(BT + (16 * nt + fr) * 264 + 32 * ks + 8 * fq); a1[nt] = MFMA16(bfr, sf, a1[nt]); } }
#pragma unroll
            for (int ks = 0; ks < 2; ++ks)
#pragma unroll
                for (int nt = 0; nt < 4; ++nt) { const bf16x8 b2 = *(const LAS bf16x8*)(BT + (16 * nt + fr) * 264 + 128 + 32 * ks + 8 * fq); a2[nt] = MFMA16(b2, qf[ks], a2[nt]);
                    const bf16x8 b3 = *(const LAS bf16x8*)(BT + (16 * nt + fr) * 264 + 192 + 32 * ks + 8 * fq); a3[nt] = MFMA16(b3, qf[ks], a3[nt]); }
            const float sfw = __expf(lgm * (float)(i + 1)), sbw = __expf(lgm * (float)(CHUNK - i));
            float sum = 0.f;
#pragma unroll
            for (int nt = 0; nt < 4; ++nt) { a1[nt] = a1[nt] + a2[nt] * sfw + a3[nt] * sbw; sum += (a1[nt][0] + a1[nt][1]) + (a1[nt][2] + a1[nt][3]); }
            sum += __shfl_xor(sum, 16); sum += __shfl_xor(sum, 32);
            const float mean = sum * (1.f / 64.f); float q = 0.f;
#pragma unroll
            for (int nt = 0; nt < 4; ++nt) { a1[nt] = a1[nt] - mean; q += (a1[nt][0] * a1[nt][0] + a1[nt][1] * a1[nt][1]) + (a1[nt][2] * a1[nt][2] + a1[nt][3] * a1[nt][3]); }
            q += __shfl_xor(q, 16); q += __shfl_xor(q, 32);
            const float rstd = 1.f / sqrtf(q * (1.f / 64.f) + LN_EPS);
            f32x4 ggv[4], gbv[4];
#pragma unroll
            for (int nt = 0; nt < 4; ++nt) { ggv[nt] = *(const f32x4*)(C.ret_gn_g + l * GWID + 64 * h + 16 * nt + 4 * fq); gbv[nt] = *(const f32x4*)(C.ret_gn_b + l * GWID + 64 * h + 16 * nt + 4 * fq); }
            asm volatile("" ::: "memory");
#pragma unroll
            for (int nt = 0; nt < 4; ++nt) { const int e = 64 * h + 16 * nt + 4 * fq;
                const f32x4 gg = ggv[nt], gb = gbv[nt];
                float gf[4]; unpack4(gwv[nt], gf);
                float o[4];
#pragma unroll
                for (int r = 0; r < 4; ++r) o[r] = silu_f(gf[r]) * (a1[nt][r] * rstd * gg[r] + gb[r]);
                u32x2 ow; ow.x = pk2(o[0], o[1]); ow.y = pk2(o[2], o[3]);
                *(u32x2*)(C.Y + (size_t)(row0 + i) * DM + 256 + e) = ow; }
        }
        __syncthreads();
    }
}

#define LRU_SCAN_STEP(DIR, N) \
    "v_fmac_f32_dpp %4, %4, %0 " DIR ":" #N " row_mask:0xf bank_mask:0xf\n\t" "v_fmac_f32_dpp %5, %5, %1 " DIR ":" #N " row_mask:0xf bank_mask:0xf\n\t" \
    "v_fmac_f32_dpp %6, %6, %2 " DIR ":" #N " row_mask:0xf bank_mask:0xf\n\t" "v_fmac_f32_dpp %7, %7, %3 " DIR ":" #N " row_mask:0xf bank_mask:0xf\n\t" \
    "v_mul_f32_dpp %0, %0, %0 " DIR ":" #N " row_mask:0xf bank_mask:0xf\n\t" "v_mul_f32_dpp %1, %1, %1 " DIR ":" #N " row_mask:0xf bank_mask:0xf\n\t" \
    "v_mul_f32_dpp %2, %2, %2 " DIR ":" #N " row_mask:0xf bank_mask:0xf\n\t" "v_mul_f32_dpp %3, %3, %3 " DIR ":" #N " row_mask:0xf bank_mask:0xf\n\t"
#define LRU_SCAN4(DIR, a, b) asm volatile("s_nop 1\n\t" LRU_SCAN_STEP(DIR, 1) LRU_SCAN_STEP(DIR, 2) LRU_SCAN_STEP(DIR, 4) LRU_SCAN_STEP(DIR, 8) \
    : "+v"(a[0]), "+v"(a[1]), "+v"(a[2]), "+v"(a[3]), "+v"(b[0]), "+v"(b[1]), "+v"(b[2]), "+v"(b[3]))
template <int MODE, int Z>
__device__ __forceinline__ void lru_dir(const Ctx& C, int l, int b, int n, int row0, const LAS bf16* xa, int w, int fr, int fq, f32x4 (&hf)[8][2]) {
    const int hh = w >> 1, half = w & 1, cb = 64 * hh + 32 * half;
    const int lane = fq * 16 + fr, edge_src = (fq * 16 + (Z ? 0 : 15)) << 2;
    bf16x8 wa[2][2], wx[2][2];
    {
        const bf16* WTa = C.LRUW + (((size_t)l * 2 + 0) * 8 + Z * 4 + hh) * 4096; const bf16* WTx = C.LRUW + (((size_t)l * 2 + 1) * 8 + Z * 4 + hh) * 4096;
#pragma unroll
        for (int ntl = 0; ntl < 2; ++ntl)
#pragma unroll
            for (int ks = 0; ks < 2; ++ks) { wa[ntl][ks] = *(const bf16x8*)(WTa + (32 * half + 16 * ntl + fr) * 64 + 32 * ks + 8 * fq); wx[ntl][ks] = *(const bf16x8*)(WTx + (32 * half + 16 * ntl + fr) * 64 + 32 * ks + 8 * fq); }
    }
    f32x4 ba2[2], bx2[2], spv[2], hprev[2], Ap[2];
    const size_t co = ((size_t)(b * NCH + n) * 2 + Z) * GWID + cb + 4 * fq;
#pragma unroll
    for (int ntl = 0; ntl < 2; ++ntl) { const int ci = (l * 2 + Z) * GWID + cb + 16 * ntl + 4 * fq;
        ba2[ntl] = *(const f32x4*)(C.BA2 + ci); bx2[ntl] = *(const f32x4*)(C.BX2 + ci); spv[ntl] = *(const f32x4*)(C.SP + ci);
        hprev[ntl] = MODE ? *(const f32x4*)(C.CH + co + 16 * ntl) : (f32x4){0.f, 0.f, 0.f, 0.f}; Ap[ntl] = (f32x4){1.f, 1.f, 1.f, 1.f}; }
    u32x2 gpre[8][2];
    if (MODE && Z) {
#pragma unroll
        for (int mt = 0; mt < 8; ++mt)
#pragma unroll
            for (int ntl = 0; ntl < 2; ++ntl) gpre[mt][ntl] = *(const u32x2*)(C.Z + (size_t)(row0 + 16 * mt + fr) * INW + ZC_CG + cb + 16 * ntl + 4 * fq);
    }
#pragma unroll
    for (int i = 0; i < 8; ++i) { const int mt = Z ? 7 - i : i; const int t = 16 * mt + fr;
        bf16x8 af[2];
#pragma unroll
        for (int ks = 0; ks < 2; ++ks) af[ks] = *(const LAS bf16x8*)(xa + t * 264 + 64 * hh + 32 * ks + 8 * fq);
        f32x4 Av[2], Bv[2];
#pragma unroll
        for (int ntl = 0; ntl < 2; ++ntl) { f32x4 aa = ba2[ntl], ax = bx2[ntl];
#pragma unroll
            for (int ks = 0; ks < 2; ++ks) { aa = MFMA16(wa[ntl][ks], af[ks], aa); ax = MFMA16(wx[ntl][ks], af[ks], ax); }
            const u32x2 xw = *(const LAS u32x2*)(xa + t * 264 + cb + 16 * ntl + 4 * fq); const f32x4 xv = (f32x4){bflo(xw.x), bfhi(xw.x), bflo(xw.y), bfhi(xw.y)};
#pragma unroll
            for (int r = 0; r < 4; ++r) { const float rg = __builtin_amdgcn_rcpf(1.0f + __builtin_amdgcn_exp2f(aa[r])), ig = __builtin_amdgcn_rcpf(1.0f + __builtin_amdgcn_exp2f(ax[r]));
                const float a = __builtin_amdgcn_exp2f(spv[ntl][r] * rg);
                Av[ntl][r] = a; Bv[ntl][r] = xv[r] * ig * __builtin_amdgcn_sqrtf(fmaf(-a, a, 1.0f)); } }
        {
            if (Z == 0) { LRU_SCAN4("row_shr", Av[0], Bv[0]); LRU_SCAN4("row_shr", Av[1], Bv[1]); } else { LRU_SCAN4("row_shl", Av[0], Bv[0]); LRU_SCAN4("row_shl", Av[1], Bv[1]); }
        }
#pragma unroll
        for (int ntl = 0; ntl < 2; ++ntl) {
            f32x4 cin;
#pragma unroll
            for (int r = 0; r < 4; ++r) cin[r] = __int_as_float(__builtin_amdgcn_ds_bpermute(edge_src, __float_as_int(hprev[ntl][r])));
            const f32x4 hv = Bv[ntl] + Av[ntl] * cin;
            hprev[ntl] = hv; Ap[ntl] = Ap[ntl] * Av[ntl];
            if (MODE) {
                if (Z == 0) hf[mt][ntl] = hv;
                else { const f32x4 hs = hf[mt][ntl] + hv;
                    float gf[4]; unpack4(gpre[mt][ntl], gf);
                    u32x2 ow; ow.x = pk2(hs[0] * gelu_f(gf[0]), hs[1] * gelu_f(gf[1])); ow.y = pk2(hs[2] * gelu_f(gf[2]), hs[3] * gelu_f(gf[3]));
                    *(u32x2*)(C.Y + (size_t)(row0 + t) * DM + 512 + cb + 16 * ntl + 4 * fq) = ow; }
            }
        }
    }
    if (!MODE && fr == (Z ? 0 : 15)) {
#pragma unroll
        for (int ntl = 0; ntl < 2; ++ntl) { *(f32x4*)(C.CA + co + 16 * ntl) = Ap[ntl]; *(f32x4*)(C.CH + co + 16 * ntl) = hprev[ntl]; } }
    (void)lane;
}
template <int MODE>
__device__ __forceinline__ void lru_pass(const Ctx& C, int l, int chunk, LAS unsigned char* lds) {
    int tid_ = threadIdx.x; asm volatile("" : "+v"(tid_)); const int tid = tid_, lane = tid & 63, w = tid >> 6, fr = lane & 15, fq = lane >> 4;
    LAS bf16* xa = (LAS bf16*)lds;
    const int b = chunk >> 6, n = chunk & 63, row0 = chunk * CHUNK;
    {
        const int cg8 = (tid & 31) * 8, t0 = (tid >> 5) * 8;
        float wk[4][8], bias[8];
#pragma unroll
        for (int k = 0; k < 4; ++k) { const float* wp = C.lru_conv_w + (size_t)(l * 4 + k) * GWID + cg8; const f32x4 w0 = *(const f32x4*)wp, w1 = *(const f32x4*)(wp + 4);
            wk[k][0] = w0[0]; wk[k][1] = w0[1]; wk[k][2] = w0[2]; wk[k][3] = w0[3]; wk[k][4] = w1[0]; wk[k][5] = w1[1]; wk[k][6] = w1[2]; wk[k][7] = w1[3]; }
        { const f32x4 b0 = *(const f32x4*)(C.lru_conv_b + l * GWID + cg8), b1 = *(const f32x4*)(C.lru_conv_b + l * GWID + cg8 + 4);
          bias[0] = b0[0]; bias[1] = b0[1]; bias[2] = b0[2]; bias[3] = b0[3]; bias[4] = b1[0]; bias[5] = b1[1]; bias[6] = b1[2]; bias[7] = b1[3]; }
        float xr[11][8];
#pragma unroll
        for (int r = 0; r < 11; ++r) { const int sq = n * CHUNK + t0 - 2 + r; u32x4 w = (u32x4){0u, 0u, 0u, 0u};
            if (sq >= 0 && sq < SEQ) w = *(const u32x4*)(C.Z + (size_t)(b * SEQ + sq) * INW + ZC_CX + cg8);
            unpack8(w, xr[r]); }
#pragma unroll
        for (int tt = 0; tt < 8; ++tt) { float acc[8];
#pragma unroll
            for (int c = 0; c < 8; ++c) acc[c] = bias[c] + ((wk[0][c] * xr[tt][c] + wk[1][c] * xr[tt + 1][c]) + (wk[2][c] * xr[tt + 2][c] + wk[3][c] * xr[tt + 3][c]));
            *(LAS u32x4*)(xa + (t0 + tt) * 264 + cg8) = pack8(acc); }
    }
    __syncthreads();
    f32x4 hf[8][2];
    lru_dir<MODE, 0>(C, l, b, n, row0, xa, w, fr, fq, hf);
    lru_dir<MODE, 1>(C, l, b, n, row0, xa, w, fr, fq, hf);
    __syncthreads();
}

__device__ __forceinline__ void sc_chunk(const Ctx& C, int l, int chunk) {
    int tid_ = threadIdx.x; asm volatile("" : "+v"(tid_)); const int tid = tid_; const int b = chunk >> 6, n = chunk & 63, row0 = chunk * CHUNK;
    const int c8 = (tid & 31) * 8, t0 = (tid >> 5) * 8;
    float wk[3][8];
#pragma unroll
    for (int k = 0; k < 3; ++k) { const float* wp = C.sc_conv_w + (size_t)(l * 3 + k) * GWID + c8; const f32x4 w0 = *(const f32x4*)wp, w1 = *(const f32x4*)(wp + 4);
        wk[k][0] = w0[0]; wk[k][1] = w0[1]; wk[k][2] = w0[2]; wk[k][3] = w0[3]; wk[k][4] = w1[0]; wk[k][5] = w1[1]; wk[k][6] = w1[2]; wk[k][7] = w1[3]; }
    float ch[10][8];
#pragma unroll
    for (int r = 0; r < 10; ++r) { const int sq = n * CHUNK + t0 - 1 + r; u32x4 cw = (u32x4){0u, 0u, 0u, 0u}, hw = cw;
        if (sq >= 0 && sq < SEQ) { const bf16* zr = C.Z + (size_t)(b * SEQ + sq) * INW; cw = *(const u32x4*)(zr + ZC_DC + c8); hw = *(const u32x4*)(zr + ZC_DH + c8); }
        float cf[8], hf[8]; unpack8(cw, cf); unpack8(hw, hf);
#pragma unroll
        for (int i = 0; i < 8; ++i) ch[r][i] = cf[i] * hf[i]; }
#pragma unroll
    for (int tt = 0; tt < 8; ++tt) { const u32x4 bw = *(const u32x4*)(C.Z + (size_t)(row0 + t0 + tt) * INW + ZC_DB + c8); float bf_[8]; unpack8(bw, bf_);
        float acc[8];
#pragma unroll
        for (int i = 0; i < 8; ++i) acc[i] = bf_[i] * (wk[0][i] * ch[tt][i] + wk[1][i] * ch[tt + 1][i] + wk[2][i] * ch[tt + 2][i]);
        *(u32x4*)(C.Y + (size_t)(row0 + t0 + tt) * DM + 768 + c8) = pack8(acc); }
}

__device__ __forceinline__ void carry_phase(const Ctx& C) {
    int tid_ = threadIdx.x; asm volatile("" : "+v"(tid_)); const int gt = blockIdx.x * 512 + tid_, NT = gridDim.x * 512;
    for (int i2 = gt; i2 < (int)USTRIDE / 2; i2 += NT) { const int idx = 2 * i2, h = (idx >> 12) & 3;
        const float cd = __expf(log_gamma_h(h) * (float)CHUNK);
        unsigned* pf = (unsigned*)(C.UF + idx); unsigned* pb = (unsigned*)(C.UB + idx); float sf0 = 0.f, sf1 = 0.f, sb0 = 0.f, sb1 = 0.f;
#pragma unroll 1
        for (int n8 = 0; n8 < NCH; n8 += 8) { unsigned uf[8], ub[8];
#pragma unroll
            for (int i = 0; i < 8; ++i) { uf[i] = pf[(size_t)(n8 + i) * (USTRIDE / 2)]; ub[i] = pb[(size_t)(NCH - 1 - n8 - i) * (USTRIDE / 2)]; }
#pragma unroll
            for (int i = 0; i < 8; ++i) { pf[(size_t)(n8 + i) * (USTRIDE / 2)] = pk2(sf0, sf1); sf0 = cd * sf0 + bflo(uf[i]); sf1 = cd * sf1 + bfhi(uf[i]);
                pb[(size_t)(NCH - 1 - n8 - i) * (USTRIDE / 2)] = pk2(sb0, sb1); sb0 = cd * sb0 + bflo(ub[i]); sb1 = cd * sb1 + bfhi(ub[i]); } }
    }
    if (gt < BATCH * 512) { const int b = gt >> 9, zc = gt & 511, z = zc >> 8; float st = 0.f;
#pragma unroll 1
        for (int n8 = 0; n8 < NCH; n8 += 8) { float a[8], hh[8];
#pragma unroll
            for (int i = 0; i < 8; ++i) { const int n = z ? NCH - 1 - n8 - i : n8 + i; const size_t o = (size_t)(b * NCH + n) * 512 + zc; a[i] = C.CA[o]; hh[i] = C.CH[o]; }
#pragma unroll
            for (int i = 0; i < 8; ++i) { const int n = z ? NCH - 1 - n8 - i : n8 + i; const size_t o = (size_t)(b * NCH + n) * 512 + zc; C.CH[o] = st; st = a[i] * st + hh[i]; } } }
}

#define RLX_AGENT __ATOMIC_RELAXED, __HIP_MEMORY_SCOPE_AGENT
#define XB_TMO      128
#define XB_XCNT(j)  (256  + 64 * (j))
#define XB_XSUB(j)  (1280 + 64 * (j))
#define XB_XGEN(j)  (2304 + 64 * (j))
#define XB_TOP      3328
#define XB_TOPGEN   3392
#define XCD_BAR_WORDS 3456
#define XB_SPIN_CAP (1u << 18)

__device__ __forceinline__ unsigned xb_ld(unsigned* p)              { return __hip_atomic_load(p, __ATOMIC_RELAXED, __HIP_MEMORY_SCOPE_AGENT); }
__device__ __forceinline__ unsigned xb_add(unsigned* p, unsigned v) { return __hip_atomic_fetch_add(p, v, __ATOMIC_RELAXED, __HIP_MEMORY_SCOPE_AGENT); }
__device__ __forceinline__ unsigned xb_xcc_id() { return (unsigned)__builtin_amdgcn_s_getreg((3 << 11) | 20) & 0xFu; }
#define XB_SPIN(cond, bar) do { unsigned _sp = 0; while (cond) { __builtin_amdgcn_s_sleep(1); \
    if ((++_sp & 255u) == 0u) { if (xb_ld(&(bar)[XB_TMO])) break; if (_sp > XB_SPIN_CAP) { atomicAdd(&(bar)[XB_TMO], 1u); break; } } } } while (0)

struct XcdBarrier {
    unsigned* bar; unsigned x;
    volatile LAS unsigned* st;
};

__device__ __forceinline__ XcdBarrier xcd_barrier_post(unsigned* bar, volatile LAS unsigned* st) {
    XcdBarrier b; b.bar = bar; b.x = xb_xcc_id(); b.st = st;
    if (threadIdx.x == 0) (void)xb_add(&bar[XB_XCNT(b.x)], 1u);
    return b;
}
__device__ __forceinline__ void xcd_barrier_complete(unsigned* bar, unsigned x, unsigned& nloc, unsigned& nx) {
    const unsigned G = gridDim.x * gridDim.y * gridDim.z;
    unsigned sum, cnt, mine, sp = 0u;
    for (;;) {
        sum = 0u; cnt = 0u; mine = 0u;
#pragma unroll
        for (unsigned j = 0; j < 16; ++j) { const unsigned c = xb_ld(&bar[XB_XCNT(j)]); sum += c; cnt += (c > 0u) ? 1u : 0u; mine = (j == x) ? c : mine; }
        if (sum == G) break;
        __builtin_amdgcn_s_sleep(1);
        if ((++sp & 255u) == 0u) { if (xb_ld(&bar[XB_TMO])) break; if (sp > XB_SPIN_CAP) { atomicAdd(&bar[XB_TMO], 1u); break; } }
    }
    nloc = mine > 0u ? mine : 1u; nx = cnt > 0u ? cnt : 1u;
}

__device__ __forceinline__ void xcd_barrier(const XcdBarrier& b) {
    asm volatile("s_waitcnt vmcnt(0)" ::: "memory");
    __syncthreads();
    if (threadIdx.x == 0) {
        unsigned* bar = b.bar;
        __builtin_amdgcn_s_waitcnt(0);
        unsigned nloc = b.st[0], nx = b.st[1];
        if (nloc == 0u) { xcd_barrier_complete(bar, b.x, nloc, nx); b.st[0] = nloc; b.st[1] = nx; }
        const unsigned old = xb_add(&bar[XB_XSUB(b.x)], 1u);
        const unsigned gen = old / nloc;
        if (old + 1u == (gen + 1u) * nloc) {
            __builtin_amdgcn_fence(__ATOMIC_RELEASE, "agent");
            asm volatile("s_waitcnt vmcnt(0)" ::: "memory");
            const unsigned og = xb_add(&bar[XB_TOP], 1u);
            const unsigned tg = og / nx;
            if (og + 1u == (tg + 1u) * nx) xb_add(&bar[XB_TOPGEN], 1u);
            else XB_SPIN(xb_ld(&bar[XB_TOPGEN]) == tg, bar);
            __builtin_amdgcn_fence(__ATOMIC_ACQUIRE, "agent");
            xb_add(&bar[XB_XGEN(b.x)], 1u);
            asm volatile("s_waitcnt vmcnt(0)" ::: "memory");
        } else {
            XB_SPIN(xb_ld(&bar[XB_XGEN(b.x)]) == gen, bar);
            __builtin_amdgcn_fence(__ATOMIC_ACQUIRE, "agent");
            asm volatile("s_waitcnt vmcnt(0)" ::: "memory");
        }
    }
    __syncthreads();
}

#ifndef STAG_TICKS
#define STAG_TICKS 0
#endif
__device__ __forceinline__ void xcd_stagger(unsigned x, unsigned ticks) {
    const unsigned long long t0 = __builtin_amdgcn_s_memrealtime(), dt = (unsigned long long)x * ticks;
    while (__builtin_amdgcn_s_memrealtime() - t0 < dt) __builtin_amdgcn_s_sleep(4);
}
#ifndef DUP_MIX
#define DUP_MIX 0
#endif
#ifndef DUP_G13
#define DUP_G13 0
#endif
#ifndef DUP_G2
#define DUP_G2 0
#endif
#ifndef REV_G4
#define REV_G4 1
#endif
#ifndef DUP_G3
#define DUP_G3 0
#endif
#ifndef DUP_G4
#define DUP_G4 0
#endif
#ifndef DUP_CARRY
#define DUP_CARRY 0
#endif
#ifndef DUP_LRU
#define DUP_LRU 0
#endif
#ifndef DUP_RET
#define DUP_RET 0
#endif
#ifndef DUP_GS
#define DUP_GS 0
#endif
#ifndef DUP_PRO
#define DUP_PRO 0
#endif
#define GRID_SYNC() do { asm volatile("s_waitcnt vmcnt(0) lgkmcnt(0)" ::: "memory"); grid.sync(); __builtin_amdgcn_fence(__ATOMIC_ACQUIRE, "agent"); asm volatile("s_waitcnt vmcnt(0)" ::: "memory"); } while (0)
typedef const __attribute__((address_space(4))) Args* KArgP;
__device__ __forceinline__ KArgP launder(KArgP p) { asm volatile("" : "+s"(p)); return p; }
__device__ __forceinline__ Ctx make_ctx(KArgP ap) {
    const __attribute__((address_space(4))) Args& args = *ap;
    Ctx C;
    C.x = (const float*)args.in[0]; C.pos = (const int*)args.in[1]; C.w_in = (const float*)args.in[2]; C.gmlp_ln_g = (const float*)args.in[3]; C.gmlp_ln_b = (const float*)args.in[4];
    C.gmlp_ws = (const float*)args.in[5]; C.gmlp_bs = (const float*)args.in[6]; C.ret_gn_g = (const float*)args.in[7]; C.ret_gn_b = (const float*)args.in[8];
    C.lru_conv_w = (const float*)args.in[9]; C.lru_conv_b = (const float*)args.in[10]; C.lru_wa = (const float*)args.in[11]; C.lru_ba = (const float*)args.in[12];
    C.lru_wx = (const float*)args.in[13]; C.lru_bx = (const float*)args.in[14]; C.lru_lambda = (const float*)args.in[15]; C.sc_conv_w = (const float*)args.in[16];
    C.w_out = (const float*)args.in[17]; C.ln1_g = (const float*)args.in[18]; C.ln1_b = (const float*)args.in[19]; C.ffn_wg = (const float*)args.in[20]; C.ffn_wu = (const float*)args.in[21];
    C.ffn_wd = (const float*)args.in[22]; C.ln2_g = (const float*)args.in[23]; C.ln2_b = (const float*)args.in[24];
    C.out = args.out; unsigned char* ws = args.ws;
    C.WIN = (bf16*)(ws + OFF_WIN); C.WOUT = (bf16*)(ws + OFF_WOUT); C.WGU = (bf16*)(ws + OFF_WGU); C.WD = (bf16*)(ws + OFF_WD); C.LRUW = (bf16*)(ws + OFF_LRUW);
    C.XB = (bf16*)(ws + OFF_XB); C.Z = (bf16*)(ws + OFF_Z); C.Y = (bf16*)(ws + OFF_Y); C.UF = (bf16*)(ws + OFF_UF); C.UB = (bf16*)(ws + OFF_UB); C.CA = (float*)(ws + OFF_CA); C.CH = (float*)(ws + OFF_CH); C.SP = (float*)(ws + OFF_SP); C.BA2 = C.SP + DEPTH * 2 * GWID; C.BX2 = C.SP + 2 * DEPTH * 2 * GWID; C.S1 = (float*)(ws + OFF_S1); C.T1 = (float*)(ws + OFF_T1); C.S3 = (float*)(ws + OFF_S3); C.T3 = (float*)(ws + OFF_T3); C.WSB = (bf16*)(ws + OFF_WSB); C.P0 = (long long*)(ws + OFF_P0); C.P1 = (long long*)(ws + OFF_P1);
    return C;
}
__global__ void __launch_bounds__(512) hybrid_fwd(Args args) {
    extern __shared__ __attribute__((aligned(16))) unsigned char lds_raw[];
    LAS unsigned char* lds = (LAS unsigned char*)lds_raw;
    cg::grid_group grid = cg::this_grid();
    (void)args; const KArgP ap0 = (KArgP)__builtin_amdgcn_kernarg_segment_ptr();
    unsigned char* const args_ws_ptr = ap0->ws;
    const int G = gridDim.x;
    if (threadIdx.x < 64) ((LAS unsigned*)(lds + LDS_MISC_OFF))[threadIdx.x] = 0u;
    __syncthreads();
    const XcdBarrier bar = xcd_barrier_post((unsigned*)(args_ws_ptr + OFF_CTL), (volatile LAS unsigned*)(lds + LDS_MISC_OFF));

    for (int q = 0; q <= DUP_PRO; ++q) { const Ctx C = make_ctx(launder(ap0)); prologue(C, lds); __syncthreads(); }
    if (G > 1024) GRID_SYNC();
    else xcd_barrier(bar);
#pragma unroll 1
    for (int l = 0; l < DEPTH; ++l) {
        {
            const Ctx C = make_ctx(launder(ap0));
            pg8::Gemm g{C.XB, C.WIN + (size_t)l * INW * DM, M, INW, DM}; pg8::StaticOrder S; S.init(M, INW, G, (int)blockIdx.x);
            EpiLnBf16 E{C.Z, INW, C.P0, C.S1 + l * INW, C.T1 + l * INW, l ? 1 : 0};
#pragma unroll 1
            for (int rep = 0; rep <= DUP_G13; ++rep)
            pg8::gemm_phase<EpiLnBf16, pg8::StaticOrder, true, true>(lds, g, S, E);
        }
        xcd_barrier(bar);
#pragma unroll 1
        for (int rep = 0; rep <= DUP_MIX; ++rep)
#pragma unroll 1
        for (int c = blockIdx.x; c < NCHUNK; c += G) {
            for (int q = 0; q <= DUP_GS; ++q) { const Ctx C = make_ctx(launder(ap0)); gmlp_chunk(C, l, c, lds); }
            for (int q = 0; q <= DUP_RET; ++q) { const Ctx C = make_ctx(launder(ap0)); ret_pass1(C, c, lds); }
            for (int q = 0; q <= DUP_LRU; ++q) { const Ctx C = make_ctx(launder(ap0)); lru_pass<0>(C, l, c, lds); }
            for (int q = 0; q <= DUP_GS; ++q) { const Ctx C = make_ctx(launder(ap0)); sc_chunk(C, l, c); } }
        xcd_barrier(bar);
        { const Ctx C = make_ctx(launder(ap0)); carry_phase(C); zero_rows(C.P1); }
        xcd_barrier(bar);
#pragma unroll 1
        for (int rep = 0; rep <= DUP_MIX; ++rep)
#pragma unroll 1
        for (int c = blockIdx.x; c < NCHUNK; c += G) {
            for (int q = 0; q <= DUP_RET; ++q) { const Ctx C = make_ctx(launder(ap0)); ret_pass2(C, l, c, lds); }
            for (int q = 0; q <= DUP_LRU; ++q) { const Ctx C = make_ctx(launder(ap0)); lru_pass<1>(C, l, c, lds); } }
        xcd_barrier(bar);
        {
            const Ctx C = make_ctx(launder(ap0));
            pg8::Gemm g{C.Y, C.WOUT + (size_t)l * DM * DM, M, DM, DM}; pg8::StaticOrder S; S.init(M, DM, G, (int)blockIdx.x);
            stage_gain_bias((LAS float*)(lds + LDS_GB_OFF), C.ln2_g + (l ? l - 1 : 0) * DM, C.ln2_b + (l ? l - 1 : 0) * DM, l == 0 ? 1 : 0);
            EpiResLn E{C.x, C.out, C.XB, C.XB, C.P0, (const LAS float*)(lds + LDS_GB_OFF), C.P1, l == 0 ? 1 : 0, 0, DN_ALPHA};
            pg8::gemm_phase<EpiResLn, pg8::StaticOrder, true, true>(lds, g, S, E);
        }
        xcd_barrier(bar);
        {
            const Ctx C = make_ctx(launder(ap0));
            zero_rows(C.P0);
            pg8::Gemm g{C.XB, C.WGU + (size_t)l * 2 * DFF * DM, M, 2 * DFF, DM}; pg8::StaticOrder S; S.init(M, 2 * DFF, G, (int)blockIdx.x);
            EpiSwiGLU E{C.Z, C.P1, C.S3 + l * 2 * DFF, C.T3 + l * 2 * DFF};
            pg8::gemm_phase<EpiSwiGLU, pg8::StaticOrder, true, true>(lds, g, S, E);
        }
        xcd_barrier(bar);
        {
            const Ctx C = make_ctx(launder(ap0));
            pg8::Gemm g{C.Z, C.WD + (size_t)l * DM * DFF, M, DM, DFF}; pg8::StaticOrder S; S.init(M, DM, G, (int)blockIdx.x, REV_G4);
            stage_gain_bias((LAS float*)(lds + LDS_GB_OFF), C.ln1_g + l * DM, C.ln1_b + l * DM, 0);
            EpiResLn E{C.x, C.out, C.XB, C.XB, C.P1, (const LAS float*)(lds + LDS_GB_OFF), C.P0, 0, l + 1 == DEPTH ? 1 : 0, DN_ALPHA};
            pg8::gemm_phase<EpiResLn, pg8::StaticOrder, true, true>(lds, g, S, E);
        }
        xcd_barrier(bar);
    }
    { const Ctx C = make_ctx(launder(ap0)); final_ln(C.out, C.P0, C.ln2_g + (DEPTH - 1) * DM, C.ln2_b + (DEPTH - 1) * DM); }
}

extern "C" void kernel_launch(void* const* d_in, const int* in_sizes, int n_in, void* d_out, int out_size, void* d_ws, size_t ws_size, hipStream_t stream) {
    static int grid = 0;
    if (grid == 0) {
        if (n_in != 25 || out_size != M * DM || ws_size < WS_END) { fprintf(stderr, "kernel_launch: unexpected shapes (n_in %d out %d ws %zu need %zu)\n", n_in, out_size, ws_size, (size_t)WS_END); grid = -1; return; }
        int dev = 0, cus = 0, per_cu = 0;
        (void)hipGetDevice(&dev); (void)hipDeviceGetAttribute(&cus, hipDeviceAttributeMultiprocessorCount, dev);
        if (hipFuncSetAttribute((const void*)hybrid_fwd, hipFuncAttributeMaxDynamicSharedMemorySize, LDS_BYTES) != hipSuccess) { fprintf(stderr, "kernel_launch: hipFuncSetAttribute failed\n"); grid = -1; return; }
        if (hipOccupancyMaxActiveBlocksPerMultiprocessor(&per_cu, (const void*)hybrid_fwd, 512, LDS_BYTES) != hipSuccess || per_cu < 1) { fprintf(stderr, "kernel_launch: occupancy query says %d\n", per_cu); per_cu = 1; }
        (void)hipGetLastError();
        grid = cus * per_cu; if (grid > 256) grid = 256; if (grid < 1) grid = 256;
    }
    if (grid < 0) return;
    if (hipMemsetAsync((char*)d_ws + OFF_CTL, 0, CTL_BYTES, stream) != hipSuccess) { fprintf(stderr, "kernel_launch: memset failed\n"); return; }
    Args a{};
    for (int i = 0; i < 25; ++i) a.in[i] = d_in[i];
    a.out = (float*)d_out; a.ws = (unsigned char*)d_ws;
    void* kargs[] = {&a};
    hipError_t e = hipLaunchCooperativeKernel((const void*)hybrid_fwd, dim3(grid), dim3(512), kargs, LDS_BYTES, stream);
    if (e != hipSuccess) fprintf(stderr, "cooperative launch failed: %s (grid %d)\n", hipGetErrorString(e), grid);
}
```

```cpp
#define EPI_RB 4
#include <hip/hip_runtime.h>
#include <hip/hip_cooperative_groups.h>
#include <cstdio>
#include <cstdint>
namespace cg = cooperative_groups;
namespace pg8 {
#define PG8_LAS __attribute__((address_space(3)))
typedef unsigned short bf16_t;
typedef short bf16x8 __attribute__((ext_vector_type(8)));
typedef float f32x4 __attribute__((ext_vector_type(4)));
typedef unsigned u32x4 __attribute__((ext_vector_type(4)));
constexpr int BM = 256, BK = 64, HALF = 128, HTB = HALF * BK * 2  , STAGE_BYTES = 8 * HTB, NXCD = 8, WGM = 8;

__host__ __device__ __forceinline__ int lds_byte(int r, int c) { const int st = (r >> 4) * 2 + (c >> 5), rr = r & 15, cc = c & 31, ob = rr * 64 + cc * 2; return st * 1024 + (ob ^ (((ob >> 9) & 1) << 5)); }
__host__ __device__ __forceinline__ void stage_rc(int b, int& R, int& C) { const int st = b / 1024, sb = b % 1024, swz = sb ^ (((sb >> 9) & 1) << 5); R = (st >> 1) * 16 + swz / 64; C = (st & 1) * 32 + (swz % 64) / 2; }
__host__ __device__ __forceinline__ int perm32(int rho) { const int n = rho >> 4, i = rho & 15; return 8 * (i >> 2) + 4 * n + (i & 3); }

struct Unit { int pm, pn; };
struct Gemm { const bf16_t* A; const bf16_t* Bt; int M, N, K; };

struct StaticOrder {
    int nM, nN, nwg, G, c, rev;
    __host__ __device__ void init(int M, int N, int G_, int c_, int rev_ = 0) { nM = M / BM; nN = N / BM; nwg = nM * nN; G = G_; c = c_; rev = (rev_ && nwg % G_ == 0) ? 1 : 0; }
    __host__ __device__ bool next(int i, Unit& u) const {
        if ((long)i * G + c >= nwg) return false;
        const long L = (long)(rev ? nwg / G - 1 - i : i) * G + c;
        int wgid = (int)L; { const int q = nwg / NXCD, r = nwg % NXCD, xcd = wgid % NXCD, off = wgid / NXCD; wgid = (xcd < r ? xcd * (q + 1) : r * (q + 1) + (xcd - r) * q) + off; }
        const int nig = WGM * nN, gid = wgid / nig, fm = gid * WGM, gsz = (nM - fm) < WGM ? (nM - fm) : WGM;
        u.pm = fm + ((wgid % nig) % gsz); u.pn = (wgid % nig) / gsz; return true;
    }
    __device__ __forceinline__ void a_ready(const Unit&) const {}
    __device__ __forceinline__ void done(const Unit&) const {}
};

__device__ __forceinline__ unsigned cvt_pk_bf16(float lo, float hi) { unsigned r; asm volatile("v_cvt_pk_bf16_f32 %0, %1, %2" : "=v"(r) : "v"(lo), "v"(hi)); return r; }
typedef float f32x2 __attribute__((ext_vector_type(2)));
__device__ __forceinline__ f32x2 gelu_pk(f32x2 v) {
    const f32x2 av = __builtin_elementwise_abs(v), d = av * 0.2316418882f + 1.0f;
    f32x2 t; t.x = __builtin_amdgcn_rcpf(d.x); t.y = __builtin_amdgcn_rcpf(d.y);
    f32x2 q = t * 0.5307027145f + (-0.7265760135f); q = q * t + 0.7107068705f; q = q * t + (-0.142248368f); q = q * t + 0.127414796f; q = q * t;
    const f32x2 s = (v * v) * (-0.72134752044f);
    f32x2 e; e.x = __builtin_amdgcn_exp2f(s.x); e.y = __builtin_amdgcn_exp2f(s.y);
    const f32x2 m = v * (q * e), r = v - m;
    f32x2 o; o.x = v.x < 0.f ? m.x : r.x; o.y = v.y < 0.f ? m.y : r.y; return o;
}

template <int ACT  > struct EpiBf16 {
    static constexpr bool PERM = true, AFTER_DRAIN = false; static_assert(ACT == 0 || ACT == 1, "EpiBf16: ACT is 0 (none) or 1 (gelu_pk)");
    bf16_t* O; int ldc; const float* bias; int split_cols; size_t split_stride; float scale0;
    __device__ __forceinline__ void operator()(const f32x4 (&acc)[2][2][4][2], const Unit& u, int wr, int wc, int fr, int fq) const {
        const int row0 = u.pm * BM + wr * 64 + fr; int colt = u.pn * BM; bf16_t* base = O;
        float sc = 1.f; if (split_cols) { const int t = colt / split_cols; base += (size_t)t * split_stride; colt -= t * split_cols; if (t == 0) sc = scale0; }
        const int col0 = colt + wc * 32 + 8 * fq, bcol0 = u.pn * BM + wc * 32 + 8 * fq;
        f32x4 bv[2][2];
#pragma unroll
        for (int bj = 0; bj < 2; ++bj)
#pragma unroll
            for (int n = 0; n < 2; ++n) bv[bj][n] = bias ? *(const f32x4*)(bias + bcol0 + bj * HALF + 4 * n) : (f32x4){0.f, 0.f, 0.f, 0.f};
#pragma unroll
        for (int ai = 0; ai < 2; ++ai)
#pragma unroll
            for (int m = 0; m < 4; ++m) { bf16_t* rowp = base + (size_t)(row0 + ai * HALF + m * 16) * ldc + col0;
#pragma unroll
                for (int bj = 0; bj < 2; ++bj) { f32x4 v0 = acc[ai][bj][m][0] + bv[bj][0], v1 = acc[ai][bj][m][1] + bv[bj][1];
                    if (ACT == 1) { f32x2 a = gelu_pk((f32x2){v0[0], v0[1]}), b = gelu_pk((f32x2){v0[2], v0[3]}), c = gelu_pk((f32x2){v1[0], v1[1]}), d = gelu_pk((f32x2){v1[2], v1[3]});
                        v0 = (f32x4){a.x, a.y, b.x, b.y}; v1 = (f32x4){c.x, c.y, d.x, d.y}; }
                    v0 = v0 * sc; v1 = v1 * sc; u32x4 w; w.x = cvt_pk_bf16(v0[0], v0[1]); w.y = cvt_pk_bf16(v0[2], v0[3]); w.z = cvt_pk_bf16(v1[0], v1[1]); w.w = cvt_pk_bf16(v1[2], v1[3]);
                    *(u32x4*)(rowp + bj * HALF) = w; } }
    }
};
template <class Epi, class Sched, bool ALIGN_EPI = false, bool SP2 = false>
__device__ __forceinline__ void gemm_phase(PG8_LAS unsigned char* lds, const Gemm g, const Sched& S, const Epi& E) {
    int tid_ = threadIdx.x; asm volatile("" : "+v"(tid_)); const int tid = tid_, wid = __builtin_amdgcn_readfirstlane(tid >> 6), lane = tid & 63, wr = wid >> 2, wc = wid & 3, fr = lane & 15, fq = lane >> 4;
    const int K = g.K, nt = K / BK;
    unsigned voffA[2], voffB[2];
#pragma unroll
    for (int i = 0; i < 2; ++i) { int R, C; stage_rc(tid * 16 + i * 8192, R, C); const int Rb = Epi::PERM ? ((R & ~31) + perm32(R & 31)) : R;
        voffA[i] = (unsigned)(R * K + C) * 2u; voffB[i] = (unsigned)(Rb * K + C) * 2u; }
    const size_t kstep = (size_t)(BK * 2);
    const size_t hstep = (size_t)HALF * K * 2;
    const size_t tstep = 2 * hstep;
    const unsigned ldsw = (unsigned)wid * 1024u;
    const int aoff = lds_byte(wr * 64 + fr, fq * 8), boff = lds_byte(wc * 32 + fr, fq * 8);
#define PG8_SA(b, h) (((b) * 2 + (h)) * HTB)
#define PG8_SB(b, h) ((4 + (b) * 2 + (h)) * HTB)
#define PG8_STAGE(bufoff, gbase, voff) do { _Pragma("unroll") for (int _i = 0; _i < 2; ++_i) \
        __builtin_amdgcn_global_load_lds((const unsigned*)((const char*)(gbase) + (voff)[_i]), (PG8_LAS unsigned*)(lds + (bufoff) + ldsw + _i * 8192), 16, 0, 0); } while (0)
#define PG8_LDA(dst, b, h) do { _Pragma("unroll") for (int m = 0; m < 4; ++m) _Pragma("unroll") for (int k = 0; k < 2; ++k) dst[m][k] = *(const PG8_LAS bf16x8*)(lds + PG8_SA(b, h) + aoff + m * 2048 + k * 1024); } while (0)
#define PG8_LDB(dst, b, h) do { _Pragma("unroll") for (int n = 0; n < 2; ++n) _Pragma("unroll") for (int k = 0; k < 2; ++k) dst[n][k] = *(const PG8_LAS bf16x8*)(lds + PG8_SB(b, h) + boff + n * 2048 + k * 1024); } while (0)
#define PG8_MMA(ai, bj, At, Bt) do { __builtin_amdgcn_s_setprio(1); _Pragma("unroll") for (int m = 0; m < 4; ++m) _Pragma("unroll") for (int n = 0; n < 2; ++n) _Pragma("unroll") for (int k = 0; k < 2; ++k) \
        acc[ai][bj][m][n] = __builtin_amdgcn_mfma_f32_16x16x32_bf16(Bt[n][k], At[m][k], acc[ai][bj][m][n], 0, 0, 0); __builtin_amdgcn_s_setprio(0); } while (0)
#define PG8_WAIT_V(n) asm volatile("s_waitcnt vmcnt(" #n ")" ::: "memory")
#define PG8_WAIT_L(n) asm volatile("s_waitcnt lgkmcnt(" #n ")" ::: "memory")
#define PG8_BAR __builtin_amdgcn_s_barrier()
#define PG8_SCHED __builtin_amdgcn_sched_barrier(0)
    Unit cur, nxt; int ui = 0;
    if (!S.next(0, cur)) return;
    f32x4 acc[2][2][4][2];
#pragma unroll
    for (int a = 0; a < 2; ++a)
#pragma unroll
        for (int b = 0; b < 2; ++b)
#pragma unroll
            for (int m = 0; m < 4; ++m)
#pragma unroll
                for (int n = 0; n < 2; ++n) acc[a][b][m][n] = (f32x4){0.f, 0.f, 0.f, 0.f};
    bf16x8 At[4][2], B0[2][2], B1[2][2];
    const char* cA = (const char*)g.A + (size_t)cur.pm * tstep; const char* cB = (const char*)g.Bt + (size_t)cur.pn * tstep;
    S.a_ready(cur);
    if constexpr (SP2) {
        PG8_STAGE(PG8_SB(0, 0), cB, voffB); PG8_STAGE(PG8_SB(0, 1), cB + hstep, voffB); PG8_STAGE(PG8_SA(0, 0), cA, voffA); PG8_STAGE(PG8_SA(0, 1), cA + hstep, voffA);
        if (wr == 1) PG8_BAR;
        PG8_WAIT_V(2); PG8_BAR;
        PG8_STAGE(PG8_SB(1, 0), cB + kstep, voffB); PG8_STAGE(PG8_SA(1, 0), cA + kstep, voffA); PG8_STAGE(PG8_SB(1, 1), cB + hstep + kstep, voffB);
        PG8_WAIT_V(6); PG8_BAR;
    } else {
        PG8_STAGE(PG8_SB(0, 0), cB, voffB); PG8_STAGE(PG8_SA(0, 0), cA, voffA); PG8_STAGE(PG8_SB(0, 1), cB + hstep, voffB); PG8_STAGE(PG8_SA(0, 1), cA + hstep, voffA);
        if (wr == 1) PG8_BAR;
        PG8_WAIT_V(4); PG8_BAR;
        PG8_STAGE(PG8_SB(1, 0), cB + kstep, voffB); PG8_STAGE(PG8_SA(1, 0), cA + kstep, voffA); PG8_STAGE(PG8_SB(1, 1), cB + hstep + kstep, voffB);
        PG8_WAIT_V(6); PG8_BAR;
    }
    for (;;) {
        const bool has_next = S.next(ui + 1, nxt);
        const char* nA = has_next ? (const char*)g.A + (size_t)nxt.pm * tstep : cA; const char* nB = has_next ? (const char*)g.Bt + (size_t)nxt.pn * tstep : cB;
        for (int t = 0; t < nt; t += 2) {
            const bool last = (t == nt - 2);
            const char* a1 = cA + (size_t)(t + 1) * kstep;
            const char* a2 = last ? nA : cA + (size_t)(t + 2) * kstep; const char* b2 = last ? nB : cB + (size_t)(t + 2) * kstep;
            const char* a3 = a2 + kstep; const char* b3 = b2 + kstep;
            if (last && has_next) S.a_ready(nxt);
            if constexpr (SP2) {
            PG8_LDB(B0, 0, 0); PG8_LDB(B1, 0, 1); PG8_SCHED; PG8_LDA(At, 0, 0); PG8_STAGE(PG8_SA(1, 1), a1 + hstep, voffA);
            PG8_WAIT_V(8); PG8_WAIT_L(0); PG8_BAR; PG8_MMA(0, 0, At, B0); PG8_MMA(0, 1, At, B1); PG8_BAR; PG8_SCHED;
            PG8_LDA(At, 0, 1); PG8_STAGE(PG8_SB(0, 0), b2, voffB); PG8_STAGE(PG8_SB(0, 1), b2 + hstep, voffB); PG8_STAGE(PG8_SA(0, 0), a2, voffA);
            PG8_WAIT_V(8); PG8_WAIT_L(0); PG8_BAR; PG8_MMA(1, 0, At, B0); PG8_MMA(1, 1, At, B1); PG8_BAR; PG8_SCHED;
            PG8_LDB(B0, 1, 0); PG8_LDB(B1, 1, 1); PG8_SCHED; PG8_LDA(At, 1, 0); PG8_STAGE(PG8_SA(0, 1), a2 + hstep, voffA);
            PG8_WAIT_V(8); PG8_WAIT_L(0); PG8_BAR; PG8_MMA(0, 0, At, B0); PG8_MMA(0, 1, At, B1); PG8_BAR; PG8_SCHED;
            PG8_LDA(At, 1, 1); PG8_STAGE(PG8_SB(1, 0), b3, voffB); PG8_STAGE(PG8_SB(1, 1), b3 + hstep, voffB); PG8_STAGE(PG8_SA(1, 0), a3, voffA);
            PG8_WAIT_V(8); PG8_WAIT_L(0); PG8_BAR; PG8_MMA(1, 0, At, B0); PG8_MMA(1, 1, At, B1); PG8_BAR; PG8_SCHED;
            } else {
            PG8_LDB(B0, 0, 0); PG8_SCHED; PG8_LDA(At, 0, 0); PG8_STAGE(PG8_SA(1, 1), a1 + hstep, voffA);
            PG8_WAIT_L(8); PG8_BAR; PG8_WAIT_L(0); PG8_MMA(0, 0, At, B0); PG8_BAR; PG8_SCHED;
            PG8_LDB(B1, 0, 1); PG8_STAGE(PG8_SB(0, 0), b2, voffB);
            PG8_BAR; PG8_WAIT_L(0); PG8_MMA(0, 1, At, B1); PG8_BAR;
            PG8_LDA(At, 0, 1); PG8_STAGE(PG8_SA(0, 0), a2, voffA);
            PG8_BAR; PG8_WAIT_L(0); PG8_MMA(1, 0, At, B0); PG8_BAR; PG8_SCHED;
            PG8_STAGE(PG8_SB(0, 1), b2 + hstep, voffB);
            PG8_WAIT_V(6); PG8_BAR; PG8_MMA(1, 1, At, B1); PG8_BAR;
            PG8_LDB(B0, 1, 0); PG8_SCHED; PG8_LDA(At, 1, 0); PG8_STAGE(PG8_SA(0, 1), a2 + hstep, voffA);
            PG8_WAIT_L(8); PG8_BAR; PG8_WAIT_L(0); PG8_MMA(0, 0, At, B0); PG8_BAR; PG8_SCHED;
            PG8_LDB(B1, 1, 1); PG8_STAGE(PG8_SB(1, 0), b3, voffB);
            PG8_BAR; PG8_WAIT_L(0); PG8_MMA(0, 1, At, B1); PG8_BAR;
            PG8_LDA(At, 1, 1); PG8_STAGE(PG8_SA(1, 0), a3, voffA);
            PG8_BAR; PG8_WAIT_L(0); PG8_MMA(1, 0, At, B0); PG8_BAR; PG8_SCHED;
            PG8_STAGE(PG8_SB(1, 1), b3 + hstep, voffB);
            PG8_WAIT_V(6); PG8_BAR; PG8_MMA(1, 1, At, B1); PG8_BAR;
            }
        }
        if constexpr (ALIGN_EPI) { if (wr == 0) PG8_BAR; }
        if constexpr (!Epi::AFTER_DRAIN) { E(acc, cur, wr, wc, fr, fq); S.done(cur); }
        if (!has_next) break;
#pragma unroll
        for (int a = 0; a < 2; ++a)
#pragma unroll
            for (int b = 0; b < 2; ++b)
#pragma unroll
                for (int m = 0; m < 4; ++m)
#pragma unroll
                    for (int n = 0; n < 2; ++n) acc[a][b][m][n] = (f32x4){0.f, 0.f, 0.f, 0.f};
        cur = nxt; cA = nA; cB = nB; ++ui;
        if constexpr (ALIGN_EPI) { if (wr == 1) PG8_BAR; }
    }
    PG8_WAIT_V(0);
    if constexpr (!ALIGN_EPI) { if (wr == 0) PG8_BAR; }
    PG8_BAR;
    if constexpr (Epi::AFTER_DRAIN) { E.fused(acc, cur, wr, wc, fr, fq, lds, wid, lane); S.done(cur); }
#undef PG8_SA
#undef PG8_SB
#undef PG8_STAGE
#undef PG8_LDA
#undef PG8_LDB
#undef PG8_MMA
#undef PG8_WAIT_V
#undef PG8_WAIT_L
#undef PG8_BAR
#undef PG8_SCHED
}
}

constexpr int BATCH = 8, SEQ = 8192, DM = 1024, DEPTH = 4, GWID = 256, NHEAD = 4, HDIM = 64, INW = 2816, CHUNK = 128, DFF = 2816;
constexpr int M = BATCH * SEQ;
constexpr int NCH = SEQ / CHUNK;
constexpr int NCHUNK = M / CHUNK;
constexpr float LN_EPS = 1e-5f;
constexpr float DN_ALPHA = 1.6817928305074290f;
constexpr int ZC_AU = 0, ZC_AV = 256, ZC_RQ = 512, ZC_RK = 768, ZC_RV = 1024, ZC_RG = 1280, ZC_CX = 1536, ZC_CG = 1792, ZC_DB = 2048, ZC_DC = 2304, ZC_DH = 2560;

#define LAS __attribute__((address_space(3)))
typedef unsigned short bf16;
typedef short bf16x8 __attribute__((ext_vector_type(8)));
typedef float f32x4 __attribute__((ext_vector_type(4)));
typedef unsigned u32x4 __attribute__((ext_vector_type(4)));
typedef unsigned u32x2 __attribute__((ext_vector_type(2)));

constexpr size_t SZ_WIN = (size_t)INW * DM * 2, SZ_WOUT = (size_t)DM * DM * 2, SZ_WGU = (size_t)2 * DFF * DM * 2, SZ_WD = (size_t)DM * DFF * 2, SZ_LRUW = (size_t)16 * 4096 * 2;
constexpr size_t OFF_WIN = 0;
constexpr size_t OFF_WOUT = OFF_WIN + DEPTH * SZ_WIN;
constexpr size_t OFF_WGU = OFF_WOUT + DEPTH * SZ_WOUT;
constexpr size_t OFF_WD = OFF_WGU + DEPTH * SZ_WGU;
constexpr size_t OFF_LRUW = OFF_WD + DEPTH * SZ_WD;
constexpr size_t OFF_XB = OFF_LRUW + DEPTH * SZ_LRUW;
constexpr size_t OFF_Z = OFF_XB + (size_t)M * DM * 2;
constexpr size_t OFF_Y = OFF_Z + (size_t)M * INW * 2;
constexpr size_t OFF_UF = OFF_Y + (size_t)M * DM * 2;
constexpr size_t USTRIDE = (size_t)BATCH * NHEAD * 4096;
constexpr size_t OFF_UB = OFF_UF + (size_t)NCH * USTRIDE * 2;
constexpr size_t OFF_CA = OFF_UB + (size_t)NCH * USTRIDE * 2;
constexpr size_t OFF_CH = OFF_CA + (size_t)BATCH * NCH * 512 * 4;
constexpr size_t OFF_SP = OFF_CH + (size_t)BATCH * NCH * 512 * 4;
constexpr size_t OFF_S1 = OFF_SP + (size_t)3 * DEPTH * 2 * GWID * 4;
constexpr size_t OFF_T1 = OFF_S1 + (size_t)DEPTH * INW * 4;
constexpr size_t OFF_S3 = OFF_T1 + (size_t)DEPTH * INW * 4;
constexpr size_t OFF_T3 = OFF_S3 + (size_t)DEPTH * 2 * DFF * 4;
constexpr size_t OFF_WSB = OFF_T3 + (size_t)DEPTH * 2 * DFF * 4;
constexpr size_t OFF_P0 = OFF_WSB + (size_t)DEPTH * NHEAD * CHUNK * CHUNK * 2;
constexpr size_t OFF_P1 = OFF_P0 + (size_t)M * 2 * 8;
constexpr size_t OFF_CTL = OFF_P1 + (size_t)M * 2 * 8;
constexpr size_t CTL_BYTES = 16384;
constexpr size_t WS_END = OFF_CTL + CTL_BYTES;
constexpr int LDS_MISC_OFF = 131072, LDS_GB_OFF = 131072 + 256, LDS_BYTES = 131072 + 256 + 8192;

__device__ __forceinline__ float bflo(unsigned w) { return __uint_as_float(w << 16); }
__device__ __forceinline__ float bfhi(unsigned w) { return __uint_as_float(w & 0xffff0000u); }
__device__ __forceinline__ void unpack8(const u32x4 w, float* f) { f[0] = bflo(w.x); f[1] = bfhi(w.x); f[2] = bflo(w.y); f[3] = bfhi(w.y); f[4] = bflo(w.z); f[5] = bfhi(w.z); f[6] = bflo(w.w); f[7] = bfhi(w.w); }
__device__ __forceinline__ void unpack4(const u32x2 w, float* f) { f[0] = bflo(w.x); f[1] = bfhi(w.x); f[2] = bflo(w.y); f[3] = bfhi(w.y); }
__device__ __forceinline__ unsigned pk2(float lo, float hi) { return pg8::cvt_pk_bf16(lo, hi); }
__device__ __forceinline__ bf16 f2bf(float x) { return (bf16)(pg8::cvt_pk_bf16(x, 0.f) & 0xffffu); }
__device__ __forceinline__ u32x4 pack8(const float* f) { u32x4 w; w.x = pk2(f[0], f[1]); w.y = pk2(f[2], f[3]); w.z = pk2(f[4], f[5]); w.w = pk2(f[6], f[7]); return w; }
__device__ __forceinline__ float sigmoid_f(float x) { return __builtin_amdgcn_rcpf(1.0f + __expf(-x)); }
__device__ __forceinline__ float silu_f(float x) { return x * sigmoid_f(x); }
__device__ __forceinline__ float gelu_f(float x) { return x * sigmoid_f(1.5957691216057308f * (x + 0.044715f * x * x * x)); }
__device__ __forceinline__ float log_gamma_h(int h) { return h == 0 ? -0.0317486983145803f : (h == 1 ? -0.015748356968139168f : (h == 2 ? -0.007843177461025893f : -0.003913899321136329f)); }
__device__ __forceinline__ void rope_cs(float pos, int i, float& c, float& s) {
    const float invf = exp2f(-(float)i * 0.4152410118609203f);
    const float ang = pos * invf;
    const float n = rintf(ang * 0.15915494309189535f);
    float r = fmaf(-n, 6.2831854820251465f, ang); r = fmaf(-n, -1.7484555e-7f, r);
    const float rv = r * 0.15915494309189535f;
    s = __builtin_amdgcn_sinf(rv); c = __builtin_amdgcn_cosf(rv);
}
__device__ __forceinline__ float neg_expm1_f(float x) {
    const float p = -x * (1.0f + x * (0.5f + x * (0.16666667f + x * (0.041666668f + x * 0.0083333338f))));
    return x > -0.25f ? p : 1.0f - __expf(x);
}
#define MFMA16(a, b, c) __builtin_amdgcn_mfma_f32_16x16x32_bf16((a), (b), (c), 0, 0, 0)
template <int CTRL> __device__ __forceinline__ float dpp_f(float oldv, float src) { return __int_as_float(__builtin_amdgcn_update_dpp(__float_as_int(oldv), __float_as_int(src), CTRL, 0xf, 0xf, false)); }

#ifndef EPI_RB
#define EPI_RB 4
#endif
typedef long long i64x2 __attribute__((ext_vector_type(2)));
__device__ __forceinline__ float fx2f(long long v) { return (float)(int)(v >> 32) + (float)(unsigned)v * 2.3283064365386963e-10f; }
__device__ __forceinline__ void row_stats_fin(const i64x2 v, float& mu, float& rs) { mu = fx2f(v.x) * (1.f / DM); const float var = fmaxf(fx2f(v.y) * (1.f / DM) - mu * mu, 0.f); rs = __builtin_amdgcn_rsqf(var + LN_EPS); }
__device__ __forceinline__ void row_stats8(const long long* P, int row0, float (&mu8)[8], float (&rs8)[8]) {
    i64x2 raw[8];
#pragma unroll
    for (int q = 0; q < 8; ++q) raw[q] = *(const i64x2*)(P + 2 * (size_t)(row0 + (q >> 2) * 128 + (q & 3) * 16));
    asm volatile("" ::: "memory");
#pragma unroll
    for (int q = 0; q < 8; ++q) row_stats_fin(raw[q], mu8[q], rs8[q]);
}
__device__ __forceinline__ void row_stats(const long long* P, int row, float& mu, float& rs) {
    const i64x2 v = *(const i64x2*)(P + 2 * (size_t)row); mu = fx2f(v.x) * (1.f / DM); const float var = fmaxf(fx2f(v.y) * (1.f / DM) - mu * mu, 0.f); rs = __builtin_amdgcn_rsqf(var + LN_EPS);
}
struct EpiLnBf16 {
    static constexpr bool PERM = true, AFTER_DRAIN = false;
    bf16* O; int ldc; const long long* P; const float* S; const float* T; int fold;
    __device__ __forceinline__ void operator()(const pg8::f32x4 (&acc)[2][2][4][2], const pg8::Unit& u, int wr, int wc, int fr, int fq) const {
        const int row0 = u.pm * 256 + wr * 64 + fr, col0 = u.pn * 256 + wc * 32 + 8 * fq;
        f32x4 sv[2][2], tv[2][2];
#pragma unroll
        for (int bj = 0; bj < 2; ++bj)
#pragma unroll
            for (int n = 0; n < 2; ++n) { sv[bj][n] = fold ? *(const f32x4*)(S + col0 + bj * 128 + 4 * n) : (f32x4){0.f, 0.f, 0.f, 0.f}; tv[bj][n] = fold ? *(const f32x4*)(T + col0 + bj * 128 + 4 * n) : (f32x4){0.f, 0.f, 0.f, 0.f}; }
        float mu8[8], rs8[8];
#pragma unroll
        for (int q = 0; q < 8; ++q) { mu8[q] = 0.f; rs8[q] = 1.f; }
        if (fold) row_stats8(P, row0, mu8, rs8);
#pragma unroll
        for (int ai = 0; ai < 2; ++ai)
#pragma unroll
            for (int m = 0; m < 4; ++m) { const int row = row0 + ai * 128 + m * 16; const float mu = mu8[ai * 4 + m], rs = rs8[ai * 4 + m];
                bf16* rowp = O + (size_t)row * ldc + col0;
#pragma unroll
                for (int bj = 0; bj < 2; ++bj) { const f32x4 v0 = (acc[ai][bj][m][0] - sv[bj][0] * mu) * rs + tv[bj][0], v1 = (acc[ai][bj][m][1] - sv[bj][1] * mu) * rs + tv[bj][1];
                    u32x4 w; w.x = pk2(v0[0], v0[1]); w.y = pk2(v0[2], v0[3]); w.z = pk2(v1[0], v1[1]); w.w = pk2(v1[2], v1[3]);
                    *(u32x4*)(rowp + bj * 128) = w; } }
    }
};
struct EpiSwiGLU {
    static constexpr bool PERM = true, AFTER_DRAIN = false;
    bf16* O; const long long* P; const float* S; const float* T;
    __device__ __forceinline__ void operator()(const pg8::f32x4 (&acc)[2][2][4][2], const pg8::Unit& u, int wr, int wc, int fr, int fq) const {
        const int row0 = u.pm * 256 + wr * 64 + fr, col0 = u.pn * 128 + wc * 32 + 8 * fq, gcol0 = u.pn * 256 + wc * 32 + 8 * fq;
        f32x4 sv[2][2], tv[2][2];
#pragma unroll
        for (int bj = 0; bj < 2; ++bj)
#pragma unroll
            for (int n = 0; n < 2; ++n) { sv[bj][n] = *(const f32x4*)(S + gcol0 + bj * 128 + 4 * n); tv[bj][n] = *(const f32x4*)(T + gcol0 + bj * 128 + 4 * n); }
        float mu8[8], rs8[8];
        row_stats8(P, row0, mu8, rs8);
#pragma unroll
        for (int ai = 0; ai < 2; ++ai)
#pragma unroll
            for (int m = 0; m < 4; ++m) { const int row = row0 + ai * 128 + m * 16; const float mu = mu8[ai * 4 + m], rs = rs8[ai * 4 + m];
                bf16* rowp = O + (size_t)row * DFF + col0;
                const f32x4 g0 = (acc[ai][0][m][0] - sv[0][0] * mu) * rs + tv[0][0], g1 = (acc[ai][0][m][1] - sv[0][1] * mu) * rs + tv[0][1];
                const f32x4 u0 = (acc[ai][1][m][0] - sv[1][0] * mu) * rs + tv[1][0], u1 = (acc[ai][1][m][1] - sv[1][1] * mu) * rs + tv[1][1];
#define SWG(gv, uv, j) ((gv[j] * uv[j]) * __builtin_amdgcn_rcpf(1.0f + __builtin_amdgcn_exp2f(gv[j])))
                u32x4 w; w.x = pk2(SWG(g0, u0, 0), SWG(g0, u0, 1)); w.y = pk2(SWG(g0, u0, 2), SWG(g0, u0, 3));
                w.z = pk2(SWG(g1, u1, 0), SWG(g1, u1, 1)); w.w = pk2(SWG(g1, u1, 2), SWG(g1, u1, 3));
#undef SWG
                *(u32x4*)rowp = w; }
    }
};
template <int RAW> struct EpiResLn {
    static constexpr bool PERM = true, AFTER_DRAIN = false;
    const float* resf; float* outf; const bf16* xb; bf16* xbo; const long long* Pin; const LAS float* gb; long long* Pout; int wf32; float alpha;
    __device__ __forceinline__ void operator()(const pg8::f32x4 (&acc)[2][2][4][2], const pg8::Unit& u, int wr, int wc, int fr, int fq) const {
        const int row0 = u.pm * 256 + wr * 64 + fr, col0 = u.pn * 256 + wc * 32 + 8 * fq;
#pragma unroll
        for (int gq = 0; gq < 8 / EPI_RB; ++gq) {
            u32x4 sw[EPI_RB][2]; float mu[EPI_RB], rs[EPI_RB];
#pragma unroll
            for (int mm = 0; mm < EPI_RB; ++mm) { const int q = gq * EPI_RB + mm, row = row0 + (q >> 2) * 128 + (q & 3) * 16;
                mu[mm] = 0.f; rs[mm] = 1.f;
                if (!RAW) { row_stats(Pin, row, mu[mm], rs[mm]);
#pragma unroll
                    for (int bj = 0; bj < 2; ++bj) sw[mm][bj] = *(const u32x4*)(xb + (size_t)row * DM + col0 + bj * 128); } }
#pragma unroll
            for (int mm = 0; mm < EPI_RB; ++mm) { const int q = gq * EPI_RB + mm, ai = q >> 2, m = q & 3; const int row = row0 + ai * 128 + m * 16; const size_t off = (size_t)row * DM + col0;
                float sm = 0.f, sq = 0.f;
#pragma unroll
                for (int bj = 0; bj < 2; ++bj) { f32x4 v[2];
#pragma unroll
                    for (int n = 0; n < 2; ++n) { f32x4 r;
                        if (RAW) r = *(const f32x4*)(resf + off + bj * 128 + 4 * n);
                        else { const u32x4 w = sw[mm][bj]; r = n ? (f32x4){bflo(w.z), bfhi(w.z), bflo(w.w), bfhi(w.w)} : (f32x4){bflo(w.x), bfhi(w.x), bflo(w.y), bfhi(w.y)}; }
                        const f32x4 gvv = *(const LAS f32x4*)(gb + col0 + bj * 128 + 4 * n), bvv = *(const LAS f32x4*)(gb + DM + col0 + bj * 128 + 4 * n);
                        const f32x4 rr = (r - mu[mm]) * rs[mm] * gvv + bvv;
                        v[n] = rr * alpha + acc[ai][bj][m][n];
                        if (wf32) *(f32x4*)(outf + off + bj * 128 + 4 * n) = v[n];
                        sm += (v[n][0] + v[n][1]) + (v[n][2] + v[n][3]); sq += (v[n][0] * v[n][0] + v[n][1] * v[n][1]) + (v[n][2] * v[n][2] + v[n][3] * v[n][3]); }
                    u32x4 w; w.x = pk2(v[0][0], v[0][1]); w.y = pk2(v[0][2], v[0][3]); w.z = pk2(v[1][0], v[1][1]); w.w = pk2(v[1][2], v[1][3]);
                    if (!wf32) *(u32x4*)(xbo + off + bj * 128) = w; }
                sm += __shfl_xor(sm, 16); sm += __shfl_xor(sm, 32); sq += __shfl_xor(sq, 16); sq += __shfl_xor(sq, 32);
                if (fq == 0) { __hip_atomic_fetch_add(Pout + 2 * (size_t)row, (long long)(sm * 4294967296.0f), __ATOMIC_RELAXED, __HIP_MEMORY_SCOPE_AGENT); __hip_atomic_fetch_add(Pout + 2 * (size_t)row + 1, (long long)(sq * 4294967296.0f), __ATOMIC_RELAXED, __HIP_MEMORY_SCOPE_AGENT); } }
            asm volatile("" ::: "memory");
        }
    }
};
__device__ __forceinline__ void stage_gain_bias(LAS float* gb, const float* g, const float* b, int raw) {
    int tid_ = threadIdx.x; asm volatile("" : "+v"(tid_));
    const int i = tid_ & 255; const bool isb = tid_ >= 256;
    f32x4 v = raw ? (isb ? (f32x4){0.f, 0.f, 0.f, 0.f} : (f32x4){1.f, 1.f, 1.f, 1.f}) : *((const f32x4*)(isb ? b : g) + i);
    *((LAS f32x4*)(gb + (isb ? DM : 0)) + i) = v;
    __syncthreads();
}

struct Args { const void* in[25]; float* out; unsigned char* ws; };
struct Ctx {
    const float* x; const int* pos; const float* w_in; const float* gmlp_ln_g; const float* gmlp_ln_b; const float* gmlp_ws; const float* gmlp_bs; const float* ret_gn_g; const float* ret_gn_b;
    const float* lru_conv_w; const float* lru_conv_b; const float* lru_wa; const float* lru_ba; const float* lru_wx; const float* lru_bx; const float* lru_lambda; const float* sc_conv_w;
    const float* w_out; const float* ln1_g; const float* ln1_b; const float* ffn_wg; const float* ffn_wu; const float* ffn_wd; const float* ln2_g; const float* ln2_b;
    float* out; bf16 *WIN, *WOUT, *WGU, *WD, *LRUW, *XB, *Z, *Y, *UF, *UB; float *CA, *CH, *SP, *BA2, *BX2, *S1, *T1, *S3, *T3; long long *P0, *P1; bf16* WSB;
};

__device__ __forceinline__ void tr_item(const float* W, int N, bf16* dst_rows, int ldt, int k0, int n0, LAS float* scr, int lane, const float* gs = nullptr, float sc = 1.0f) {
#pragma unroll 16
    for (int i = 0; i < 32; ++i) { const int kk = 2 * i + (lane >> 5); scr[kk * 33 + (lane & 31)] = W[(size_t)(k0 + kk) * N + n0 + (lane & 31)] * (gs ? gs[k0 + kk] * sc : sc); }
    asm volatile("s_waitcnt lgkmcnt(0)" ::: "memory");
    const int c = lane & 7;
#pragma unroll
    for (int j = 0; j < 4; ++j) { const int n = (lane >> 3) + 8 * j; const LAS float* s = scr + (8 * c) * 33 + n;
        u32x4 o; o.x = pk2(s[0 * 33], s[1 * 33]); o.y = pk2(s[2 * 33], s[3 * 33]); o.z = pk2(s[4 * 33], s[5 * 33]); o.w = pk2(s[6 * 33], s[7 * 33]);
        *(u32x4*)(dst_rows + (size_t)n * ldt + k0 + 8 * c) = o; }
    asm volatile("s_waitcnt lgkmcnt(0)" ::: "memory");
}
__device__ __forceinline__ void prologue(const Ctx& C, LAS unsigned char* lds) {
    int tid_ = threadIdx.x; asm volatile("" : "+v"(tid_)); const int tid = tid_, lane = tid & 63, wave = tid >> 6;
    LAS float* scr = (LAS float*)(lds + wave * 16384);
    const int gw = blockIdx.x * 8 + wave, NGW = gridDim.x * 8;
    constexpr int I_IN = (DM / 64) * (INW / 32), I_OUT = (DM / 64) * (DM / 32), I_G = (DM / 64) * (DFF / 32), I_D = (DFF / 64) * (DM / 32), I_L = 8 * 2;
    constexpr int PER_LAYER = I_IN + I_OUT + 2 * I_G + I_D + 2 * I_L;
    for (int it = gw; it < DEPTH * PER_LAYER; it += NGW) {
        const int l = it / PER_LAYER; int r = it % PER_LAYER;
        if (r < I_IN) { const int nb = INW / 32, k0 = 64 * (r / nb), n0 = 32 * (r % nb); tr_item(C.w_in + (size_t)l * DM * INW, INW, C.WIN + (size_t)l * INW * DM + (size_t)n0 * DM, DM, k0, n0, scr, lane, l ? C.ln2_g + (l - 1) * DM : nullptr); continue; } r -= I_IN;
        if (r < I_OUT) { const int nb = DM / 32, k0 = 64 * (r / nb), n0 = 32 * (r % nb); tr_item(C.w_out + (size_t)l * DM * DM, DM, C.WOUT + (size_t)l * DM * DM + (size_t)n0 * DM, DM, k0, n0, scr, lane); continue; } r -= I_OUT;
        if (r < 2 * I_G) { const int up = r >= I_G; if (up) r -= I_G; const int nb = DFF / 32, k0 = 64 * (r / nb), n0 = 32 * (r % nb); const int drow = 256 * (n0 / 128) + (n0 % 128) + (up ? 128 : 0);
            tr_item((up ? C.ffn_wu : C.ffn_wg) + (size_t)l * DM * DFF, DFF, C.WGU + (size_t)l * 2 * DFF * DM + (size_t)drow * DM, DM, k0, n0, scr, lane, C.ln1_g + l * DM, up ? -0.6931471805599453f : -1.4426950408889634f); continue; } r -= 2 * I_G;
        if (r < I_D) { const int nb = DM / 32, k0 = 64 * (r / nb), n0 = 32 * (r % nb); tr_item(C.ffn_wd + (size_t)l * DFF * DM, DM, C.WD + (size_t)l * DM * DFF + (size_t)n0 * DFF, DFF, k0, n0, scr, lane); continue; } r -= I_D;
        { const int which = r >= I_L; if (which) r -= I_L; const int mat = r >> 1, n0 = 32 * (r & 1);
          tr_item((which ? C.lru_wx : C.lru_wa) + ((size_t)l * 8 + mat) * 4096, 64, C.LRUW + (((size_t)l * 2 + which) * 8 + mat) * 4096 + (size_t)n0 * 64, 64, 0, n0, scr, lane, nullptr, -1.4426950408889634f); }
    }
    __syncthreads();
    {
        LAS float* red = (LAS float*)lds;
#pragma unroll 1
        for (int task = blockIdx.x; task < DEPTH * 66; task += gridDim.x) {
            const int l = task / 66, r = task % 66, kind = r / 22, cb = r % 22;
            if (kind == 0 && l == 0) continue;
            const float *pw0 = C.w_in, *pw1 = C.ffn_wg, *pw2 = C.ffn_wu, *pg0 = C.ln2_g, *pg1 = C.ln1_g, *pb0 = C.ln2_b, *pb1 = C.ln1_b;
            asm volatile("" : "+s"(pw0), "+s"(pw1), "+s"(pw2), "+s"(pg0), "+s"(pg1), "+s"(pb0), "+s"(pb1));
            const float* W = (kind == 0 ? pw0 : (kind == 1 ? pw1 : pw2)) + (size_t)l * DM * INW;
            const float* gk = kind == 0 ? pg0 + (l - 1) * DM : pg1 + l * DM; const float* bk = kind == 0 ? pb0 + (l - 1) * DM : pb1 + l * DM;
            const int col = cb * 128 + (tid & 127), slice = tid >> 7;
            const float wsc = kind == 0 ? 1.0f : (kind == 1 ? -1.4426950408889634f : -0.6931471805599453f);
            float sa = 0.f, ta = 0.f;
#pragma unroll 16
            for (int k = slice * 256; k < slice * 256 + 256; ++k) { const float wv = W[(size_t)k * INW + col] * wsc; sa += bflo(pk2(gk[k] * wv, 0.f)); ta += bk[k] * wv; }
            red[tid * 2] = sa; red[tid * 2 + 1] = ta;
            __syncthreads();
            if (tid < 128) { const float ss = (red[tid * 2] + red[(tid + 128) * 2]) + (red[(tid + 256) * 2] + red[(tid + 384) * 2]);
                const float tt = (red[tid * 2 + 1] + red[(tid + 128) * 2 + 1]) + (red[(tid + 256) * 2 + 1] + red[(tid + 384) * 2 + 1]);
                if (kind == 0) { C.S1[l * INW + cb * 128 + tid] = ss; C.T1[l * INW + cb * 128 + tid] = tt; }
                else { const int d = l * 2 * DFF + 256 * cb + (kind == 2 ? 128 : 0) + tid; C.S3[d] = ss; C.T3[d] = tt; } }
            __syncthreads();
        }
    }
    if (blockIdx.x * 512 + tid < DEPTH * 2 * GWID) { const int i = blockIdx.x * 512 + tid;
        C.SP[i] = -8.0f * 1.4426950408889634f * log1pf(expf(-C.lru_lambda[i])); C.BA2[i] = -1.4426950408889634f * C.lru_ba[i]; C.BX2[i] = -1.4426950408889634f * C.lru_bx[i]; }
    for (size_t i = (size_t)blockIdx.x * 512 + tid; i < (size_t)DEPTH * NHEAD * CHUNK * CHUNK / 8; i += (size_t)gridDim.x * 512) { const f32x4 a = *(const f32x4*)(C.gmlp_ws + i * 8), b4 = *(const f32x4*)(C.gmlp_ws + i * 8 + 4);
        u32x4 o; o.x = pk2(a[0], a[1]); o.y = pk2(a[2], a[3]); o.z = pk2(b4[0], b4[1]); o.w = pk2(b4[2], b4[3]); *(u32x4*)(C.WSB + i * 8) = o; }
    const size_t gt = (size_t)blockIdx.x * 512 + tid, NT = (size_t)gridDim.x * 512;
#pragma unroll 4
    for (size_t i = gt; i < (size_t)M * DM / 8; i += NT) { const f32x4 a = *(const f32x4*)(C.x + i * 8), b = *(const f32x4*)(C.x + i * 8 + 4);
        u32x4 o; o.x = pk2(a[0], a[1]); o.y = pk2(a[2], a[3]); o.z = pk2(b[0], b[1]); o.w = pk2(b[2], b[3]); *(u32x4*)(C.XB + i * 8) = o; }
}

__device__ __forceinline__ float wave_sum(float v) {
#pragma unroll
    for (int o = 1; o < 64; o <<= 1) v += __shfl_xor(v, o);
    return v;
}
__device__ __forceinline__ void final_ln(float* X, const long long* P, const float* g, const float* b) {
    int tid_ = threadIdx.x; asm volatile("" : "+v"(tid_)); const int lane = tid_ & 63, wave = tid_ >> 6;
    const int gw = blockIdx.x * 8 + wave, NGW = gridDim.x * 8;
    f32x4 gv[4], bv[4];
#pragma unroll
    for (int j = 0; j < 4; ++j) { gv[j] = *((const f32x4*)g + lane + 64 * j); bv[j] = *((const f32x4*)b + lane + 64 * j); }
    for (int m = gw; m < M; m += NGW) { f32x4* xr = (f32x4*)(X + (size_t)m * DM) + lane; float mu, rs; row_stats(P, m, mu, rs);
#pragma unroll
        for (int j = 0; j < 4; ++j) xr[64 * j] = (xr[64 * j] - mu) * rs * gv[j] + bv[j]; }
}
__device__ __forceinline__ void zero_rows(long long* P) {
    int tid_ = threadIdx.x; asm volatile("" : "+v"(tid_));
    for (int i = blockIdx.x * 512 + tid_; i < M * 2 * 8 / 16; i += gridDim.x * 512) *((f32x4*)P + i) = (f32x4){0.f, 0.f, 0.f, 0.f};
    asm volatile("s_waitcnt vmcnt(0)" ::: "memory");
}

__device__ __forceinline__ void gmlp_chunk(const Ctx& C, int l, int chunk, LAS unsigned char* lds) {
    int tid_ = threadIdx.x; asm volatile("" : "+v"(tid_)); const int tid = tid_, lane = tid & 63, w = tid >> 6, fr = lane & 15, fq = lane >> 4;
    LAS bf16* vnT = (LAS bf16*)lds;
    const int row0 = chunk * CHUNK;
    {
        const int t = tid >> 2, q4 = tid & 3;
        const bf16* src = C.Z + (size_t)(row0 + t) * INW + ZC_AV + 64 * q4;
        float v[64]; float s = 0.f;
#pragma unroll
        for (int i = 0; i < 8; ++i) { const u32x4 wv = *(const u32x4*)(src + 8 * i); float f[8]; unpack8(wv, f);
#pragma unroll
            for (int j = 0; j < 8; ++j) { v[8 * i + j] = gelu_f(f[j]); s += v[8 * i + j]; } }
        s += __shfl_xor(s, 1); s += __shfl_xor(s, 2);
        const float mean = s * (1.f / 256.f); float q = 0.f;
#pragma unroll
        for (int i = 0; i < 64; ++i) { v[i] -= mean; q += v[i] * v[i]; }
        q += __shfl_xor(q, 1); q += __shfl_xor(q, 2);
        const float rstd = 1.f / sqrtf(q * (1.f / 256.f) + LN_EPS);
        const f32x4* g4 = (const f32x4*)(C.gmlp_ln_g + l * GWID + 64 * q4); const f32x4* b4 = (const f32x4*)(C.gmlp_ln_b + l * GWID + 64 * q4);
        f32x4 gg[16], bv[16];
#pragma unroll
        for (int i4 = 0; i4 < 16; ++i4) { gg[i4] = g4[i4]; bv[i4] = b4[i4]; }
        const int tt = t ^ (16 * q4);
#pragma unroll
        for (int i4 = 0; i4 < 16; ++i4) {
            const unsigned w0 = pk2(v[4 * i4] * rstd * gg[i4][0] + bv[i4][0], v[4 * i4 + 1] * rstd * gg[i4][1] + bv[i4][1]), w1 = pk2(v[4 * i4 + 2] * rstd * gg[i4][2] + bv[i4][2], v[4 * i4 + 3] * rstd * gg[i4][3] + bv[i4][3]);
            LAS bf16* dst = vnT + (64 * q4 + 4 * i4) * 136 + tt;
            dst[0] = (bf16)(w0 & 0xffffu); dst[136] = (bf16)(w0 >> 16); dst[2 * 136] = (bf16)(w1 & 0xffffu); dst[3 * 136] = (bf16)(w1 >> 16); }
    }
    __syncthreads();
    {
        const int p = 16 * w + fr;
        u32x2 uw[NHEAD][4];
#pragma unroll
        for (int h = 0; h < NHEAD; ++h)
#pragma unroll
            for (int nt = 0; nt < 4; ++nt) uw[h][nt] = *(const u32x2*)(C.Z + (size_t)(row0 + p) * INW + ZC_AU + 64 * h + 16 * nt + 4 * fq);
#pragma unroll
        for (int h = 0; h < NHEAD; ++h) {
            f32x4 acc[4];
#pragma unroll
            for (int nt = 0; nt < 4; ++nt) acc[nt] = (f32x4){0.f, 0.f, 0.f, 0.f};
            const bf16* wsrow = C.WSB + ((size_t)(l * NHEAD + h) * CHUNK + p) * CHUNK;
            bf16x8 af[4];
#pragma unroll
            for (int ks = 0; ks < 4; ++ks) af[ks] = *(const bf16x8*)(wsrow + 32 * ks + 8 * fq);
#pragma unroll
            for (int ks = 0; ks < 4; ++ks)
#pragma unroll
                for (int nt = 0; nt < 4; ++nt) { const bf16x8 bfg = *(const LAS bf16x8*)(vnT + (64 * h + 16 * nt + fr) * 136 + 8 * ((4 * ks + fq) ^ (2 * h))); acc[nt] = MFMA16(bfg, af[ks], acc[nt]); }
            const float bias = C.gmlp_bs[(l * NHEAD + h) * CHUNK + p];
#pragma unroll
            for (int nt = 0; nt < 4; ++nt) { const int c = 64 * h + 16 * nt + 4 * fq;
                float uf[4]; unpack4(uw[h][nt], uf);
                u32x2 o; o.x = pk2(gelu_f(uf[0]) * (acc[nt][0] + bias), gelu_f(uf[1]) * (acc[nt][1] + bias)); o.y = pk2(gelu_f(uf[2]) * (acc[nt][2] + bias), gelu_f(uf[3]) * (acc[nt][3] + bias));
                *(u32x2*)(C.Y + (size_t)(row0 + p) * DM + 0 + c) = o; }
        }
    }
    __syncthreads();
}

__device__ __forceinline__ void ret_pass1(const Ctx& C, int chunk, LAS unsigned char* lds) {
    int tid_ = threadIdx.x; asm volatile("" : "+v"(tid_)); const int tid = tid_, lane = tid & 63, w = tid >> 6, fr = lane & 15, fq = lane >> 4;
    LAS bf16* vT = (LAS bf16*)lds; LAS bf16* kfT = vT + 64 * 136; LAS bf16* kbT = kfT + 64 * 136;
    const int b = chunk >> 6, n = chunk & 63, row0 = chunk * CHUNK;
    const int j = tid >> 2, sub = tid & 3;
    const bf16* zrow = C.Z + (size_t)(row0 + j) * INW;
    u32x4 k1w = *(const u32x4*)(zrow + ZC_RK + 8 * sub), k2w = *(const u32x4*)(zrow + ZC_RK + 32 + 8 * sub);
    u32x4 v1w = *(const u32x4*)(zrow + ZC_RV + 16 * sub), v2w = *(const u32x4*)(zrow + ZC_RV + 16 * sub + 8);
    float cs[8], sn[8];
    { const float pos = (float)C.pos[row0 + j];
#pragma unroll
      for (int ii = 0; ii < 8; ++ii) rope_cs(pos, 8 * sub + ii, cs[ii], sn[ii]); }
#pragma unroll 1
    for (int h = 0; h < NHEAD; ++h) {
        {
            const float lgm = log_gamma_h(h);
            const float decf = __expf(lgm * (float)(CHUNK - 1 - j)) * 0.125f, decb = __expf(lgm * (float)j) * 0.125f;
            float k1[8], k2[8]; unpack8(k1w, k1); unpack8(k2w, k2);
#pragma unroll
            for (int ii = 0; ii < 8; ++ii) { const int i = 8 * sub + ii;
                const float r1 = k1[ii] * cs[ii] - k2[ii] * sn[ii], r2 = k2[ii] * cs[ii] + k1[ii] * sn[ii];
                kfT[i * 136 + j] = f2bf(r1 * decf); kfT[(32 + i) * 136 + j] = f2bf(r2 * decf);
                kbT[i * 136 + j] = f2bf(r1 * decb); kbT[(32 + i) * 136 + j] = f2bf(r2 * decb); }
            const unsigned vw[8] = {v1w.x, v1w.y, v1w.z, v1w.w, v2w.x, v2w.y, v2w.z, v2w.w};
#pragma unroll
            for (int ii = 0; ii < 8; ++ii) { vT[(16 * sub + 2 * ii) * 136 + j] = (bf16)(vw[ii] & 0xffffu); vT[(16 * sub + 2 * ii + 1) * 136 + j] = (bf16)(vw[ii] >> 16); }
        }
        __syncthreads();
        if (h + 1 < NHEAD) {
            k1w = *(const u32x4*)(zrow + ZC_RK + 64 * (h + 1) + 8 * sub); k2w = *(const u32x4*)(zrow + ZC_RK + 64 * (h + 1) + 32 + 8 * sub);
            v1w = *(const u32x4*)(zrow + ZC_RV + 64 * (h + 1) + 16 * sub); v2w = *(const u32x4*)(zrow + ZC_RV + 64 * (h + 1) + 16 * sub + 8); }
        {
            const int z = w >> 2, mt = w & 3; LAS bf16* kT = z ? kbT : kfT;
            f32x4 acc[4];
#pragma unroll
            for (int nt = 0; nt < 4; ++nt) acc[nt] = (f32x4){0.f, 0.f, 0.f, 0.f};
#pragma unroll
            for (int ks = 0; ks < 4; ++ks) { const bf16x8 af = *(const LAS bf16x8*)(vT + (16 * mt + fr) * 136 + 32 * ks + 8 * fq);
#pragma unroll
                for (int nt = 0; nt < 4; ++nt) { const bf16x8 bfg = *(const LAS bf16x8*)(kT + (16 * nt + fr) * 136 + 32 * ks + 8 * fq); acc[nt] = MFMA16(bfg, af, acc[nt]); } }
            bf16* U = (z ? C.UB : C.UF) + (size_t)n * USTRIDE + (size_t)(b * NHEAD + h) * 4096;
#pragma unroll
            for (int nt = 0; nt < 4; ++nt) { u32x2 o; o.x = pk2(acc[nt][0], acc[nt][1]); o.y = pk2(acc[nt][2], acc[nt][3]); *(u32x2*)(U + (16 * mt + fr) * 64 + 16 * nt + 4 * fq) = o; }
        }
        __syncthreads();
    }
}

__device__ __forceinline__ void ret_pass2(const Ctx& C, int l, int chunk, LAS unsigned char* lds) {
    int tid_ = threadIdx.x; asm volatile("" : "+v"(tid_)); const int tid = tid_, lane = tid & 63, w = tid >> 6, fr = lane & 15, fq = lane >> 4;
    LAS bf16* kr = (LAS bf16*)lds; LAS bf16* qr = kr + 128 * 72; LAS bf16* BT = qr + 128 * 72; LAS bf16* Ss = BT + 64 * 264;
    const int b = chunk >> 6, n = chunk & 63, row0 = chunk * CHUNK;
    const int j = tid >> 2, sub = tid & 3, e = tid >> 3, d0 = 8 * (tid & 7);
    const bf16* zrow = C.Z + (size_t)(row0 + j) * INW;
    const size_t uo0 = (size_t)n * USTRIDE + (size_t)(b * NHEAD) * 4096 + e * 64 + d0;
    u32x4 q1w = *(const u32x4*)(zrow + ZC_RQ + 8 * sub), q2w = *(const u32x4*)(zrow + ZC_RQ + 32 + 8 * sub);
    u32x4 k1w = *(const u32x4*)(zrow + ZC_RK + 8 * sub), k2w = *(const u32x4*)(zrow + ZC_RK + 32 + 8 * sub);
    u32x4 v1w = *(const u32x4*)(zrow + ZC_RV + 16 * sub), v2w = *(const u32x4*)(zrow + ZC_RV + 16 * sub + 8);
    u32x4 rfw = *(const u32x4*)(C.UF + uo0), rbw = *(const u32x4*)(C.UB + uo0);
    float cs[8], sn[8];
    { const float pos = (float)C.pos[row0 + j];
#pragma unroll
      for (int ii = 0; ii < 8; ++ii) rope_cs(pos, 8 * sub + ii, cs[ii], sn[ii]); }
#pragma unroll 1
    for (int h = 0; h < NHEAD; ++h) {
        const float lgm = log_gamma_h(h);
        {
            float q1[8], q2[8], k1[8], k2[8]; unpack8(q1w, q1); unpack8(q2w, q2); unpack8(k1w, k1); unpack8(k2w, k2);
            float oq1[8], oq2[8], ok1[8], ok2[8];
#pragma unroll
            for (int ii = 0; ii < 8; ++ii) { const float c = cs[ii], s = sn[ii];
                oq1[ii] = q1[ii] * c - q2[ii] * s; oq2[ii] = q2[ii] * c + q1[ii] * s;
                ok1[ii] = (k1[ii] * c - k2[ii] * s) * 0.125f; ok2[ii] = (k2[ii] * c + k1[ii] * s) * 0.125f; }
            *(LAS u32x4*)(qr + j * 72 + 8 * sub) = pack8(oq1); *(LAS u32x4*)(qr + j * 72 + 32 + 8 * sub) = pack8(oq2);
            *(LAS u32x4*)(kr + j * 72 + 8 * sub) = pack8(ok1); *(LAS u32x4*)(kr + j * 72 + 32 + 8 * sub) = pack8(ok2);
            const unsigned vw[8] = {v1w.x, v1w.y, v1w.z, v1w.w, v2w.x, v2w.y, v2w.z, v2w.w};
#pragma unroll
            for (int ii = 0; ii < 8; ++ii) { BT[(16 * sub + 2 * ii) * 264 + j] = (bf16)(vw[ii] & 0xffffu); BT[(16 * sub + 2 * ii + 1) * 264 + j] = (bf16)(vw[ii] >> 16); }
            *(LAS u32x4*)(BT + e * 264 + 128 + d0) = rfw; *(LAS u32x4*)(BT + e * 264 + 192 + d0) = rbw;
        }
        __syncthreads();
        if (h + 1 < NHEAD) {
            const int hn = h + 1; const size_t uo = uo0 + (size_t)hn * 4096;
            q1w = *(const u32x4*)(zrow + ZC_RQ + 64 * hn + 8 * sub); q2w = *(const u32x4*)(zrow + ZC_RQ + 64 * hn + 32 + 8 * sub);
            k1w = *(const u32x4*)(zrow + ZC_RK + 64 * hn + 8 * sub); k2w = *(const u32x4*)(zrow + ZC_RK + 64 * hn + 32 + 8 * sub);
            v1w = *(const u32x4*)(zrow + ZC_RV + 64 * hn + 16 * sub); v2w = *(const u32x4*)(zrow + ZC_RV + 64 * hn + 16 * sub + 8);
            rfw = *(const u32x4*)(C.UF + uo); rbw = *(const u32x4*)(C.UB + uo); }
        {
            const int i = 16 * w + fr;
            u32x2 gwv[4];
#pragma unroll
            for (int nt = 0; nt < 4; ++nt) gwv[nt] = *(const u32x2*)(C.Z + (size_t)(row0 + i) * INW + ZC_RG + 64 * h + 16 * nt + 4 * fq);
            bf16x8 qf[2];
#pragma unroll
            for (int ks = 0; ks < 2; ++ks) qf[ks] = *(const LAS bf16x8*)(qr + i * 72 + 32 * ks + 8 * fq);
            LAS bf16* Sw = Ss + w * 16 * 136;
#pragma unroll
            for (int nt = 0; nt < 8; ++nt) { f32x4 s = (f32x4){0.f, 0.f, 0.f, 0.f};
#pragma unroll
                for (int ks = 0; ks < 2; ++ks) { const bf16x8 kf = *(const LAS bf16x8*)(kr + (16 * nt + fr) * 72 + 32 * ks + 8 * fq); s = MFMA16(kf, qf[ks], s); }
                float sv[4];
#pragma unroll
                for (int r = 0; r < 4; ++r) { const int jj = 16 * nt + 4 * fq + r; sv[r] = s[r] * __expf(lgm * fabsf((float)(i - jj))); }
                u32x2 o; o.x = pk2(sv[0], sv[1]); o.y = pk2(sv[2], sv[3]);
                *(LAS u32x2*)(Sw + fr * 136 + 16 * nt + 4 * fq) = o; }
            asm volatile("s_waitcnt lgkmcnt(0)" ::: "memory");
            f32x4 a1[4], a2[4], a3[4];
#pragma unroll
            for (int nt = 0; nt < 4; ++nt) { a1[nt] = (f32x4){0.f, 0.f, 0.f, 0.f}; a2[nt] = a1[nt]; a3[nt] = a1[nt]; }
#pragma unroll
            for (int ks = 0; ks < 4; ++ks) { const bf16x8 sf = *(const LAS bf16x8*)(Sw + fr * 136 + 32 * ks + 8 * fq);
#pragma unroll
                for (int nt = 0; nt < 4; ++nt) { const bf16x8 bfr = *(const LAS bf16x8*)(BT + (16 * nt + fr) * 264 + 32 * ks + 8 * fq); a1[nt] = MFMA16(bfr, sf, a1[nt]); } }
#pragma unroll
            for (int ks = 0; ks < 2; ++ks)
#pragma unroll
                for (int nt = 0; nt < 4; ++nt) { const bf16x8 b2 = *(const LAS bf16x8*)(BT + (16 * nt + fr) * 264 + 128 + 32 * ks + 8 * fq); a2[nt] = MFMA16(b2, qf[ks], a2[nt]);
                    const bf16x8 b3 = *(const LAS bf16x8*)(BT + (16 * nt + fr) * 264 + 192 + 32 * ks + 8 * fq); a3[nt] = MFMA16(b3, qf[ks], a3[nt]); }
            const float sfw = __expf(lgm * (float)(i + 1)), sbw = __expf(lgm * (float)(CHUNK - i));
            float sum = 0.f;
#pragma unroll
            for (int nt = 0; nt < 4; ++nt) { a1[nt] = a1[nt] + a2[nt] * sfw + a3[nt] * sbw; sum += (a1[nt][0] + a1[nt][1]) + (a1[nt][2] + a1[nt][3]); }
            sum += __shfl_xor(sum, 16); sum += __shfl_xor(sum, 32);
            const float mean = sum * (1.f / 64.f); float q = 0.f;
#pragma unroll
            for (int nt = 0; nt < 4; ++nt) { a1[nt] = a1[nt] - mean; q += (a1[nt][0] * a1[nt][0] + a1[nt][1] * a1[nt][1]) + (a1[nt][2] * a1[nt][2] + a1[nt][3] * a1[nt][3]); }
            q += __shfl_xor(q, 16); q += __shfl_xor(q, 32);
            const float rstd = 1.f / sqrtf(q * (1.f / 64.f) + LN_EPS);
            f32x4 ggv[4], gbv[4];
#pragma unroll
            for (int nt = 0; nt < 4; ++nt) { ggv[nt] = *(const f32x4*)(C.ret_gn_g + l * GWID + 64 * h + 16 * nt + 4 * fq); gbv[nt] = *(const f32x4*)(C.ret_gn_b + l * GWID + 64 * h + 16 * nt + 4 * fq); }
            asm volatile("" ::: "memory");
#pragma unroll
            for (int nt = 0; nt < 4; ++nt) { const int e = 64 * h + 16 * nt + 4 * fq;
                const f32x4 gg = ggv[nt], gb = gbv[nt];
                float gf[4]; unpack4(gwv[nt], gf);
                float o[4];
#pragma unroll
                for (int r = 0; r < 4; ++r) o[r] = silu_f(gf[r]) * (a1[nt][r] * rstd * gg[r] + gb[r]);
                u32x2 ow; ow.x = pk2(o[0], o[1]); ow.y = pk2(o[2], o[3]);
                *(u32x2*)(C.Y + (size_t)(row0 + i) * DM + 256 + e) = ow; }
        }
        __syncthreads();
    }
}

#define LRU_SCAN_STEP(DIR, N) \
    "v_fmac_f32_dpp %4, %4, %0 " DIR ":" #N " row_mask:0xf bank_mask:0xf\n\t" "v_fmac_f32_dpp %5, %5, %1 " DIR ":" #N " row_mask:0xf bank_mask:0xf\n\t" \
    "v_fmac_f32_dpp %6, %6, %2 " DIR ":" #N " row_mask:0xf bank_mask:0xf\n\t" "v_fmac_f32_dpp %7, %7, %3 " DIR ":" #N " row_mask:0xf bank_mask:0xf\n\t" \
    "v_mul_f32_dpp %0, %0, %0 " DIR ":" #N " row_mask:0xf bank_mask:0xf\n\t" "v_mul_f32_dpp %1, %1, %1 " DIR ":" #N " row_mask:0xf bank_mask:0xf\n\t" \
    "v_mul_f32_dpp %2, %2, %2 " DIR ":" #N " row_mask:0xf bank_mask:0xf\n\t" "v_mul_f32_dpp %3, %3, %3 " DIR ":" #N " row_mask:0xf bank_mask:0xf\n\t"
#define LRU_SCAN4(DIR, a, b) asm volatile("s_nop 1\n\t" LRU_SCAN_STEP(DIR, 1) LRU_SCAN_STEP(DIR, 2) LRU_SCAN_STEP(DIR, 4) LRU_SCAN_STEP(DIR, 8) \
    : "+v"(a[0]), "+v"(a[1]), "+v"(a[2]), "+v"(a[3]), "+v"(b[0]), "+v"(b[1]), "+v"(b[2]), "+v"(b[3]))
template <int MODE, int Z>
__device__ __forceinline__ void lru_dir(const Ctx& C, int l, int b, int n, int row0, const LAS bf16* xa, int w, int fr, int fq, f32x4 (&hf)[8][2]) {
    const int hh = w >> 1, half = w & 1, cb = 64 * hh + 32 * half;
    const int lane = fq * 16 + fr, edge_src = (fq * 16 + (Z ? 0 : 15)) << 2;
    bf16x8 wa[2][2], wx[2][2];
    {
        const bf16* WTa = C.LRUW + (((size_t)l * 2 + 0) * 8 + Z * 4 + hh) * 4096; const bf16* WTx = C.LRUW + (((size_t)l * 2 + 1) * 8 + Z * 4 + hh) * 4096;
#pragma unroll
        for (int ntl = 0; ntl < 2; ++ntl)
#pragma unroll
            for (int ks = 0; ks < 2; ++ks) { wa[ntl][ks] = *(const bf16x8*)(WTa + (32 * half + 16 * ntl + fr) * 64 + 32 * ks + 8 * fq); wx[ntl][ks] = *(const bf16x8*)(WTx + (32 * half + 16 * ntl + fr) * 64 + 32 * ks + 8 * fq); }
    }
    f32x4 ba2[2], bx2[2], spv[2], hprev[2], Ap[2];
    const size_t co = ((size_t)(b * NCH + n) * 2 + Z) * GWID + cb + 4 * fq;
#pragma unroll
    for (int ntl = 0; ntl < 2; ++ntl) { const int ci = (l * 2 + Z) * GWID + cb + 16 * ntl + 4 * fq;
        ba2[ntl] = *(const f32x4*)(C.BA2 + ci); bx2[ntl] = *(const f32x4*)(C.BX2 + ci); spv[ntl] = *(const f32x4*)(C.SP + ci);
        hprev[ntl] = MODE ? *(const f32x4*)(C.CH + co + 16 * ntl) : (f32x4){0.f, 0.f, 0.f, 0.f}; Ap[ntl] = (f32x4){1.f, 1.f, 1.f, 1.f}; }
    u32x2 gpre[8][2];
    if (MODE && Z) {
#pragma unroll
        for (int mt = 0; mt < 8; ++mt)
#pragma unroll
            for (int ntl = 0; ntl < 2; ++ntl) gpre[mt][ntl] = *(const u32x2*)(C.Z + (size_t)(row0 + 16 * mt + fr) * INW + ZC_CG + cb + 16 * ntl + 4 * fq);
    }
#pragma unroll
    for (int i = 0; i < 8; ++i) { const int mt = Z ? 7 - i : i; const int t = 16 * mt + fr;
        bf16x8 af[2];
#pragma unroll
        for (int ks = 0; ks < 2; ++ks) af[ks] = *(const LAS bf16x8*)(xa + t * 264 + 64 * hh + 32 * ks + 8 * fq);
        f32x4 Av[2], Bv[2];
#pragma unroll
        for (int ntl = 0; ntl < 2; ++ntl) { f32x4 aa = ba2[ntl], ax = bx2[ntl];
#pragma unroll
            for (int ks = 0; ks < 2; ++ks) { aa = MFMA16(wa[ntl][ks], af[ks], aa); ax = MFMA16(wx[ntl][ks], af[ks], ax); }
            const u32x2 xw = *(const LAS u32x2*)(xa + t * 264 + cb + 16 * ntl + 4 * fq); const f32x4 xv = (f32x4){bflo(xw.x), bfhi(xw.x), bflo(xw.y), bfhi(xw.y)};
#pragma unroll
            for (int r = 0; r < 4; ++r) { const float rg = __builtin_amdgcn_rcpf(1.0f + __builtin_amdgcn_exp2f(aa[r])), ig = __builtin_amdgcn_rcpf(1.0f + __builtin_amdgcn_exp2f(ax[r]));
                const float a = __builtin_amdgcn_exp2f(spv[ntl][r] * rg);
                Av[ntl][r] = a; Bv[ntl][r] = xv[r] * ig * __builtin_amdgcn_sqrtf(fmaf(-a, a, 1.0f)); } }
        {
            if (Z == 0) { LRU_SCAN4("row_shr", Av[0], Bv[0]); LRU_SCAN4("row_shr", Av[1], Bv[1]); } else { LRU_SCAN4("row_shl", Av[0], Bv[0]); LRU_SCAN4("row_shl", Av[1], Bv[1]); }
        }
#pragma unroll
        for (int ntl = 0; ntl < 2; ++ntl) {
            f32x4 cin;
#pragma unroll
            for (int r = 0; r < 4; ++r) cin[r] = __int_as_float(__builtin_amdgcn_ds_bpermute(edge_src, __float_as_int(hprev[ntl][r])));
            const f32x4 hv = Bv[ntl] + Av[ntl] * cin;
            hprev[ntl] = hv; Ap[ntl] = Ap[ntl] * Av[ntl];
            if (MODE) {
                if (Z == 0) hf[mt][ntl] = hv;
                else { const f32x4 hs = hf[mt][ntl] + hv;
                    float gf[4]; unpack4(gpre[mt][ntl], gf);
                    u32x2 ow; ow.x = pk2(hs[0] * gelu_f(gf[0]), hs[1] * gelu_f(gf[1])); ow.y = pk2(hs[2] * gelu_f(gf[2]), hs[3] * gelu_f(gf[3]));
                    *(u32x2*)(C.Y + (size_t)(row0 + t) * DM + 512 + cb + 16 * ntl + 4 * fq) = ow; }
            }
        }
    }
    if (!MODE && fr == (Z ? 0 : 15)) {
#pragma unroll
        for (int ntl = 0; ntl < 2; ++ntl) { *(f32x4*)(C.CA + co + 16 * ntl) = Ap[ntl]; *(f32x4*)(C.CH + co + 16 * ntl) = hprev[ntl]; } }
    (void)lane;
}
template <int MODE>
__device__ __forceinline__ void lru_pass(const Ctx& C, int l, int chunk, LAS unsigned char* lds) {
    int tid_ = threadIdx.x; asm volatile("" : "+v"(tid_)); const int tid = tid_, lane = tid & 63, w = tid >> 6, fr = lane & 15, fq = lane >> 4;
    LAS bf16* xa = (LAS bf16*)lds;
    const int b = chunk >> 6, n = chunk & 63, row0 = chunk * CHUNK;
    {
        const int cg8 = (tid & 31) * 8, t0 = (tid >> 5) * 8;
        float wk[4][8], bias[8];
#pragma unroll
        for (int k = 0; k < 4; ++k) { const float* wp = C.lru_conv_w + (size_t)(l * 4 + k) * GWID + cg8; const f32x4 w0 = *(const f32x4*)wp, w1 = *(const f32x4*)(wp + 4);
            wk[k][0] = w0[0]; wk[k][1] = w0[1]; wk[k][2] = w0[2]; wk[k][3] = w0[3]; wk[k][4] = w1[0]; wk[k][5] = w1[1]; wk[k][6] = w1[2]; wk[k][7] = w1[3]; }
        { const f32x4 b0 = *(const f32x4*)(C.lru_conv_b + l * GWID + cg8), b1 = *(const f32x4*)(C.lru_conv_b + l * GWID + cg8 + 4);
          bias[0] = b0[0]; bias[1] = b0[1]; bias[2] = b0[2]; bias[3] = b0[3]; bias[4] = b1[0]; bias[5] = b1[1]; bias[6] = b1[2]; bias[7] = b1[3]; }
        float xr[11][8];
#pragma unroll
        for (int r = 0; r < 11; ++r) { const int sq = n * CHUNK + t0 - 2 + r; u32x4 w = (u32x4){0u, 0u, 0u, 0u};
            if (sq >= 0 && sq < SEQ) w = *(const u32x4*)(C.Z + (size_t)(b * SEQ + sq) * INW + ZC_CX + cg8);
            unpack8(w, xr[r]); }
#pragma unroll
        for (int tt = 0; tt < 8; ++tt) { float acc[8];
#pragma unroll
            for (int c = 0; c < 8; ++c) acc[c] = bias[c] + ((wk[0][c] * xr[tt][c] + wk[1][c] * xr[tt + 1][c]) + (wk[2][c] * xr[tt + 2][c] + wk[3][c] * xr[tt + 3][c]));
            *(LAS u32x4*)(xa + (t0 + tt) * 264 + cg8) = pack8(acc); }
    }
    __syncthreads();
    f32x4 hf[8][2];
    lru_dir<MODE, 0>(C, l, b, n, row0, xa, w, fr, fq, hf);
    lru_dir<MODE, 1>(C, l, b, n, row0, xa, w, fr, fq, hf);
    __syncthreads();
}

__device__ __forceinline__ void sc_chunk(const Ctx& C, int l, int chunk) {
    int tid_ = threadIdx.x; asm volatile("" : "+v"(tid_)); const int tid = tid_; const int b = chunk >> 6, n = chunk & 63, row0 = chunk * CHUNK;
    const int c8 = (tid & 31) * 8, t0 = (tid >> 5) * 8;
    float wk[3][8];
#pragma unroll
    for (int k = 0; k < 3; ++k) { const float* wp = C.sc_conv_w + (size_t)(l * 3 + k) * GWID + c8; const f32x4 w0 = *(const f32x4*)wp, w1 = *(const f32x4*)(wp + 4);
        wk[k][0] = w0[0]; wk[k][1] = w0[1]; wk[k][2] = w0[2]; wk[k][3] = w0[3]; wk[k][4] = w1[0]; wk[k][5] = w1[1]; wk[k][6] = w1[2]; wk[k][7] = w1[3]; }
    float ch[10][8];
#pragma unroll
    for (int r = 0; r < 10; ++r) { const int sq = n * CHUNK + t0 - 1 + r; u32x4 cw = (u32x4){0u, 0u, 0u, 0u}, hw = cw;
        if (sq >= 0 && sq < SEQ) { const bf16* zr = C.Z + (size_t)(b * SEQ + sq) * INW; cw = *(const u32x4*)(zr + ZC_DC + c8); hw = *(const u32x4*)(zr + ZC_DH + c8); }
        float cf[8], hf[8]; unpack8(cw, cf); unpack8(hw, hf);
#pragma unroll
        for (int i = 0; i < 8; ++i) ch[r][i] = cf[i] * hf[i]; }
#pragma unroll
    for (int tt = 0; tt < 8; ++tt) { const u32x4 bw = *(const u32x4*)(C.Z + (size_t)(row0 + t0 + tt) * INW + ZC_DB + c8); float bf_[8]; unpack8(bw, bf_);
        float acc[8];
#pragma unroll
        for (int i = 0; i < 8; ++i) acc[i] = bf_[i] * (wk[0][i] * ch[tt][i] + wk[1][i] * ch[tt + 1][i] + wk[2][i] * ch[tt + 2][i]);
        *(u32x4*)(C.Y + (size_t)(row0 + t0 + tt) * DM + 768 + c8) = pack8(acc); }
}

__device__ __forceinline__ void carry_phase(const Ctx& C) {
    int tid_ = threadIdx.x; asm volatile("" : "+v"(tid_)); const int gt = blockIdx.x * 512 + tid_, NT = gridDim.x * 512;
    for (int i2 = gt; i2 < (int)USTRIDE / 2; i2 += NT) { const int idx = 2 * i2, h = (idx >> 12) & 3;
        const float cd = __expf(log_gamma_h(h) * (float)CHUNK);
        unsigned* pf = (unsigned*)(C.UF + idx); unsigned* pb = (unsigned*)(C.UB + idx); float sf0 = 0.f, sf1 = 0.f, sb0 = 0.f, sb1 = 0.f;
#pragma unroll 1
        for (int n8 = 0; n8 < NCH; n8 += 8) { unsigned uf[8], ub[8];
#pragma unroll
            for (int i = 0; i < 8; ++i) { uf[i] = pf[(size_t)(n8 + i) * (USTRIDE / 2)]; ub[i] = pb[(size_t)(NCH - 1 - n8 - i) * (USTRIDE / 2)]; }
#pragma unroll
            for (int i = 0; i < 8; ++i) { pf[(size_t)(n8 + i) * (USTRIDE / 2)] = pk2(sf0, sf1); sf0 = cd * sf0 + bflo(uf[i]); sf1 = cd * sf1 + bfhi(uf[i]);
                pb[(size_t)(NCH - 1 - n8 - i) * (USTRIDE / 2)] = pk2(sb0, sb1); sb0 = cd * sb0 + bflo(ub[i]); sb1 = cd * sb1 + bfhi(ub[i]); } }
    }
    if (gt < BATCH * 512) { const int b = gt >> 9, zc = gt & 511, z = zc >> 8; float st = 0.f;
#pragma unroll 1
        for (int n8 = 0; n8 < NCH; n8 += 8) { float a[8], hh[8];
#pragma unroll
            for (int i = 0; i < 8; ++i) { const int n = z ? NCH - 1 - n8 - i : n8 + i; const size_t o = (size_t)(b * NCH + n) * 512 + zc; a[i] = C.CA[o]; hh[i] = C.CH[o]; }
#pragma unroll
            for (int i = 0; i < 8; ++i) { const int n = z ? NCH - 1 - n8 - i : n8 + i; const size_t o = (size_t)(b * NCH + n) * 512 + zc; C.CH[o] = st; st = a[i] * st + hh[i]; } } }
}

#define RLX_AGENT __ATOMIC_RELAXED, __HIP_MEMORY_SCOPE_AGENT
#define XB_TMO      128
#define XB_XCNT(j)  (256  + 64 * (j))
#define XB_XSUB(j)  (1280 + 64 * (j))
#define XB_XGEN(j)  (2304 + 64 * (j))
#define XB_TOP      3328
#define XB_TOPGEN   3392
#define XCD_BAR_WORDS 3456
#define XB_SPIN_CAP (1u << 18)

__device__ __forceinline__ unsigned xb_ld(unsigned* p)              { return __hip_atomic_load(p, __ATOMIC_RELAXED, __HIP_MEMORY_SCOPE_AGENT); }
__device__ __forceinline__ unsigned xb_add(unsigned* p, unsigned v) { return __hip_atomic_fetch_add(p, v, __ATOMIC_RELAXED, __HIP_MEMORY_SCOPE_AGENT); }
__device__ __forceinline__ unsigned xb_xcc_id() { return (unsigned)__builtin_amdgcn_s_getreg((3 << 11) | 20) & 0xFu; }
#define XB_SPIN(cond, bar) do { unsigned _sp = 0; while (cond) { __builtin_amdgcn_s_sleep(1); \
    if ((++_sp & 255u) == 0u) { if (xb_ld(&(bar)[XB_TMO])) break; if (_sp > XB_SPIN_CAP) { atomicAdd(&(bar)[XB_TMO], 1u); break; } } } } while (0)

struct XcdBarrier {
    unsigned* bar; unsigned x;
    volatile LAS unsigned* st;
};

__device__ __forceinline__ XcdBarrier xcd_barrier_post(unsigned* bar, volatile LAS unsigned* st) {
    XcdBarrier b; b.bar = bar; b.x = xb_xcc_id(); b.st = st;
    if (threadIdx.x == 0) (void)xb_add(&bar[XB_XCNT(b.x)], 1u);
    return b;
}
__device__ __forceinline__ void xcd_barrier_complete(unsigned* bar, unsigned x, unsigned& nloc, unsigned& nx) {
    const unsigned G = gridDim.x * gridDim.y * gridDim.z;
    unsigned sum, cnt, mine, sp = 0u;
    for (;;) {
        sum = 0u; cnt = 0u; mine = 0u;
#pragma unroll
        for (unsigned j = 0; j < 16; ++j) { const unsigned c = xb_ld(&bar[XB_XCNT(j)]); sum += c; cnt += (c > 0u) ? 1u : 0u; mine = (j == x) ? c : mine; }
        if (sum == G) break;
        __builtin_amdgcn_s_sleep(1);
        if ((++sp & 255u) == 0u) { if (xb_ld(&bar[XB_TMO])) break; if (sp > XB_SPIN_CAP) { atomicAdd(&bar[XB_TMO], 1u); break; } }
    }
    nloc = mine > 0u ? mine : 1u; nx = cnt > 0u ? cnt : 1u;
}

__device__ __forceinline__ void xcd_barrier(const XcdBarrier& b) {
    asm volatile("s_waitcnt vmcnt(0)" ::: "memory");
    __syncthreads();
    if (threadIdx.x == 0) {
        unsigned* bar = b.bar;
        __builtin_amdgcn_s_waitcnt(0);
        unsigned nloc = b.st[0], nx = b.st[1];
        if (nloc == 0u) { xcd_barrier_complete(bar, b.x, nloc, nx); b.st[0] = nloc; b.st[1] = nx; }
        const unsigned old = xb_add(&bar[XB_XSUB(b.x)], 1u);
        const unsigned gen = old / nloc;
        if (old + 1u == (gen + 1u) * nloc) {
            __builtin_amdgcn_fence(__ATOMIC_RELEASE, "agent");
            asm volatile("s_waitcnt vmcnt(0)" ::: "memory");
            const unsigned og = xb_add(&bar[XB_TOP], 1u);
            const unsigned tg = og / nx;
            if (og + 1u == (tg + 1u) * nx) xb_add(&bar[XB_TOPGEN], 1u);
            else XB_SPIN(xb_ld(&bar[XB_TOPGEN]) == tg, bar);
            __builtin_amdgcn_fence(__ATOMIC_ACQUIRE, "agent");
            xb_add(&bar[XB_XGEN(b.x)], 1u);
            asm volatile("s_waitcnt vmcnt(0)" ::: "memory");
        } else {
            XB_SPIN(xb_ld(&bar[XB_XGEN(b.x)]) == gen, bar);
            __builtin_amdgcn_fence(__ATOMIC_ACQUIRE, "agent");
            asm volatile("s_waitcnt vmcnt(0)" ::: "memory");
        }
    }
    __syncthreads();
}

#ifndef STAG_TICKS
#define STAG_TICKS 0
#endif
__device__ __forceinline__ void xcd_stagger(unsigned x, unsigned ticks) {
    const unsigned long long t0 = __builtin_amdgcn_s_memrealtime(), dt = (unsigned long long)x * ticks;
    while (__builtin_amdgcn_s_memrealtime() - t0 < dt) __builtin_amdgcn_s_sleep(4);
}
#ifndef DUP_MIX
#define DUP_MIX 0
#endif
#ifndef DUP_G13
#define DUP_G13 0
#endif
#ifndef DUP_G2
#define DUP_G2 0
#endif
#ifndef REV_G4
#define REV_G4 1
#endif
#ifndef DUP_G3
#define DUP_G3 0
#endif
#ifndef DUP_G4
#define DUP_G4 0
#endif
#ifndef DUP_CARRY
#define DUP_CARRY 0
#endif
#ifndef DUP_LRU
#define DUP_LRU 0
#endif
#ifndef DUP_RET
#define DUP_RET 0
#endif
#ifndef DUP_GS
#define DUP_GS 0
#endif
#ifndef DUP_PRO
#define DUP_PRO 0
#endif
#define GRID_SYNC() do { asm volatile("s_waitcnt vmcnt(0) lgkmcnt(0)" ::: "memory"); grid.sync(); __builtin_amdgcn_fence(__ATOMIC_ACQUIRE, "agent"); asm volatile("s_waitcnt vmcnt(0)" ::: "memory"); } while (0)
typedef const __attribute__((address_space(4))) Args* KArgP;
__device__ __forceinline__ KArgP launder(KArgP p) { asm volatile("" : "+s"(p)); return p; }
__device__ __forceinline__ Ctx make_ctx(KArgP ap) {
    const __attribute__((address_space(4))) Args& args = *ap;
    Ctx C;
    C.x = (const float*)args.in[0]; C.pos = (const int*)args.in[1]; C.w_in = (const float*)args.in[2]; C.gmlp_ln_g = (const float*)args.in[3]; C.gmlp_ln_b = (const float*)args.in[4];
    C.gmlp_ws = (const float*)args.in[5]; C.gmlp_bs = (const float*)args.in[6]; C.ret_gn_g = (const float*)args.in[7]; C.ret_gn_b = (const float*)args.in[8];
    C.lru_conv_w = (const float*)args.in[9]; C.lru_conv_b = (const float*)args.in[10]; C.lru_wa = (const float*)args.in[11]; C.lru_ba = (const float*)args.in[12];
    C.lru_wx = (const float*)args.in[13]; C.lru_bx = (const float*)args.in[14]; C.lru_lambda = (const float*)args.in[15]; C.sc_conv_w = (const float*)args.in[16];
    C.w_out = (const float*)args.in[17]; C.ln1_g = (const float*)args.in[18]; C.ln1_b = (const float*)args.in[19]; C.ffn_wg = (const float*)args.in[20]; C.ffn_wu = (const float*)args.in[21];
    C.ffn_wd = (const float*)args.in[22]; C.ln2_g = (const float*)args.in[23]; C.ln2_b = (const float*)args.in[24];
    C.out = args.out; unsigned char* ws = args.ws;
    C.WIN = (bf16*)(ws + OFF_WIN); C.WOUT = (bf16*)(ws + OFF_WOUT); C.WGU = (bf16*)(ws + OFF_WGU); C.WD = (bf16*)(ws + OFF_WD); C.LRUW = (bf16*)(ws + OFF_LRUW);
    C.XB = (bf16*)(ws + OFF_XB); C.Z = (bf16*)(ws + OFF_Z); C.Y = (bf16*)(ws + OFF_Y); C.UF = (bf16*)(ws + OFF_UF); C.UB = (bf16*)(ws + OFF_UB); C.CA = (float*)(ws + OFF_CA); C.CH = (float*)(ws + OFF_CH); C.SP = (float*)(ws + OFF_SP); C.BA2 = C.SP + DEPTH * 2 * GWID; C.BX2 = C.SP + 2 * DEPTH * 2 * GWID; C.S1 = (float*)(ws + OFF_S1); C.T1 = (float*)(ws + OFF_T1); C.S3 = (float*)(ws + OFF_S3); C.T3 = (float*)(ws + OFF_T3); C.WSB = (bf16*)(ws + OFF_WSB); C.P0 = (long long*)(ws + OFF_P0); C.P1 = (long long*)(ws + OFF_P1);
    return C;
}
__global__ void __launch_bounds__(512) hybrid_fwd(Args args) {
    extern __shared__ __attribute__((aligned(16))) unsigned char lds_raw[];
    LAS unsigned char* lds = (LAS unsigned char*)lds_raw;
    cg::grid_group grid = cg::this_grid();
    (void)args; const KArgP ap0 = (KArgP)__builtin_amdgcn_kernarg_segment_ptr();
    unsigned char* const args_ws_ptr = ap0->ws;
    const int G = gridDim.x;
    if (threadIdx.x < 64) ((LAS unsigned*)(lds + LDS_MISC_OFF))[threadIdx.x] = 0u;
    __syncthreads();
    const XcdBarrier bar = xcd_barrier_post((unsigned*)(args_ws_ptr + OFF_CTL), (volatile LAS unsigned*)(lds + LDS_MISC_OFF));

    for (int q = 0; q <= DUP_PRO; ++q) { const Ctx C = make_ctx(launder(ap0)); prologue(C, lds); __syncthreads(); }
    if (G > 1024) GRID_SYNC();
    else xcd_barrier(bar);
#pragma unroll 1
    for (int l = 0; l < DEPTH; ++l) {
        {
            const Ctx C = make_ctx(launder(ap0));
            pg8::Gemm g{C.XB, C.WIN + (size_t)l * INW * DM, M, INW, DM}; pg8::StaticOrder S; S.init(M, INW, G, (int)blockIdx.x);
            EpiLnBf16 E{C.Z, INW, C.P0, C.S1 + l * INW, C.T1 + l * INW, l ? 1 : 0};
#pragma unroll 1
            for (int rep = 0; rep <= DUP_G13; ++rep)
            pg8::gemm_phase<EpiLnBf16, pg8::StaticOrder, true, true>(lds, g, S, E);
        }
        xcd_barrier(bar);
#pragma unroll 1
        for (int rep = 0; rep <= DUP_MIX; ++rep)
#pragma unroll 1
        for (int c = blockIdx.x; c < NCHUNK; c += G) {
            for (int q = 0; q <= DUP_GS; ++q) { const Ctx C = make_ctx(launder(ap0)); gmlp_chunk(C, l, c, lds); }
            for (int q = 0; q <= DUP_RET; ++q) { const Ctx C = make_ctx(launder(ap0)); ret_pass1(C, c, lds); }
            for (int q = 0; q <= DUP_LRU; ++q) { const Ctx C = make_ctx(launder(ap0)); lru_pass<0>(C, l, c, lds); }
            for (int q = 0; q <= DUP_GS; ++q) { const Ctx C = make_ctx(launder(ap0)); sc_chunk(C, l, c); } }
        xcd_barrier(bar);
        { const Ctx C = make_ctx(launder(ap0)); carry_phase(C); zero_rows(C.P1); }
        xcd_barrier(bar);
#pragma unroll 1
        for (int rep = 0; rep <= DUP_MIX; ++rep)
#pragma unroll 1
        for (int c = blockIdx.x; c < NCHUNK; c += G) {
            for (int q = 0; q <= DUP_RET; ++q) { const Ctx C = make_ctx(launder(ap0)); ret_pass2(C, l, c, lds); }
            for (int q = 0; q <= DUP_LRU; ++q) { const Ctx C = make_ctx(launder(ap0)); lru_pass<1>(C, l, c, lds); } }
        xcd_barrier(bar);
        {
            const Ctx C = make_ctx(launder(ap0));
            pg8::Gemm g{C.Y, C.WOUT + (size_t)l * DM * DM, M, DM, DM}; pg8::StaticOrder S; S.init(M, DM, G, (int)blockIdx.x);
            stage_gain_bias((LAS float*)(lds + LDS_GB_OFF), C.ln2_g + (l ? l - 1 : 0) * DM, C.ln2_b + (l ? l - 1 : 0) * DM, l == 0 ? 1 : 0);
            if (l == 0) { EpiResLn<1> E{C.x, C.out, C.XB, C.XB, C.P0, (const LAS float*)(lds + LDS_GB_OFF), C.P1, 0, DN_ALPHA};
                pg8::gemm_phase<EpiResLn<1>, pg8::StaticOrder, true, true>(lds, g, S, E); }
            else { EpiResLn<0> E{C.x, C.out, C.XB, C.XB, C.P0, (const LAS float*)(lds + LDS_GB_OFF), C.P1, 0, DN_ALPHA};
                pg8::gemm_phase<EpiResLn<0>, pg8::StaticOrder, true, true>(lds, g, S, E); }
        }
        xcd_barrier(bar);
        {
            const Ctx C = make_ctx(launder(ap0));
            zero_rows(C.P0);
            pg8::Gemm g{C.XB, C.WGU + (size_t)l * 2 * DFF * DM, M, 2 * DFF, DM}; pg8::StaticOrder S; S.init(M, 2 * DFF, G, (int)blockIdx.x);
            EpiSwiGLU E{C.Z, C.P1, C.S3 + l * 2 * DFF, C.T3 + l * 2 * DFF};
            pg8::gemm_phase<EpiSwiGLU, pg8::StaticOrder, true, true>(lds, g, S, E);
        }
        xcd_barrier(bar);
        {
            const Ctx C = make_ctx(launder(ap0));
            pg8::Gemm g{C.Z, C.WD + (size_t)l * DM * DFF, M, DM, DFF}; pg8::StaticOrder S; S.init(M, DM, G, (int)blockIdx.x, REV_G4);
            stage_gain_bias((LAS float*)(lds + LDS_GB_OFF), C.ln1_g + l * DM, C.ln1_b + l * DM, 0);
            EpiResLn<0> E{C.x, C.out, C.XB, C.XB, C.P1, (const LAS float*)(lds + LDS_GB_OFF), C.P0, l + 1 == DEPTH ? 1 : 0, DN_ALPHA};
            pg8::gemm_phase<EpiResLn<0>, pg8::StaticOrder, true, true>(lds, g, S, E);
        }
        xcd_barrier(bar);
    }
    { const Ctx C = make_ctx(launder(ap0)); final_ln(C.out, C.P0, C.ln2_g + (DEPTH - 1) * DM, C.ln2_b + (DEPTH - 1) * DM); }
}

extern "C" void kernel_launch(void* const* d_in, const int* in_sizes, int n_in, void* d_out, int out_size, void* d_ws, size_t ws_size, hipStream_t stream) {
    static int grid = 0;
    if (grid == 0) {
        if (n_in != 25 || out_size != M * DM || ws_size < WS_END) { fprintf(stderr, "kernel_launch: unexpected shapes (n_in %d out %d ws %zu need %zu)\n", n_in, out_size, ws_size, (size_t)WS_END); grid = -1; return; }
        int dev = 0, cus = 0, per_cu = 0;
        (void)hipGetDevice(&dev); (void)hipDeviceGetAttribute(&cus, hipDeviceAttributeMultiprocessorCount, dev);
        if (hipFuncSetAttribute((const void*)hybrid_fwd, hipFuncAttributeMaxDynamicSharedMemorySize, LDS_BYTES) != hipSuccess) { fprintf(stderr, "kernel_launch: hipFuncSetAttribute failed\n"); grid = -1; return; }
        if (hipOccupancyMaxActiveBlocksPerMultiprocessor(&per_cu, (const void*)hybrid_fwd, 512, LDS_BYTES) != hipSuccess || per_cu < 1) { fprintf(stderr, "kernel_launch: occupancy query says %d\n", per_cu); per_cu = 1; }
        (void)hipGetLastError();
        grid = cus * per_cu; if (grid > 256) grid = 256; if (grid < 1) grid = 256;
    }
    if (grid < 0) return;
    if (hipMemsetAsync((char*)d_ws + OFF_CTL, 0, CTL_BYTES, stream) != hipSuccess) { fprintf(stderr, "kernel_launch: memset failed\n"); return; }
    Args a{};
    for (int i = 0; i < 25; ++i) a.in[i] = d_in[i];
    a.out = (float*)d_out; a.ws = (unsigned char*)d_ws;
    void* kargs[] = {&a};
    hipError_t e = hipLaunchCooperativeKernel((const void*)hybrid_fwd, dim3(grid), dim3(512), kargs, LDS_BYTES, stream);
    if (e != hipSuccess) fprintf(stderr, "cooperative launch failed: %s (grid %d)\n", hipGetErrorString(e), grid);
}
```

```cpp
#define EPI_RB 4
#include <hip/hip_runtime.h>
#include <hip/hip_cooperative_groups.h>
#include <cstdio>
#include <cstdint>
namespace cg = cooperative_groups;
namespace pg8 {
#define PG8_LAS __attribute__((address_space(3)))
typedef unsigned short bf16_t;
typedef short bf16x8 __attribute__((ext_vector_type(8)));
typedef float f32x4 __attribute__((ext_vector_type(4)));
typedef unsigned u32x4 __attribute__((ext_vector_type(4)));
constexpr int BM = 256, BK = 64, HALF = 128, HTB = HALF * BK * 2  , STAGE_BYTES = 8 * HTB, NXCD = 8, WGM = 8;

__host__ __device__ __forceinline__ int lds_byte(int r, int c) { const int st = (r >> 4) * 2 + (c >> 5), rr = r & 15, cc = c & 31, ob = rr * 64 + cc * 2; return st * 1024 + (ob ^ (((ob >> 9) & 1) << 5)); }
__host__ __device__ __forceinline__ void stage_rc(int b, int& R, int& C) { const int st = b / 1024, sb = b % 1024, swz = sb ^ (((sb >> 9) & 1) << 5); R = (st >> 1) * 16 + swz / 64; C = (st & 1) * 32 + (swz % 64) / 2; }
__host__ __device__ __forceinline__ int perm32(int rho) { const int n = rho >> 4, i = rho & 15; return 8 * (i >> 2) + 4 * n + (i & 3); }

struct Unit { int pm, pn; };
struct Gemm { const bf16_t* A; const bf16_t* Bt; int M, N, K; };

struct StaticOrder {
    int nM, nN, nwg, G, c, rev;
    __host__ __device__ void init(int M, int N, int G_, int c_, int rev_ = 0) { nM = M / BM; nN = N / BM; nwg = nM * nN; G = G_; c = c_; rev = (rev_ && nwg % G_ == 0) ? 1 : 0; }
    __host__ __device__ bool next(int i, Unit& u) const {
        if ((long)i * G + c >= nwg) return false;
        const long L = (long)(rev ? nwg / G - 1 - i : i) * G + c;
        int wgid = (int)L; { const int q = nwg / NXCD, r = nwg % NXCD, xcd = wgid % NXCD, off = wgid / NXCD; wgid = (xcd < r ? xcd * (q + 1) : r * (q + 1) + (xcd - r) * q) + off; }
        const int nig = WGM * nN, gid = wgid / nig, fm = gid * WGM, gsz = (nM - fm) < WGM ? (nM - fm) : WGM;
        u.pm = fm + ((wgid % nig) % gsz); u.pn = (wgid % nig) / gsz; return true;
    }
    __device__ __forceinline__ void a_ready(const Unit&) const {}
    __device__ __forceinline__ void done(const Unit&) const {}
};

__device__ __forceinline__ unsigned cvt_pk_bf16(float lo, float hi) { unsigned r; asm volatile("v_cvt_pk_bf16_f32 %0, %1, %2" : "=v"(r) : "v"(lo), "v"(hi)); return r; }
typedef float f32x2 __attribute__((ext_vector_type(2)));
__device__ __forceinline__ f32x2 gelu_pk(f32x2 v) {
    const f32x2 av = __builtin_elementwise_abs(v), d = av * 0.2316418882f + 1.0f;
    f32x2 t; t.x = __builtin_amdgcn_rcpf(d.x); t.y = __builtin_amdgcn_rcpf(d.y);
    f32x2 q = t * 0.5307027145f + (-0.7265760135f); q = q * t + 0.7107068705f; q = q * t + (-0.142248368f); q = q * t + 0.127414796f; q = q * t;
    const f32x2 s = (v * v) * (-0.72134752044f);
    f32x2 e; e.x = __builtin_amdgcn_exp2f(s.x); e.y = __builtin_amdgcn_exp2f(s.y);
    const f32x2 m = v * (q * e), r = v - m;
    f32x2 o; o.x = v.x < 0.f ? m.x : r.x; o.y = v.y < 0.f ? m.y : r.y; return o;
}

template <int ACT  > struct EpiBf16 {
    static constexpr bool PERM = true, AFTER_DRAIN = false; static_assert(ACT == 0 || ACT == 1, "EpiBf16: ACT is 0 (none) or 1 (gelu_pk)");
    bf16_t* O; int ldc; const float* bias; int split_cols; size_t split_stride; float scale0;
    __device__ __forceinline__ void operator()(const f32x4 (&acc)[2][2][4][2], const Unit& u, int wr, int wc, int fr, int fq) const {
        const int row0 = u.pm * BM + wr * 64 + fr; int colt = u.pn * BM; bf16_t* base = O;
        float sc = 1.f; if (split_cols) { const int t = colt / split_cols; base += (size_t)t * split_stride; colt -= t * split_cols; if (t == 0) sc = scale0; }
        const int col0 = colt + wc * 32 + 8 * fq, bcol0 = u.pn * BM + wc * 32 + 8 * fq;
        f32x4 bv[2][2];
#pragma unroll
        for (int bj = 0; bj < 2; ++bj)
#pragma unroll
            for (int n = 0; n < 2; ++n) bv[bj][n] = bias ? *(const f32x4*)(bias + bcol0 + bj * HALF + 4 * n) : (f32x4){0.f, 0.f, 0.f, 0.f};
#pragma unroll
        for (int ai = 0; ai < 2; ++ai)
#pragma unroll
            for (int m = 0; m < 4; ++m) { bf16_t* rowp = base + (size_t)(row0 + ai * HALF + m * 16) * ldc + col0;
#pragma unroll
                for (int bj = 0; bj < 2; ++bj) { f32x4 v0 = acc[ai][bj][m][0] + bv[bj][0], v1 = acc[ai][bj][m][1] + bv[bj][1];
                    if (ACT == 1) { f32x2 a = gelu_pk((f32x2){v0[0], v0[1]}), b = gelu_pk((f32x2){v0[2], v0[3]}), c = gelu_pk((f32x2){v1[0], v1[1]}), d = gelu_pk((f32x2){v1[2], v1[3]});
                        v0 = (f32x4){a.x, a.y, b.x, b.y}; v1 = (f32x4){c.x, c.y, d.x, d.y}; }
                    v0 = v0 * sc; v1 = v1 * sc; u32x4 w; w.x = cvt_pk_bf16(v0[0], v0[1]); w.y = cvt_pk_bf16(v0[2], v0[3]); w.z = cvt_pk_bf16(v1[0], v1[1]); w.w = cvt_pk_bf16(v1[2], v1[3]);
                    *(u32x4*)(rowp + bj * HALF) = w; } }
    }
};
template <class Epi, class Sched, bool ALIGN_EPI = false, bool SP2 = false>
__device__ __forceinline__ void gemm_phase(PG8_LAS unsigned char* lds, const Gemm g, const Sched& S, const Epi& E) {
    int tid_ = threadIdx.x; asm volatile("" : "+v"(tid_)); const int tid = tid_, wid = __builtin_amdgcn_readfirstlane(tid >> 6), lane = tid & 63, wr = wid >> 2, wc = wid & 3, fr = lane & 15, fq = lane >> 4;
    const int K = g.K, nt = K / BK;
    unsigned voffA[2], voffB[2];
#pragma unroll
    for (int i = 0; i < 2; ++i) { int R, C; stage_rc(tid * 16 + i * 8192, R, C); const int Rb = Epi::PERM ? ((R & ~31) + perm32(R & 31)) : R;
        voffA[i] = (unsigned)(R * K + C) * 2u; voffB[i] = (unsigned)(Rb * K + C) * 2u; }
    const size_t kstep = (size_t)(BK * 2);
    const size_t hstep = (size_t)HALF * K * 2;
    const size_t tstep = 2 * hstep;
    const unsigned ldsw = (unsigned)wid * 1024u;
    const int aoff = lds_byte(wr * 64 + fr, fq * 8), boff = lds_byte(wc * 32 + fr, fq * 8);
#define PG8_SA(b, h) (((b) * 2 + (h)) * HTB)
#define PG8_SB(b, h) ((4 + (b) * 2 + (h)) * HTB)
#define PG8_STAGE(bufoff, gbase, voff) do { _Pragma("unroll") for (int _i = 0; _i < 2; ++_i) \
        __builtin_amdgcn_global_load_lds((const unsigned*)((const char*)(gbase) + (voff)[_i]), (PG8_LAS unsigned*)(lds + (bufoff) + ldsw + _i * 8192), 16, 0, 0); } while (0)
#define PG8_LDA(dst, b, h) do { _Pragma("unroll") for (int m = 0; m < 4; ++m) _Pragma("unroll") for (int k = 0; k < 2; ++k) dst[m][k] = *(const PG8_LAS bf16x8*)(lds + PG8_SA(b, h) + aoff + m * 2048 + k * 1024); } while (0)
#define PG8_LDB(dst, b, h) do { _Pragma("unroll") for (int n = 0; n < 2; ++n) _Pragma("unroll") for (int k = 0; k < 2; ++k) dst[n][k] = *(const PG8_LAS bf16x8*)(lds + PG8_SB(b, h) + boff + n * 2048 + k * 1024); } while (0)
#define PG8_MMA(ai, bj, At, Bt) do { __builtin_amdgcn_s_setprio(1); _Pragma("unroll") for (int m = 0; m < 4; ++m) _Pragma("unroll") for (int n = 0; n < 2; ++n) _Pragma("unroll") for (int k = 0; k < 2; ++k) \
        acc[ai][bj][m][n] = __builtin_amdgcn_mfma_f32_16x16x32_bf16(Bt[n][k], At[m][k], acc[ai][bj][m][n], 0, 0, 0); __builtin_amdgcn_s_setprio(0); } while (0)
#define PG8_WAIT_V(n) asm volatile("s_waitcnt vmcnt(" #n ")" ::: "memory")
#define PG8_WAIT_L(n) asm volatile("s_waitcnt lgkmcnt(" #n ")" ::: "memory")
#define PG8_BAR __builtin_amdgcn_s_barrier()
#define PG8_SCHED __builtin_amdgcn_sched_barrier(0)
    Unit cur, nxt; int ui = 0;
    if (!S.next(0, cur)) return;
    f32x4 acc[2][2][4][2];
#pragma unroll
    for (int a = 0; a < 2; ++a)
#pragma unroll
        for (int b = 0; b < 2; ++b)
#pragma unroll
            for (int m = 0; m < 4; ++m)
#pragma unroll
                for (int n = 0; n < 2; ++n) acc[a][b][m][n] = (f32x4){0.f, 0.f, 0.f, 0.f};
    bf16x8 At[4][2], B0[2][2], B1[2][2];
    const char* cA = (const char*)g.A + (size_t)cur.pm * tstep; const char* cB = (const char*)g.Bt + (size_t)cur.pn * tstep;
    S.a_ready(cur);
    if constexpr (SP2) {
        PG8_STAGE(PG8_SB(0, 0), cB, voffB); PG8_STAGE(PG8_SB(0, 1), cB + hstep, voffB); PG8_STAGE(PG8_SA(0, 0), cA, voffA); PG8_STAGE(PG8_SA(0, 1), cA + hstep, voffA);
        if (wr == 1) PG8_BAR;
        PG8_WAIT_V(2); PG8_BAR;
        PG8_STAGE(PG8_SB(1, 0), cB + kstep, voffB); PG8_STAGE(PG8_SA(1, 0), cA + kstep, voffA); PG8_STAGE(PG8_SB(1, 1), cB + hstep + kstep, voffB);
        PG8_WAIT_V(6); PG8_BAR;
    } else {
        PG8_STAGE(PG8_SB(0, 0), cB, voffB); PG8_STAGE(PG8_SA(0, 0), cA, voffA); PG8_STAGE(PG8_SB(0, 1), cB + hstep, voffB); PG8_STAGE(PG8_SA(0, 1), cA + hstep, voffA);
        if (wr == 1) PG8_BAR;
        PG8_WAIT_V(4); PG8_BAR;
        PG8_STAGE(PG8_SB(1, 0), cB + kstep, voffB); PG8_STAGE(PG8_SA(1, 0), cA + kstep, voffA); PG8_STAGE(PG8_SB(1, 1), cB + hstep + kstep, voffB);
        PG8_WAIT_V(6); PG8_BAR;
    }
    for (;;) {
        const bool has_next = S.next(ui + 1, nxt);
        const char* nA = has_next ? (const char*)g.A + (size_t)nxt.pm * tstep : cA; const char* nB = has_next ? (const char*)g.Bt + (size_t)nxt.pn * tstep : cB;
        for (int t = 0; t < nt; t += 2) {
            const bool last = (t == nt - 2);
            const char* a1 = cA + (size_t)(t + 1) * kstep;
            const char* a2 = last ? nA : cA + (size_t)(t + 2) * kstep; const char* b2 = last ? nB : cB + (size_t)(t + 2) * kstep;
            const char* a3 = a2 + kstep; const char* b3 = b2 + kstep;
            if (last && has_next) S.a_ready(nxt);
            if constexpr (SP2) {
            PG8_LDB(B0, 0, 0); PG8_LDB(B1, 0, 1); PG8_SCHED; PG8_LDA(At, 0, 0); PG8_STAGE(PG8_SA(1, 1), a1 + hstep, voffA);
            PG8_WAIT_V(8); PG8_WAIT_L(0); PG8_BAR; PG8_MMA(0, 0, At, B0); PG8_MMA(0, 1, At, B1); PG8_BAR; PG8_SCHED;
            PG8_LDA(At, 0, 1); PG8_STAGE(PG8_SB(0, 0), b2, voffB); PG8_STAGE(PG8_SB(0, 1), b2 + hstep, voffB); PG8_STAGE(PG8_SA(0, 0), a2, voffA);
            PG8_WAIT_V(8); PG8_WAIT_L(0); PG8_BAR; PG8_MMA(1, 0, At, B0); PG8_MMA(1, 1, At, B1); PG8_BAR; PG8_SCHED;
            PG8_LDB(B0, 1, 0); PG8_LDB(B1, 1, 1); PG8_SCHED; PG8_LDA(At, 1, 0); PG8_STAGE(PG8_SA(0, 1), a2 + hstep, voffA);
            PG8_WAIT_V(8); PG8_WAIT_L(0); PG8_BAR; PG8_MMA(0, 0, At, B0); PG8_MMA(0, 1, At, B1); PG8_BAR; PG8_SCHED;
            PG8_LDA(At, 1, 1); PG8_STAGE(PG8_SB(1, 0), b3, voffB); PG8_STAGE(PG8_SB(1, 1), b3 + hstep, voffB); PG8_STAGE(PG8_SA(1, 0), a3, voffA);
            PG8_WAIT_V(8); PG8_WAIT_L(0); PG8_BAR; PG8_MMA(1, 0, At, B0); PG8_MMA(1, 1, At, B1); PG8_BAR; PG8_SCHED;
            } else {
            PG8_LDB(B0, 0, 0); PG8_SCHED; PG8_LDA(At, 0, 0); PG8_STAGE(PG8_SA(1, 1), a1 + hstep, voffA);
            PG8_WAIT_L(8); PG8_BAR; PG8_WAIT_L(0); PG8_MMA(0, 0, At, B0); PG8_BAR; PG8_SCHED;
            PG8_LDB(B1, 0, 1); PG8_STAGE(PG8_SB(0, 0), b2, voffB);
            PG8_BAR; PG8_WAIT_L(0); PG8_MMA(0, 1, At, B1); PG8_BAR;
            PG8_LDA(At, 0, 1); PG8_STAGE(PG8_SA(0, 0), a2, voffA);
            PG8_BAR; PG8_WAIT_L(0); PG8_MMA(1, 0, At, B0); PG8_BAR; PG8_SCHED;
            PG8_STAGE(PG8_SB(0, 1), b2 + hstep, voffB);
            PG8_WAIT_V(6); PG8_BAR; PG8_MMA(1, 1, At, B1); PG8_BAR;
            PG8_LDB(B0, 1, 0); PG8_SCHED; PG8_LDA(At, 1, 0); PG8_STAGE(PG8_SA(0, 1), a2 + hstep, voffA);
            PG8_WAIT_L(8); PG8_BAR; PG8_WAIT_L(0); PG8_MMA(0, 0, At, B0); PG8_BAR; PG8_SCHED;
            PG8_LDB(B1, 1, 1); PG8_STAGE(PG8_SB(1, 0), b3, voffB);
            PG8_BAR; PG8_WAIT_L(0); PG8_MMA(0, 1, At, B1); PG8_BAR;
            PG8_LDA(At, 1, 1); PG8_STAGE(PG8_SA(1, 0), a3, voffA);
            PG8_BAR; PG8_WAIT_L(0); PG8_MMA(1, 0, At, B0); PG8_BAR; PG8_SCHED;
            PG8_STAGE(PG8_SB(1, 1), b3 + hstep, voffB);
            PG8_WAIT_V(6); PG8_BAR; PG8_MMA(1, 1, At, B1); PG8_BAR;
            }
        }
        if constexpr (ALIGN_EPI) { if (wr == 0) PG8_BAR; }
        if constexpr (!Epi::AFTER_DRAIN) { E(acc, cur, wr, wc, fr, fq); S.done(cur); }
        if (!has_next) break;
#pragma unroll
        for (int a = 0; a < 2; ++a)
#pragma unroll
            for (int b = 0; b < 2; ++b)
#pragma unroll
                for (int m = 0; m < 4; ++m)
#pragma unroll
                    for (int n = 0; n < 2; ++n) acc[a][b][m][n] = (f32x4){0.f, 0.f, 0.f, 0.f};
        cur = nxt; cA = nA; cB = nB; ++ui;
        if constexpr (ALIGN_EPI) { if (wr == 1) PG8_BAR; }
    }
    PG8_WAIT_V(0);
    if constexpr (!ALIGN_EPI) { if (wr == 0) PG8_BAR; }
    PG8_BAR;
    if constexpr (Epi::AFTER_DRAIN) { E.fused(acc, cur, wr, wc, fr, fq, lds, wid, lane); S.done(cur); }
#undef PG8_SA
#undef PG8_SB
#undef PG8_STAGE
#undef PG8_LDA
#undef PG8_LDB
#undef PG8_MMA
#undef PG8_WAIT_V
#undef PG8_WAIT_L
#undef PG8_BAR
#undef PG8_SCHED
}
}

constexpr int BATCH = 8, SEQ = 8192, DM = 1024, DEPTH = 4, GWID = 256, NHEAD = 4, HDIM = 64, INW = 2816, CHUNK = 128, DFF = 2816;
constexpr int M = BATCH * SEQ;
constexpr int NCH = SEQ / CHUNK;
constexpr int NCHUNK = M / CHUNK;
constexpr float LN_EPS = 1e-5f;
constexpr float DN_ALPHA = 1.6817928305074290f;
constexpr int ZC_AU = 0, ZC_AV = 256, ZC_RQ = 512, ZC_RK = 768, ZC_RV = 1024, ZC_RG = 1280, ZC_CX = 1536, ZC_CG = 1792, ZC_DB = 2048, ZC_DC = 2304, ZC_DH = 2560;

#define LAS __attribute__((address_space(3)))
typedef unsigned short bf16;
typedef short bf16x8 __attribute__((ext_vector_type(8)));
typedef float f32x4 __attribute__((ext_vector_type(4)));
typedef unsigned u32x4 __attribute__((ext_vector_type(4)));
typedef unsigned u32x2 __attribute__((ext_vector_type(2)));

constexpr size_t SZ_WIN = (size_t)INW * DM * 2, SZ_WOUT = (size_t)DM * DM * 2, SZ_WGU = (size_t)2 * DFF * DM * 2, SZ_WD = (size_t)DM * DFF * 2, SZ_LRUW = (size_t)16 * 4096 * 2;
constexpr size_t OFF_WIN = 0;
constexpr size_t OFF_WOUT = OFF_WIN + DEPTH * SZ_WIN;
constexpr size_t OFF_WGU = OFF_WOUT + DEPTH * SZ_WOUT;
constexpr size_t OFF_WD = OFF_WGU + DEPTH * SZ_WGU;
constexpr size_t OFF_LRUW = OFF_WD + DEPTH * SZ_WD;
constexpr size_t OFF_XB = OFF_LRUW + DEPTH * SZ_LRUW;
constexpr size_t OFF_Z = OFF_XB + (size_t)M * DM * 2;
constexpr size_t OFF_Y = OFF_Z + (size_t)M * INW * 2;
constexpr size_t OFF_UF = OFF_Y + (size_t)M * DM * 2;
constexpr size_t USTRIDE = (size_t)BATCH * NHEAD * 4096;
constexpr size_t OFF_UB = OFF_UF + (size_t)NCH * USTRIDE * 2;
constexpr size_t OFF_CA = OFF_UB + (size_t)NCH * USTRIDE * 2;
constexpr size_t OFF_CH = OFF_CA + (size_t)BATCH * NCH * 512 * 4;
constexpr size_t OFF_SP = OFF_CH + (size_t)BATCH * NCH * 512 * 4;
constexpr size_t OFF_S1 = OFF_SP + (size_t)3 * DEPTH * 2 * GWID * 4;
constexpr size_t OFF_T1 = OFF_S1 + (size_t)DEPTH * INW * 4;
constexpr size_t OFF_S3 = OFF_T1 + (size_t)DEPTH * INW * 4;
constexpr size_t OFF_T3 = OFF_S3 + (size_t)DEPTH * 2 * DFF * 4;
constexpr size_t OFF_WSB = OFF_T3 + (size_t)DEPTH * 2 * DFF * 4;
constexpr size_t OFF_P0 = OFF_WSB + (size_t)DEPTH * NHEAD * CHUNK * CHUNK * 2;
constexpr size_t OFF_P1 = OFF_P0 + (size_t)M * 2 * 8;
constexpr size_t OFF_CTL = OFF_P1 + (size_t)M * 2 * 8;
constexpr size_t CTL_BYTES = 16384;
constexpr size_t WS_END = OFF_CTL + CTL_BYTES;
constexpr int LDS_MISC_OFF = 131072, LDS_GB_OFF = 131072 + 256, LDS_BYTES = 131072 + 256 + 8192;

__device__ __forceinline__ float bflo(unsigned w) { return __uint_as_float(w << 16); }
__device__ __forceinline__ float bfhi(unsigned w) { return __uint_as_float(w & 0xffff0000u); }
__device__ __forceinline__ void unpack8(const u32x4 w, float* f) { f[0] = bflo(w.x); f[1] = bfhi(w.x); f[2] = bflo(w.y); f[3] = bfhi(w.y); f[4] = bflo(w.z); f[5] = bfhi(w.z); f[6] = bflo(w.w); f[7] = bfhi(w.w); }
__device__ __forceinline__ void unpack4(const u32x2 w, float* f) { f[0] = bflo(w.x); f[1] = bfhi(w.x); f[2] = bflo(w.y); f[3] = bfhi(w.y); }
__device__ __forceinline__ unsigned pk2(float lo, float hi) { return pg8::cvt_pk_bf16(lo, hi); }
__device__ __forceinline__ bf16 f2bf(float x) { return (bf16)(pg8::cvt_pk_bf16(x, 0.f) & 0xffffu); }
__device__ __forceinline__ u32x4 pack8(const float* f) { u32x4 w; w.x = pk2(f[0], f[1]); w.y = pk2(f[2], f[3]); w.z = pk2(f[4], f[5]); w.w = pk2(f[6], f[7]); return w; }
__device__ __forceinline__ float sigmoid_f(float x) { return __builtin_amdgcn_rcpf(1.0f + __expf(-x)); }
__device__ __forceinline__ float silu_f(float x) { return x * sigmoid_f(x); }
__device__ __forceinline__ float gelu_f(float x) { return x * sigmoid_f(1.5957691216057308f * (x + 0.044715f * x * x * x)); }
__device__ __forceinline__ float log_gamma_h(int h) { return h == 0 ? -0.0317486983145803f : (h == 1 ? -0.015748356968139168f : (h == 2 ? -0.007843177461025893f : -0.003913899321136329f)); }
__device__ __forceinline__ void rope_cs(float pos, int i, float& c, float& s) {
    const float invf = exp2f(-(float)i * 0.4152410118609203f);
    const float ang = pos * invf;
    const float n = rintf(ang * 0.15915494309189535f);
    float r = fmaf(-n, 6.2831854820251465f, ang); r = fmaf(-n, -1.7484555e-7f, r);
    const float rv = r * 0.15915494309189535f;
    s = __builtin_amdgcn_sinf(rv); c = __builtin_amdgcn_cosf(rv);
}
__device__ __forceinline__ float neg_expm1_f(float x) {
    const float p = -x * (1.0f + x * (0.5f + x * (0.16666667f + x * (0.041666668f + x * 0.0083333338f))));
    return x > -0.25f ? p : 1.0f - __expf(x);
}
#define MFMA16(a, b, c) __builtin_amdgcn_mfma_f32_16x16x32_bf16((a), (b), (c), 0, 0, 0)
template <int CTRL> __device__ __forceinline__ float dpp_f(float oldv, float src) { return __int_as_float(__builtin_amdgcn_update_dpp(__float_as_int(oldv), __float_as_int(src), CTRL, 0xf, 0xf, false)); }

#ifndef EPI_RB
#define EPI_RB 4
#endif
typedef long long i64x2 __attribute__((ext_vector_type(2)));
__device__ __forceinline__ float fx2f(long long v) { return (float)(int)(v >> 32) + (float)(unsigned)v * 2.3283064365386963e-10f; }
__device__ __forceinline__ void row_stats_fin(const i64x2 v, float& mu, float& rs) { mu = fx2f(v.x) * (1.f / DM); const float var = fmaxf(fx2f(v.y) * (1.f / DM) - mu * mu, 0.f); rs = __builtin_amdgcn_rsqf(var + LN_EPS); }
__device__ __forceinline__ void row_stats8(const long long* P, int row0, float (&mu8)[8], float (&rs8)[8]) {
    i64x2 raw[8];
#pragma unroll
    for (int q = 0; q < 8; ++q) raw[q] = *(const i64x2*)(P + 2 * (size_t)(row0 + (q >> 2) * 128 + (q & 3) * 16));
    asm volatile("" ::: "memory");
#pragma unroll
    for (int q = 0; q < 8; ++q) row_stats_fin(raw[q], mu8[q], rs8[q]);
}
__device__ __forceinline__ void row_stats(const long long* P, int row, float& mu, float& rs) {
    const i64x2 v = *(const i64x2*)(P + 2 * (size_t)row); mu = fx2f(v.x) * (1.f / DM); const float var = fmaxf(fx2f(v.y) * (1.f / DM) - mu * mu, 0.f); rs = __builtin_amdgcn_rsqf(var + LN_EPS);
}
struct EpiLnBf16 {
    static constexpr bool PERM = true, AFTER_DRAIN = false;
    bf16* O; int ldc; const long long* P; const float* S; const float* T; int fold;
    __device__ __forceinline__ void operator()(const pg8::f32x4 (&acc)[2][2][4][2], const pg8::Unit& u, int wr, int wc, int fr, int fq) const {
        const int row0 = u.pm * 256 + wr * 64 + fr, col0 = u.pn * 256 + wc * 32 + 8 * fq;
        f32x4 sv[2][2], tv[2][2];
#pragma unroll
        for (int bj = 0; bj < 2; ++bj)
#pragma unroll
            for (int n = 0; n < 2; ++n) { sv[bj][n] = fold ? *(const f32x4*)(S + col0 + bj * 128 + 4 * n) : (f32x4){0.f, 0.f, 0.f, 0.f}; tv[bj][n] = fold ? *(const f32x4*)(T + col0 + bj * 128 + 4 * n) : (f32x4){0.f, 0.f, 0.f, 0.f}; }
        float mu8[8], rs8[8];
#pragma unroll
        for (int q = 0; q < 8; ++q) { mu8[q] = 0.f; rs8[q] = 1.f; }
        if (fold) row_stats8(P, row0, mu8, rs8);
#pragma unroll
        for (int ai = 0; ai < 2; ++ai)
#pragma unroll
            for (int m = 0; m < 4; ++m) { const int row = row0 + ai * 128 + m * 16; const float mu = mu8[ai * 4 + m], rs = rs8[ai * 4 + m];
                bf16* rowp = O + (size_t)row * ldc + col0;
#pragma unroll
                for (int bj = 0; bj < 2; ++bj) { const f32x4 v0 = (acc[ai][bj][m][0] - sv[bj][0] * mu) * rs + tv[bj][0], v1 = (acc[ai][bj][m][1] - sv[bj][1] * mu) * rs + tv[bj][1];
                    u32x4 w; w.x = pk2(v0[0], v0[1]); w.y = pk2(v0[2], v0[3]); w.z = pk2(v1[0], v1[1]); w.w = pk2(v1[2], v1[3]);
                    *(u32x4*)(rowp + bj * 128) = w; } }
    }
};
struct EpiSwiGLU {
    static constexpr bool PERM = true, AFTER_DRAIN = false;
    bf16* O; const long long* P; const float* S; const float* T;
    __device__ __forceinline__ void operator()(const pg8::f32x4 (&acc)[2][2][4][2], const pg8::Unit& u, int wr, int wc, int fr, int fq) const {
        const int row0 = u.pm * 256 + wr * 64 + fr, col0 = u.pn * 128 + wc * 32 + 8 * fq, gcol0 = u.pn * 256 + wc * 32 + 8 * fq;
        f32x4 sv[2][2], tv[2][2];
#pragma unroll
        for (int bj = 0; bj < 2; ++bj)
#pragma unroll
            for (int n = 0; n < 2; ++n) { sv[bj][n] = *(const f32x4*)(S + gcol0 + bj * 128 + 4 * n); tv[bj][n] = *(const f32x4*)(T + gcol0 + bj * 128 + 4 * n); }
        float mu8[8], rs8[8];
        row_stats8(P, row0, mu8, rs8);
#pragma unroll
        for (int ai = 0; ai < 2; ++ai)
#pragma unroll
            for (int m = 0; m < 4; ++m) { const int row = row0 + ai * 128 + m * 16; const float mu = mu8[ai * 4 + m], rs = rs8[ai * 4 + m];
                bf16* rowp = O + (size_t)row * DFF + col0;
                const f32x4 g0 = (acc[ai][0][m][0] - sv[0][0] * mu) * rs + tv[0][0], g1 = (acc[ai][0][m][1] - sv[0][1] * mu) * rs + tv[0][1];
                const f32x4 u0 = (acc[ai][1][m][0] - sv[1][0] * mu) * rs + tv[1][0], u1 = (acc[ai][1][m][1] - sv[1][1] * mu) * rs + tv[1][1];
#define SWG(gv, uv, j) ((gv[j] * uv[j]) * __builtin_amdgcn_rcpf(1.0f + __builtin_amdgcn_exp2f(gv[j])))
                u32x4 w; w.x = pk2(SWG(g0, u0, 0), SWG(g0, u0, 1)); w.y = pk2(SWG(g0, u0, 2), SWG(g0, u0, 3));
                w.z = pk2(SWG(g1, u1, 0), SWG(g1, u1, 1)); w.w = pk2(SWG(g1, u1, 2), SWG(g1, u1, 3));
#undef SWG
                *(u32x4*)rowp = w; }
    }
};
template <int RAW> struct EpiResLn {
    static constexpr bool PERM = true, AFTER_DRAIN = false;
    const float* resf; float* outf; const bf16* xb; bf16* xbo; const long long* Pin; const LAS float* gb; long long* Pout; int wf32; float alpha;
    __device__ __forceinline__ void operator()(const pg8::f32x4 (&acc)[2][2][4][2], const pg8::Unit& u, int wr, int wc, int fr, int fq) const {
        const int row0 = u.pm * 256 + wr * 64 + fr, col0 = u.pn * 256 + wc * 32 + 8 * fq;
#pragma unroll
        for (int gq = 0; gq < 8 / EPI_RB; ++gq) {
            u32x4 sw[EPI_RB][2]; float mu[EPI_RB], rs[EPI_RB]; i64x2 pr[EPI_RB];
#pragma unroll
            for (int mm = 0; mm < EPI_RB; ++mm) { const int q = gq * EPI_RB + mm, row = row0 + (q >> 2) * 128 + (q & 3) * 16;
                mu[mm] = 0.f; rs[mm] = 1.f;
                if (!RAW) { pr[mm] = *(const i64x2*)(Pin + 2 * (size_t)row);
#pragma unroll
                    for (int bj = 0; bj < 2; ++bj) sw[mm][bj] = *(const u32x4*)(xb + (size_t)row * DM + col0 + bj * 128); } }
            asm volatile("" ::: "memory");
            if (!RAW) {
#pragma unroll
                for (int mm = 0; mm < EPI_RB; ++mm) row_stats_fin(pr[mm], mu[mm], rs[mm]); }
#pragma unroll
            for (int mm = 0; mm < EPI_RB; ++mm) { const int q = gq * EPI_RB + mm, ai = q >> 2, m = q & 3; const int row = row0 + ai * 128 + m * 16; const size_t off = (size_t)row * DM + col0;
                float sm = 0.f, sq = 0.f;
#pragma unroll
                for (int bj = 0; bj < 2; ++bj) { f32x4 v[2];
#pragma unroll
                    for (int n = 0; n < 2; ++n) { f32x4 r;
                        if (RAW) r = *(const f32x4*)(resf + off + bj * 128 + 4 * n);
                        else { const u32x4 w = sw[mm][bj]; r = n ? (f32x4){bflo(w.z), bfhi(w.z), bflo(w.w), bfhi(w.w)} : (f32x4){bflo(w.x), bfhi(w.x), bflo(w.y), bfhi(w.y)}; }
                        const f32x4 gvv = *(const LAS f32x4*)(gb + col0 + bj * 128 + 4 * n), bvv = *(const LAS f32x4*)(gb + DM + col0 + bj * 128 + 4 * n);
                        const f32x4 rr = (r - mu[mm]) * rs[mm] * gvv + bvv;
                        v[n] = rr * alpha + acc[ai][bj][m][n];
                        if (wf32) *(f32x4*)(outf + off + bj * 128 + 4 * n) = v[n];
                        sm += (v[n][0] + v[n][1]) + (v[n][2] + v[n][3]); sq += (v[n][0] * v[n][0] + v[n][1] * v[n][1]) + (v[n][2] * v[n][2] + v[n][3] * v[n][3]); }
                    u32x4 w; w.x = pk2(v[0][0], v[0][1]); w.y = pk2(v[0][2], v[0][3]); w.z = pk2(v[1][0], v[1][1]); w.w = pk2(v[1][2], v[1][3]);
                    if (!wf32) *(u32x4*)(xbo + off + bj * 128) = w; }
                sm += __shfl_xor(sm, 16); sm += __shfl_xor(sm, 32); sq += __shfl_xor(sq, 16); sq += __shfl_xor(sq, 32);
                if (fq == 0) { __hip_atomic_fetch_add(Pout + 2 * (size_t)row, (long long)(sm * 4294967296.0f), __ATOMIC_RELAXED, __HIP_MEMORY_SCOPE_AGENT); __hip_atomic_fetch_add(Pout + 2 * (size_t)row + 1, (long long)(sq * 4294967296.0f), __ATOMIC_RELAXED, __HIP_MEMORY_SCOPE_AGENT); } }
            asm volatile("" ::: "memory");
        }
    }
};
__device__ __forceinline__ void stage_gain_bias(LAS float* gb, const float* g, const float* b, int raw) {
    int tid_ = threadIdx.x; asm volatile("" : "+v"(tid_));
    const int i = tid_ & 255; const bool isb = tid_ >= 256;
    f32x4 v = raw ? (isb ? (f32x4){0.f, 0.f, 0.f, 0.f} : (f32x4){1.f, 1.f, 1.f, 1.f}) : *((const f32x4*)(isb ? b : g) + i);
    *((LAS f32x4*)(gb + (isb ? DM : 0)) + i) = v;
    __syncthreads();
}

struct Args { const void* in[25]; float* out; unsigned char* ws; };
struct Ctx {
    const float* x; const int* pos; const float* w_in; const float* gmlp_ln_g; const float* gmlp_ln_b; const float* gmlp_ws; const float* gmlp_bs; const float* ret_gn_g; const float* ret_gn_b;
    const float* lru_conv_w; const float* lru_conv_b; const float* lru_wa; const float* lru_ba; const float* lru_wx; const float* lru_bx; const float* lru_lambda; const float* sc_conv_w;
    const float* w_out; const float* ln1_g; const float* ln1_b; const float* ffn_wg; const float* ffn_wu; const float* ffn_wd; const float* ln2_g; const float* ln2_b;
    float* out; bf16 *WIN, *WOUT, *WGU, *WD, *LRUW, *XB, *Z, *Y, *UF, *UB; float *CA, *CH, *SP, *BA2, *BX2, *S1, *T1, *S3, *T3; long long *P0, *P1; bf16* WSB;
};

__device__ __forceinline__ void tr_item(const float* W, int N, bf16* dst_rows, int ldt, int k0, int n0, LAS float* scr, int lane, const float* gs = nullptr, float sc = 1.0f) {
#pragma unroll 16
    for (int i = 0; i < 32; ++i) { const int kk = 2 * i + (lane >> 5); scr[kk * 33 + (lane & 31)] = W[(size_t)(k0 + kk) * N + n0 + (lane & 31)] * (gs ? gs[k0 + kk] * sc : sc); }
    asm volatile("s_waitcnt lgkmcnt(0)" ::: "memory");
    const int c = lane & 7;
#pragma unroll
    for (int j = 0; j < 4; ++j) { const int n = (lane >> 3) + 8 * j; const LAS float* s = scr + (8 * c) * 33 + n;
        u32x4 o; o.x = pk2(s[0 * 33], s[1 * 33]); o.y = pk2(s[2 * 33], s[3 * 33]); o.z = pk2(s[4 * 33], s[5 * 33]); o.w = pk2(s[6 * 33], s[7 * 33]);
        *(u32x4*)(dst_rows + (size_t)n * ldt + k0 + 8 * c) = o; }
    asm volatile("s_waitcnt lgkmcnt(0)" ::: "memory");
}
__device__ __forceinline__ void prologue(const Ctx& C, LAS unsigned char* lds) {
    int tid_ = threadIdx.x; asm volatile("" : "+v"(tid_)); const int tid = tid_, lane = tid & 63, wave = tid >> 6;
    LAS float* scr = (LAS float*)(lds + wave * 16384);
    const int gw = blockIdx.x * 8 + wave, NGW = gridDim.x * 8;
    constexpr int I_IN = (DM / 64) * (INW / 32), I_OUT = (DM / 64) * (DM / 32), I_G = (DM / 64) * (DFF / 32), I_D = (DFF / 64) * (DM / 32), I_L = 8 * 2;
    constexpr int PER_LAYER = I_IN + I_OUT + 2 * I_G + I_D + 2 * I_L;
    for (int it = gw; it < DEPTH * PER_LAYER; it += NGW) {
        const int l = it / PER_LAYER; int r = it % PER_LAYER;
        if (r < I_IN) { const int nb = INW / 32, k0 = 64 * (r / nb), n0 = 32 * (r % nb); tr_item(C.w_in + (size_t)l * DM * INW, INW, C.WIN + (size_t)l * INW * DM + (size_t)n0 * DM, DM, k0, n0, scr, lane, l ? C.ln2_g + (l - 1) * DM : nullptr); continue; } r -= I_IN;
        if (r < I_OUT) { const int nb = DM / 32, k0 = 64 * (r / nb), n0 = 32 * (r % nb); tr_item(C.w_out + (size_t)l * DM * DM, DM, C.WOUT + (size_t)l * DM * DM + (size_t)n0 * DM, DM, k0, n0, scr, lane); continue; } r -= I_OUT;
        if (r < 2 * I_G) { const int up = r >= I_G; if (up) r -= I_G; const int nb = DFF / 32, k0 = 64 * (r / nb), n0 = 32 * (r % nb); const int drow = 256 * (n0 / 128) + (n0 % 128) + (up ? 128 : 0);
            tr_item((up ? C.ffn_wu : C.ffn_wg) + (size_t)l * DM * DFF, DFF, C.WGU + (size_t)l * 2 * DFF * DM + (size_t)drow * DM, DM, k0, n0, scr, lane, C.ln1_g + l * DM, up ? -0.6931471805599453f : -1.4426950408889634f); continue; } r -= 2 * I_G;
        if (r < I_D) { const int nb = DM / 32, k0 = 64 * (r / nb), n0 = 32 * (r % nb); tr_item(C.ffn_wd + (size_t)l * DFF * DM, DM, C.WD + (size_t)l * DM * DFF + (size_t)n0 * DFF, DFF, k0, n0, scr, lane); continue; } r -= I_D;
        { const int which = r >= I_L; if (which) r -= I_L; const int mat = r >> 1, n0 = 32 * (r & 1);
          tr_item((which ? C.lru_wx : C.lru_wa) + ((size_t)l * 8 + mat) * 4096, 64, C.LRUW + (((size_t)l * 2 + which) * 8 + mat) * 4096 + (size_t)n0 * 64, 64, 0, n0, scr, lane, nullptr, -1.4426950408889634f); }
    }
    __syncthreads();
    {
        LAS float* red = (LAS float*)lds;
#pragma unroll 1
        for (int task = blockIdx.x; task < DEPTH * 66; task += gridDim.x) {
            const int l = task / 66, r = task % 66, kind = r / 22, cb = r % 22;
            if (kind == 0 && l == 0) continue;
            const float *pw0 = C.w_in, *pw1 = C.ffn_wg, *pw2 = C.ffn_wu, *pg0 = C.ln2_g, *pg1 = C.ln1_g, *pb0 = C.ln2_b, *pb1 = C.ln1_b;
            asm volatile("" : "+s"(pw0), "+s"(pw1), "+s"(pw2), "+s"(pg0), "+s"(pg1), "+s"(pb0), "+s"(pb1));
            const float* W = (kind == 0 ? pw0 : (kind == 1 ? pw1 : pw2)) + (size_t)l * DM * INW;
            const float* gk = kind == 0 ? pg0 + (l - 1) * DM : pg1 + l * DM; const float* bk = kind == 0 ? pb0 + (l - 1) * DM : pb1 + l * DM;
            const int col = cb * 128 + (tid & 127), slice = tid >> 7;
            const float wsc = kind == 0 ? 1.0f : (kind == 1 ? -1.4426950408889634f : -0.6931471805599453f);
            float sa = 0.f, ta = 0.f;
#pragma unroll 16
            for (int k = slice * 256; k < slice * 256 + 256; ++k) { const float wv = W[(size_t)k * INW + col] * wsc; sa += bflo(pk2(gk[k] * wv, 0.f)); ta += bk[k] * wv; }
            red[tid * 2] = sa; red[tid * 2 + 1] = ta;
            __syncthreads();
            if (tid < 128) { const float ss = (red[tid * 2] + red[(tid + 128) * 2]) + (red[(tid + 256) * 2] + red[(tid + 384) * 2]);
                const float tt = (red[tid * 2 + 1] + red[(tid + 128) * 2 + 1]) + (red[(tid + 256) * 2 + 1] + red[(tid + 384) * 2 + 1]);
                if (kind == 0) { C.S1[l * INW + cb * 128 + tid] = ss; C.T1[l * INW + cb * 128 + tid] = tt; }
                else { const int d = l * 2 * DFF + 256 * cb + (kind == 2 ? 128 : 0) + tid; C.S3[d] = ss; C.T3[d] = tt; } }
            __syncthreads();
        }
    }
    if (blockIdx.x * 512 + tid < DEPTH * 2 * GWID) { const int i = blockIdx.x * 512 + tid;
        C.SP[i] = -8.0f * 1.4426950408889634f * log1pf(expf(-C.lru_lambda[i])); C.BA2[i] = -1.4426950408889634f * C.lru_ba[i]; C.BX2[i] = -1.4426950408889634f * C.lru_bx[i]; }
    for (size_t i = (size_t)blockIdx.x * 512 + tid; i < (size_t)DEPTH * NHEAD * CHUNK * CHUNK / 8; i += (size_t)gridDim.x * 512) { const f32x4 a = *(const f32x4*)(C.gmlp_ws + i * 8), b4 = *(const f32x4*)(C.gmlp_ws + i * 8 + 4);
        u32x4 o; o.x = pk2(a[0], a[1]); o.y = pk2(a[2], a[3]); o.z = pk2(b4[0], b4[1]); o.w = pk2(b4[2], b4[3]); *(u32x4*)(C.WSB + i * 8) = o; }
    const size_t gt = (size_t)blockIdx.x * 512 + tid, NT = (size_t)gridDim.x * 512;
#pragma unroll 4
    for (size_t i = gt; i < (size_t)M * DM / 8; i += NT) { const f32x4 a = *(const f32x4*)(C.x + i * 8), b = *(const f32x4*)(C.x + i * 8 + 4);
        u32x4 o; o.x = pk2(a[0], a[1]); o.y = pk2(a[2], a[3]); o.z = pk2(b[0], b[1]); o.w = pk2(b[2], b[3]); *(u32x4*)(C.XB + i * 8) = o; }
}

__device__ __forceinline__ float wave_sum(float v) {
#pragma unroll
    for (int o = 1; o < 64; o <<= 1) v += __shfl_xor(v, o);
    return v;
}
__device__ __forceinline__ void final_ln(float* X, const long long* P, const float* g, const float* b) {
    int tid_ = threadIdx.x; asm volatile("" : "+v"(tid_)); const int lane = tid_ & 63, wave = tid_ >> 6;
    const int gw = blockIdx.x * 8 + wave, NGW = gridDim.x * 8;
    f32x4 gv[4], bv[4];
#pragma unroll
    for (int j = 0; j < 4; ++j) { gv[j] = *((const f32x4*)g + lane + 64 * j); bv[j] = *((const f32x4*)b + lane + 64 * j); }
    for (int m = gw; m < M; m += NGW) { f32x4* xr = (f32x4*)(X + (size_t)m * DM) + lane; float mu, rs; row_stats(P, m, mu, rs);
#pragma unroll
        for (int j = 0; j < 4; ++j) xr[64 * j] = (xr[64 * j] - mu) * rs * gv[j] + bv[j]; }
}
__device__ __forceinline__ void zero_rows(long long* P) {
    int tid_ = threadIdx.x; asm volatile("" : "+v"(tid_));
    for (int i = blockIdx.x * 512 + tid_; i < M * 2 * 8 / 16; i += gridDim.x * 512) *((f32x4*)P + i) = (f32x4){0.f, 0.f, 0.f, 0.f};
    asm volatile("s_waitcnt vmcnt(0)" ::: "memory");
}

__device__ __forceinline__ void gmlp_chunk(const Ctx& C, int l, int chunk, LAS unsigned char* lds) {
    int tid_ = threadIdx.x; asm volatile("" : "+v"(tid_)); const int tid = tid_, lane = tid & 63, w = tid >> 6, fr = lane & 15, fq = lane >> 4;
    LAS bf16* vnT = (LAS bf16*)lds;
    const int row0 = chunk * CHUNK;
    {
        const int t = tid >> 2, q4 = tid & 3;
        const bf16* src = C.Z + (size_t)(row0 + t) * INW + ZC_AV + 64 * q4;
        float v[64]; float s = 0.f;
#pragma unroll
        for (int i = 0; i < 8; ++i) { const u32x4 wv = *(const u32x4*)(src + 8 * i); float f[8]; unpack8(wv, f);
#pragma unroll
            for (int j = 0; j < 8; ++j) { v[8 * i + j] = gelu_f(f[j]); s += v[8 * i + j]; } }
        s += __shfl_xor(s, 1); s += __shfl_xor(s, 2);
        const float mean = s * (1.f / 256.f); float q = 0.f;
#pragma unroll
        for (int i = 0; i < 64; ++i) { v[i] -= mean; q += v[i] * v[i]; }
        q += __shfl_xor(q, 1); q += __shfl_xor(q, 2);
        const float rstd = 1.f / sqrtf(q * (1.f / 256.f) + LN_EPS);
        const f32x4* g4 = (const f32x4*)(C.gmlp_ln_g + l * GWID + 64 * q4); const f32x4* b4 = (const f32x4*)(C.gmlp_ln_b + l * GWID + 64 * q4);
        f32x4 gg[16], bv[16];
#pragma unroll
        for (int i4 = 0; i4 < 16; ++i4) { gg[i4] = g4[i4]; bv[i4] = b4[i4]; }
        const int tt = t ^ (16 * q4);
#pragma unroll
        for (int i4 = 0; i4 < 16; ++i4) {
            const unsigned w0 = pk2(v[4 * i4] * rstd * gg[i4][0] + bv[i4][0], v[4 * i4 + 1] * rstd * gg[i4][1] + bv[i4][1]), w1 = pk2(v[4 * i4 + 2] * rstd * gg[i4][2] + bv[i4][2], v[4 * i4 + 3] * rstd * gg[i4][3] + bv[i4][3]);
            LAS bf16* dst = vnT + (64 * q4 + 4 * i4) * 136 + tt;
            dst[0] = (bf16)(w0 & 0xffffu); dst[136] = (bf16)(w0 >> 16); dst[2 * 136] = (bf16)(w1 & 0xffffu); dst[3 * 136] = (bf16)(w1 >> 16); }
    }
    __syncthreads();
    {
        const int p = 16 * w + fr;
        u32x2 uw[NHEAD][4];
#pragma unroll
        for (int h = 0; h < NHEAD; ++h)
#pragma unroll
            for (int nt = 0; nt < 4; ++nt) uw[h][nt] = *(const u32x2*)(C.Z + (size_t)(row0 + p) * INW + ZC_AU + 64 * h + 16 * nt + 4 * fq);
#pragma unroll
        for (int h = 0; h < NHEAD; ++h) {
            f32x4 acc[4];
#pragma unroll
            for (int nt = 0; nt < 4; ++nt) acc[nt] = (f32x4){0.f, 0.f, 0.f, 0.f};
            const bf16* wsrow = C.WSB + ((size_t)(l * NHEAD + h) * CHUNK + p) * CHUNK;
            bf16x8 af[4];
#pragma unroll
            for (int ks = 0; ks < 4; ++ks) af[ks] = *(const bf16x8*)(wsrow + 32 * ks + 8 * fq);
#pragma unroll
            for (int ks = 0; ks < 4; ++ks)
#pragma unroll
                for (int nt = 0; nt < 4; ++nt) { const bf16x8 bfg = *(const LAS bf16x8*)(vnT + (64 * h + 16 * nt + fr) * 136 + 8 * ((4 * ks + fq) ^ (2 * h))); acc[nt] = MFMA16(bfg, af[ks], acc[nt]); }
            const float bias = C.gmlp_bs[(l * NHEAD + h) * CHUNK + p];
#pragma unroll
            for (int nt = 0; nt < 4; ++nt) { const int c = 64 * h + 16 * nt + 4 * fq;
                float uf[4]; unpack4(uw[h][nt], uf);
                u32x2 o; o.x = pk2(gelu_f(uf[0]) * (acc[nt][0] + bias), gelu_f(uf[1]) * (acc[nt][1] + bias)); o.y = pk2(gelu_f(uf[2]) * (acc[nt][2] + bias), gelu_f(uf[3]) * (acc[nt][3] + bias));
                *(u32x2*)(C.Y + (size_t)(row0 + p) * DM + 0 + c) = o; }
        }
    }
    __syncthreads();
}

__device__ __forceinline__ void ret_pass1(const Ctx& C, int chunk, LAS unsigned char* lds) {
    int tid_ = threadIdx.x; asm volatile("" : "+v"(tid_)); const int tid = tid_, lane = tid & 63, w = tid >> 6, fr = lane & 15, fq = lane >> 4;
    LAS bf16* vT = (LAS bf16*)lds; LAS bf16* kfT = vT + 64 * 136; LAS bf16* kbT = kfT + 64 * 136;
    const int b = chunk >> 6, n = chunk & 63, row0 = chunk * CHUNK;
    const int j = tid >> 2, sub = tid & 3;
    const bf16* zrow = C.Z + (size_t)(row0 + j) * INW;
    u32x4 k1w = *(const u32x4*)(zrow + ZC_RK + 8 * sub), k2w = *(const u32x4*)(zrow + ZC_RK + 32 + 8 * sub);
    u32x4 v1w = *(const u32x4*)(zrow + ZC_RV + 16 * sub), v2w = *(const u32x4*)(zrow + ZC_RV + 16 * sub + 8);
    float cs[8], sn[8];
    { const float pos = (float)C.pos[row0 + j];
#pragma unroll
      for (int ii = 0; ii < 8; ++ii) rope_cs(pos, 8 * sub + ii, cs[ii], sn[ii]); }
#pragma unroll 1
    for (int h = 0; h < NHEAD; ++h) {
        {
            const float lgm = log_gamma_h(h);
            const float decf = __expf(lgm * (float)(CHUNK - 1 - j)) * 0.125f, decb = __expf(lgm * (float)j) * 0.125f;
            float k1[8], k2[8]; unpack8(k1w, k1); unpack8(k2w, k2);
#pragma unroll
            for (int ii = 0; ii < 8; ++ii) { const int i = 8 * sub + ii;
                const float r1 = k1[ii] * cs[ii] - k2[ii] * sn[ii], r2 = k2[ii] * cs[ii] + k1[ii] * sn[ii];
                kfT[i * 136 + j] = f2bf(r1 * decf); kfT[(32 + i) * 136 + j] = f2bf(r2 * decf);
                kbT[i * 136 + j] = f2bf(r1 * decb); kbT[(32 + i) * 136 + j] = f2bf(r2 * decb); }
            const unsigned vw[8] = {v1w.x, v1w.y, v1w.z, v1w.w, v2w.x, v2w.y, v2w.z, v2w.w};
#pragma unroll
            for (int ii = 0; ii < 8; ++ii) { vT[(16 * sub + 2 * ii) * 136 + j] = (bf16)(vw[ii] & 0xffffu); vT[(16 * sub + 2 * ii + 1) * 136 + j] = (bf16)(vw[ii] >> 16); }
        }
        __syncthreads();
        if (h + 1 < NHEAD) {
            k1w = *(const u32x4*)(zrow + ZC_RK + 64 * (h + 1) + 8 * sub); k2w = *(const u32x4*)(zrow + ZC_RK + 64 * (h + 1) + 32 + 8 * sub);
            v1w = *(const u32x4*)(zrow + ZC_RV + 64 * (h + 1) + 16 * sub); v2w = *(const u32x4*)(zrow + ZC_RV + 64 * (h + 1) + 16 * sub + 8); }
        {
            const int z = w >> 2, mt = w & 3; LAS bf16* kT = z ? kbT : kfT;
            f32x4 acc[4];
#pragma unroll
            for (int nt = 0; nt < 4; ++nt) acc[nt] = (f32x4){0.f, 0.f, 0.f, 0.f};
#pragma unroll
            for (int ks = 0; ks < 4; ++ks) { const bf16x8 af = *(const LAS bf16x8*)(vT + (16 * mt + fr) * 136 + 32 * ks + 8 * fq);
#pragma unroll
                for (int nt = 0; nt < 4; ++nt) { const bf16x8 bfg = *(const LAS bf16x8*)(kT + (16 * nt + fr) * 136 + 32 * ks + 8 * fq); acc[nt] = MFMA16(bfg, af, acc[nt]); } }
            bf16* U = (z ? C.UB : C.UF) + (size_t)n * USTRIDE + (size_t)(b * NHEAD + h) * 4096;
#pragma unroll
            for (int nt = 0; nt < 4; ++nt) { u32x2 o; o.x = pk2(acc[nt][0], acc[nt][1]); o.y = pk2(acc[nt][2], acc[nt][3]); *(u32x2*)(U + (16 * mt + fr) * 64 + 16 * nt + 4 * fq) = o; }
        }
        __syncthreads();
    }
}

__device__ __forceinline__ void ret_pass2(const Ctx& C, int l, int chunk, LAS unsigned char* lds) {
    int tid_ = threadIdx.x; asm volatile("" : "+v"(tid_)); const int tid = tid_, lane = tid & 63, w = tid >> 6, fr = lane & 15, fq = lane >> 4;
    LAS bf16* kr = (LAS bf16*)lds; LAS bf16* qr = kr + 128 * 72; LAS bf16* BT = qr + 128 * 72; LAS bf16* Ss = BT + 64 * 264;
    const int b = chunk >> 6, n = chunk & 63, row0 = chunk * CHUNK;
    const int j = tid >> 2, sub = tid & 3, e = tid >> 3, d0 = 8 * (tid & 7);
    const bf16* zrow = C.Z + (size_t)(row0 + j) * INW;
    const size_t uo0 = (size_t)n * USTRIDE + (size_t)(b * NHEAD) * 4096 + e * 64 + d0;
    u32x4 q1w = *(const u32x4*)(zrow + ZC_RQ + 8 * sub), q2w = *(const u32x4*)(zrow + ZC_RQ + 32 + 8 * sub);
    u32x4 k1w = *(const u32x4*)(zrow + ZC_RK + 8 * sub), k2w = *(const u32x4*)(zrow + ZC_RK + 32 + 8 * sub);
    u32x4 v1w = *(const u32x4*)(zrow + ZC_RV + 16 * sub), v2w = *(const u32x4*)(zrow + ZC_RV + 16 * sub + 8);
    u32x4 rfw = *(const u32x4*)(C.UF + uo0), rbw = *(const u32x4*)(C.UB + uo0);
    float cs[8], sn[8];
    { const float pos = (float)C.pos[row0 + j];
#pragma unroll
      for (int ii = 0; ii < 8; ++ii) rope_cs(pos, 8 * sub + ii, cs[ii], sn[ii]); }
#pragma unroll 1
    for (int h = 0; h < NHEAD; ++h) {
        const float lgm = log_gamma_h(h);
        {
            float q1[8], q2[8], k1[8], k2[8]; unpack8(q1w, q1); unpack8(q2w, q2); unpack8(k1w, k1); unpack8(k2w, k2);
            float oq1[8], oq2[8], ok1[8], ok2[8];
#pragma unroll
            for (int ii = 0; ii < 8; ++ii) { const float c = cs[ii], s = sn[ii];
                oq1[ii] = q1[ii] * c - q2[ii] * s; oq2[ii] = q2[ii] * c + q1[ii] * s;
                ok1[ii] = (k1[ii] * c - k2[ii] * s) * 0.125f; ok2[ii] = (k2[ii] * c + k1[ii] * s) * 0.125f; }
            *(LAS u32x4*)(qr + j * 72 + 8 * sub) = pack8(oq1); *(LAS u32x4*)(qr + j * 72 + 32 + 8 * sub) = pack8(oq2);
            *(LAS u32x4*)(kr + j * 72 + 8 * sub) = pack8(ok1); *(LAS u32x4*)(kr + j * 72 + 32 + 8 * sub) = pack8(ok2);
            const unsigned vw[8] = {v1w.x, v1w.y, v1w.z, v1w.w, v2w.x, v2w.y, v2w.z, v2w.w};
#pragma unroll
            for (int ii = 0; ii < 8; ++ii) { BT[(16 * sub + 2 * ii) * 264 + j] = (bf16)(vw[ii] & 0xffffu); BT[(16 * sub + 2 * ii + 1) * 264 + j] = (bf16)(vw[ii] >> 16); }
            *(LAS u32x4*)(BT + e * 264 + 128 + d0) = rfw; *(LAS u32x4*)(BT + e * 264 + 192 + d0) = rbw;
        }
        __syncthreads();
        if (h + 1 < NHEAD) {
            const int hn = h + 1; const size_t uo = uo0 + (size_t)hn * 4096;
            q1w = *(const u32x4*)(zrow + ZC_RQ + 64 * hn + 8 * sub); q2w = *(const u32x4*)(zrow + ZC_RQ + 64 * hn + 32 + 8 * sub);
            k1w = *(const u32x4*)(zrow + ZC_RK + 64 * hn + 8 * sub); k2w = *(const u32x4*)(zrow + ZC_RK + 64 * hn + 32 + 8 * sub);
            v1w = *(const u32x4*)(zrow + ZC_RV + 64 * hn + 16 * sub); v2w = *(const u32x4*)(zrow + ZC_RV + 64 * hn + 16 * sub + 8);
            rfw = *(const u32x4*)(C.UF + uo); rbw = *(const u32x4*)(C.UB + uo); }
        {
            const int i = 16 * w + fr;
            u32x2 gwv[4];
#pragma unroll
            for (int nt = 0; nt < 4; ++nt) gwv[nt] = *(const u32x2*)(C.Z + (size_t)(row0 + i) * INW + ZC_RG + 64 * h + 16 * nt + 4 * fq);
            bf16x8 qf[2];
#pragma unroll
            for (int ks = 0; ks < 2; ++ks) qf[ks] = *(const LAS bf16x8*)(qr + i * 72 + 32 * ks + 8 * fq);
            LAS bf16* Sw = Ss + w * 16 * 136;
#pragma unroll
            for (int nt = 0; nt < 8; ++nt) { f32x4 s = (f32x4){0.f, 0.f, 0.f, 0.f};
#pragma unroll
                for (int ks = 0; ks < 2; ++ks) { const bf16x8 kf = *(const LAS bf16x8*)(kr + (16 * nt + fr) * 72 + 32 * ks + 8 * fq); s = MFMA16(kf, qf[ks], s); }
                float sv[4];
#pragma unroll
                for (int r = 0; r < 4; ++r) { const int jj = 16 * nt + 4 * fq + r; sv[r] = s[r] * __expf(lgm * fabsf((float)(i - jj))); }
                u32x2 o; o.x = pk2(sv[0], sv[1]); o.y = pk2(sv[2], sv[3]);
                *(LAS u32x2*)(Sw + fr * 136 + 16 * nt + 4 * fq) = o; }
            asm volatile("s_waitcnt lgkmcnt(0)" ::: "memory");
            f32x4 a1[4], a2[4], a3[4];
#pragma unroll
            for (int nt = 0; nt < 4; ++nt) { a1[nt] = (f32x4){0.f, 0.f, 0.f, 0.f}; a2[nt] = a1[nt]; a3[nt] = a1[nt]; }
#pragma unroll
            for (int ks = 0; ks < 4; ++ks) { const bf16x8 sf = *(const LAS bf16x8*)(Sw + fr * 136 + 32 * ks + 8 * fq);
#pragma unroll
                for (int nt = 0; nt < 4; ++nt) { const bf16x8 bfr = *(const LAS bf16x8*)(BT + (16 * nt + fr) * 264 + 32 * ks + 8 * fq); a1[nt] = MFMA16(bfr, sf, a1[nt]); } }
#pragma unroll
            for (int ks = 0; ks < 2; ++ks)
#pragma unroll
                for (int nt = 0; nt < 4; ++nt) { const bf16x8 b2 = *(const LAS bf16x8*)(BT + (16 * nt + fr) * 264 + 128 + 32 * ks + 8 * fq); a2[nt] = MFMA16(b2, qf[ks], a2[nt]);
                    const bf16x8 b3 = *(const LAS bf16x8*)(BT + (16 * nt + fr) * 264 + 192 + 32 * ks + 8 * fq); a3[nt] = MFMA16(b3, qf[ks], a3[nt]); }
            const float sfw = __expf(lgm * (float)(i + 1)), sbw = __expf(lgm * (float)(CHUNK - i));
            float sum = 0.f;
#pragma unroll
            for (int nt = 0; nt < 4; ++nt) { a1[nt] = a1[nt] + a2[nt] * sfw + a3[nt] * sbw; sum += (a1[nt][0] + a1[nt][1]) + (a1[nt][2] + a1[nt][3]); }
            sum += __shfl_xor(sum, 16); sum += __shfl_xor(sum, 32);
            const float mean = sum * (1.f / 64.f); float q = 0.f;
#pragma unroll
            for (int nt = 0; nt < 4; ++nt) { a1[nt] = a1[nt] - mean; q += (a1[nt][0] * a1[nt][0] + a1[nt][1] * a1[nt][1]) + (a1[nt][2] * a1[nt][2] + a1[nt][3] * a1[nt][3]); }
            q += __shfl_xor(q, 16); q += __shfl_xor(q, 32);
            const float rstd = 1.f / sqrtf(q * (1.f / 64.f) + LN_EPS);
            f32x4 ggv[4], gbv[4];
#pragma unroll
            for (int nt = 0; nt < 4; ++nt) { ggv[nt] = *(const f32x4*)(C.ret_gn_g + l * GWID + 64 * h + 16 * nt + 4 * fq); gbv[nt] = *(const f32x4*)(C.ret_gn_b + l * GWID + 64 * h + 16 * nt + 4 * fq); }
            asm volatile("" ::: "memory");
#pragma unroll
            for (int nt = 0; nt < 4; ++nt) { const int e = 64 * h + 16 * nt + 4 * fq;
                const f32x4 gg = ggv[nt], gb = gbv[nt];
                float gf[4]; unpack4(gwv[nt], gf);
                float o[4];
#pragma unroll
                for (int r = 0; r < 4; ++r) o[r] = silu_f(gf[r]) * (a1[nt][r] * rstd * gg[r] + gb[r]);
                u32x2 ow; ow.x = pk2(o[0], o[1]); ow.y = pk2(o[2], o[3]);
                *(u32x2*)(C.Y + (size_t)(row0 + i) * DM + 256 + e) = ow; }
        }
        __syncthreads();
    }
}

#define LRU_SCAN_STEP(DIR, N) \
    "v_fmac_f32_dpp %4, %4, %0 " DIR ":" #N " row_mask:0xf bank_mask:0xf\n\t" "v_fmac_f32_dpp %5, %5, %1 " DIR ":" #N " row_mask:0xf bank_mask:0xf\n\t" \
    "v_fmac_f32_dpp %6, %6, %2 " DIR ":" #N " row_mask:0xf bank_mask:0xf\n\t" "v_fmac_f32_dpp %7, %7, %3 " DIR ":" #N " row_mask:0xf bank_mask:0xf\n\t" \
    "v_mul_f32_dpp %0, %0, %0 " DIR ":" #N " row_mask:0xf bank_mask:0xf\n\t" "v_mul_f32_dpp %1, %1, %1 " DIR ":" #N " row_mask:0xf bank_mask:0xf\n\t" \
    "v_mul_f32_dpp %2, %2, %2 " DIR ":" #N " row_mask:0xf bank_mask:0xf\n\t" "v_mul_f32_dpp %3, %3, %3 " DIR ":" #N " row_mask:0xf bank_mask:0xf\n\t"
#define LRU_SCAN4(DIR, a, b) asm volatile("s_nop 1\n\t" LRU_SCAN_STEP(DIR, 1) LRU_SCAN_STEP(DIR, 2) LRU_SCAN_STEP(DIR, 4) LRU_SCAN_STEP(DIR, 8) \
    : "+v"(a[0]), "+v"(a[1]), "+v"(a[2]), "+v"(a[3]), "+v"(b[0]), "+v"(b[1]), "+v"(b[2]), "+v"(b[3]))
template <int MODE, int Z>
__device__ __forceinline__ void lru_dir(const Ctx& C, int l, int b, int n, int row0, const LAS bf16* xa, int w, int fr, int fq, f32x4 (&hf)[8][2]) {
    const int hh = w >> 1, half = w & 1, cb = 64 * hh + 32 * half;
    const int lane = fq * 16 + fr, edge_src = (fq * 16 + (Z ? 0 : 15)) << 2;
    bf16x8 wa[2][2], wx[2][2];
    {
        const bf16* WTa = C.LRUW + (((size_t)l * 2 + 0) * 8 + Z * 4 + hh) * 4096; const bf16* WTx = C.LRUW + (((size_t)l * 2 + 1) * 8 + Z * 4 + hh) * 4096;
#pragma unroll
        for (int ntl = 0; ntl < 2; ++ntl)
#pragma unroll
            for (int ks = 0; ks < 2; ++ks) { wa[ntl][ks] = *(const bf16x8*)(WTa + (32 * half + 16 * ntl + fr) * 64 + 32 * ks + 8 * fq); wx[ntl][ks] = *(const bf16x8*)(WTx + (32 * half + 16 * ntl + fr) * 64 + 32 * ks + 8 * fq); }
    }
    f32x4 ba2[2], bx2[2], spv[2], hprev[2], Ap[2];
    const size_t co = ((size_t)(b * NCH + n) * 2 + Z) * GWID + cb + 4 * fq;
#pragma unroll
    for (int ntl = 0; ntl < 2; ++ntl) { const int ci = (l * 2 + Z) * GWID + cb + 16 * ntl + 4 * fq;
        ba2[ntl] = *(const f32x4*)(C.BA2 + ci); bx2[ntl] = *(const f32x4*)(C.BX2 + ci); spv[ntl] = *(const f32x4*)(C.SP + ci);
        hprev[ntl] = MODE ? *(const f32x4*)(C.CH + co + 16 * ntl) : (f32x4){0.f, 0.f, 0.f, 0.f}; Ap[ntl] = (f32x4){1.f, 1.f, 1.f, 1.f}; }
    u32x2 gpre[8][2];
    if (MODE && Z) {
#pragma unroll
        for (int mt = 0; mt < 8; ++mt)
#pragma unroll
            for (int ntl = 0; ntl < 2; ++ntl) gpre[mt][ntl] = *(const u32x2*)(C.Z + (size_t)(row0 + 16 * mt + fr) * INW + ZC_CG + cb + 16 * ntl + 4 * fq);
    }
#pragma unroll
    for (int i = 0; i < 8; ++i) { const int mt = Z ? 7 - i : i; const int t = 16 * mt + fr;
        bf16x8 af[2];
#pragma unroll
        for (int ks = 0; ks < 2; ++ks) af[ks] = *(const LAS bf16x8*)(xa + t * 264 + 64 * hh + 32 * ks + 8 * fq);
        f32x4 Av[2], Bv[2];
#pragma unroll
        for (int ntl = 0; ntl < 2; ++ntl) { f32x4 aa = ba2[ntl], ax = bx2[ntl];
#pragma unroll
            for (int ks = 0; ks < 2; ++ks) { aa = MFMA16(wa[ntl][ks], af[ks], aa); ax = MFMA16(wx[ntl][ks], af[ks], ax); }
            const u32x2 xw = *(const LAS u32x2*)(xa + t * 264 + cb + 16 * ntl + 4 * fq); const f32x4 xv = (f32x4){bflo(xw.x), bfhi(xw.x), bflo(xw.y), bfhi(xw.y)};
#pragma unroll
            for (int r = 0; r < 4; ++r) { const float rg = __builtin_amdgcn_rcpf(1.0f + __builtin_amdgcn_exp2f(aa[r])), ig = __builtin_amdgcn_rcpf(1.0f + __builtin_amdgcn_exp2f(ax[r]));
                const float a = __builtin_amdgcn_exp2f(spv[ntl][r] * rg);
                Av[ntl][r] = a; Bv[ntl][r] = xv[r] * ig * __builtin_amdgcn_sqrtf(fmaf(-a, a, 1.0f)); } }
        {
            if (Z == 0) { LRU_SCAN4("row_shr", Av[0], Bv[0]); LRU_SCAN4("row_shr", Av[1], Bv[1]); } else { LRU_SCAN4("row_shl", Av[0], Bv[0]); LRU_SCAN4("row_shl", Av[1], Bv[1]); }
        }
#pragma unroll
        for (int ntl = 0; ntl < 2; ++ntl) {
            f32x4 cin;
#pragma unroll
            for (int r = 0; r < 4; ++r) cin[r] = __int_as_float(__builtin_amdgcn_ds_bpermute(edge_src, __float_as_int(hprev[ntl][r])));
            const f32x4 hv = Bv[ntl] + Av[ntl] * cin;
            hprev[ntl] = hv; Ap[ntl] = Ap[ntl] * Av[ntl];
            if (MODE) {
                if (Z == 0) hf[mt][ntl] = hv;
                else { const f32x4 hs = hf[mt][ntl] + hv;
                    float gf[4]; unpack4(gpre[mt][ntl], gf);
                    u32x2 ow; ow.x = pk2(hs[0] * gelu_f(gf[0]), hs[1] * gelu_f(gf[1])); ow.y = pk2(hs[2] * gelu_f(gf[2]), hs[3] * gelu_f(gf[3]));
                    *(u32x2*)(C.Y + (size_t)(row0 + t) * DM + 512 + cb + 16 * ntl + 4 * fq) = ow; }
            }
        }
    }
    if (!MODE && fr == (Z ? 0 : 15)) {
#pragma unroll
        for (int ntl = 0; ntl < 2; ++ntl) { *(f32x4*)(C.CA + co + 16 * ntl) = Ap[ntl]; *(f32x4*)(C.CH + co + 16 * ntl) = hprev[ntl]; } }
    (void)lane;
}
template <int MODE>
__device__ __forceinline__ void lru_pass(const Ctx& C, int l, int chunk, LAS unsigned char* lds) {
    int tid_ = threadIdx.x; asm volatile("" : "+v"(tid_)); const int tid = tid_, lane = tid & 63, w = tid >> 6, fr = lane & 15, fq = lane >> 4;
    LAS bf16* xa = (LAS bf16*)lds;
    const int b = chunk >> 6, n = chunk & 63, row0 = chunk * CHUNK;
    {
        const int cg8 = (tid & 31) * 8, t0 = (tid >> 5) * 8;
        float wk[4][8], bias[8];
#pragma unroll
        for (int k = 0; k < 4; ++k) { const float* wp = C.lru_conv_w + (size_t)(l * 4 + k) * GWID + cg8; const f32x4 w0 = *(const f32x4*)wp, w1 = *(const f32x4*)(wp + 4);
            wk[k][0] = w0[0]; wk[k][1] = w0[1]; wk[k][2] = w0[2]; wk[k][3] = w0[3]; wk[k][4] = w1[0]; wk[k][5] = w1[1]; wk[k][6] = w1[2]; wk[k][7] = w1[3]; }
        { const f32x4 b0 = *(const f32x4*)(C.lru_conv_b + l * GWID + cg8), b1 = *(const f32x4*)(C.lru_conv_b + l * GWID + cg8 + 4);
          bias[0] = b0[0]; bias[1] = b0[1]; bias[2] = b0[2]; bias[3] = b0[3]; bias[4] = b1[0]; bias[5] = b1[1]; bias[6] = b1[2]; bias[7] = b1[3]; }
        float xr[11][8];
#pragma unroll
        for (int r = 0; r < 11; ++r) { const int sq = n * CHUNK + t0 - 2 + r; u32x4 w = (u32x4){0u, 0u, 0u, 0u};
            if (sq >= 0 && sq < SEQ) w = *(const u32x4*)(C.Z + (size_t)(b * SEQ + sq) * INW + ZC_CX + cg8);
            unpack8(w, xr[r]); }
#pragma unroll
        for (int tt = 0; tt < 8; ++tt) { float acc[8];
#pragma unroll
            for (int c = 0; c < 8; ++c) acc[c] = bias[c] + ((wk[0][c] * xr[tt][c] + wk[1][c] * xr[tt + 1][c]) + (wk[2][c] * xr[tt + 2][c] + wk[3][c] * xr[tt + 3][c]));
            *(LAS u32x4*)(xa + (t0 + tt) * 264 + cg8) = pack8(acc); }
    }
    __syncthreads();
    f32x4 hf[8][2];
    lru_dir<MODE, 0>(C, l, b, n, row0, xa, w, fr, fq, hf);
    lru_dir<MODE, 1>(C, l, b, n, row0, xa, w, fr, fq, hf);
    __syncthreads();
}

__device__ __forceinline__ void sc_chunk(const Ctx& C, int l, int chunk) {
    int tid_ = threadIdx.x; asm volatile("" : "+v"(tid_)); const int tid = tid_; const int b = chunk >> 6, n = chunk & 63, row0 = chunk * CHUNK;
    const int c8 = (tid & 31) * 8, t0 = (tid >> 5) * 8;
    float wk[3][8];
#pragma unroll
    for (int k = 0; k < 3; ++k) { const float* wp = C.sc_conv_w + (size_t)(l * 3 + k) * GWID + c8; const f32x4 w0 = *(const f32x4*)wp, w1 = *(const f32x4*)(wp + 4);
        wk[k][0] = w0[0]; wk[k][1] = w0[1]; wk[k][2] = w0[2]; wk[k][3] = w0[3]; wk[k][4] = w1[0]; wk[k][5] = w1[1]; wk[k][6] = w1[2]; wk[k][7] = w1[3]; }
    float ch[10][8];
#pragma unroll
    for (int r = 0; r < 10; ++r) { const int sq = n * CHUNK + t0 - 1 + r; u32x4 cw = (u32x4){0u, 0u, 0u, 0u}, hw = cw;
        if (sq >= 0 && sq < SEQ) { const bf16* zr = C.Z + (size_t)(b * SEQ + sq) * INW; cw = *(const u32x4*)(zr + ZC_DC + c8); hw = *(const u32x4*)(zr + ZC_DH + c8); }
        float cf[8], hf[8]; unpack8(cw, cf); unpack8(hw, hf);
#pragma unroll
        for (int i = 0; i < 8; ++i) ch[r][i] = cf[i] * hf[i]; }
#pragma unroll
    for (int tt = 0; tt < 8; ++tt) { const u32x4 bw = *(const u32x4*)(C.Z + (size_t)(row0 + t0 + tt) * INW + ZC_DB + c8); float bf_[8]; unpack8(bw, bf_);
        float acc[8];
#pragma unroll
        for (int i = 0; i < 8; ++i) acc[i] = bf_[i] * (wk[0][i] * ch[tt][i] + wk[1][i] * ch[tt + 1][i] + wk[2][i] * ch[tt + 2][i]);
        *(u32x4*)(C.Y + (size_t)(row0 + t0 + tt) * DM + 768 + c8) = pack8(acc); }
}

__device__ __forceinline__ void carry_phase(const Ctx& C) {
    int tid_ = threadIdx.x; asm volatile("" : "+v"(tid_)); const int gt = blockIdx.x * 512 + tid_, NT = gridDim.x * 512;
    for (int i2 = gt; i2 < (int)USTRIDE / 2; i2 += NT) { const int idx = 2 * i2, h = (idx >> 12) & 3;
        const float cd = __expf(log_gamma_h(h) * (float)CHUNK);
        unsigned* pf = (unsigned*)(C.UF + idx); unsigned* pb = (unsigned*)(C.UB + idx); float sf0 = 0.f, sf1 = 0.f, sb0 = 0.f, sb1 = 0.f;
#pragma unroll 1
        for (int n8 = 0; n8 < NCH; n8 += 8) { unsigned uf[8], ub[8];
#pragma unroll
            for (int i = 0; i < 8; ++i) { uf[i] = pf[(size_t)(n8 + i) * (USTRIDE / 2)]; ub[i] = pb[(size_t)(NCH - 1 - n8 - i) * (USTRIDE / 2)]; }
#pragma unroll
            for (int i = 0; i < 8; ++i) { pf[(size_t)(n8 + i) * (USTRIDE / 2)] = pk2(sf0, sf1); sf0 = cd * sf0 + bflo(uf[i]); sf1 = cd * sf1 + bfhi(uf[i]);
                pb[(size_t)(NCH - 1 - n8 - i) * (USTRIDE / 2)] = pk2(sb0, sb1); sb0 = cd * sb0 + bflo(ub[i]); sb1 = cd * sb1 + bfhi(ub[i]); } }
    }
    if (gt < BATCH * 512) { const int b = gt >> 9, zc = gt & 511, z = zc >> 8; float st = 0.f;
#pragma unroll 1
        for (int n8 = 0; n8 < NCH; n8 += 8) { float a[8], hh[8];
#pragma unroll
            for (int i = 0; i < 8; ++i) { const int n = z ? NCH - 1 - n8 - i : n8 + i; const size_t o = (size_t)(b * NCH + n) * 512 + zc; a[i] = C.CA[o]; hh[i] = C.CH[o]; }
#pragma unroll
            for (int i = 0; i < 8; ++i) { const int n = z ? NCH - 1 - n8 - i : n8 + i; const size_t o = (size_t)(b * NCH + n) * 512 + zc; C.CH[o] = st; st = a[i] * st + hh[i]; } } }
}

#define RLX_AGENT __ATOMIC_RELAXED, __HIP_MEMORY_SCOPE_AGENT
#define XB_TMO      128
#define XB_XCNT(j)  (256  + 64 * (j))
#define XB_XSUB(j)  (1280 + 64 * (j))
#define XB_XGEN(j)  (2304 + 64 * (j))
#define XB_TOP      3328
#define XB_TOPGEN   3392
#define XCD_BAR_WORDS 3456
#define XB_SPIN_CAP (1u << 18)

__device__ __forceinline__ unsigned xb_ld(unsigned* p)              { return __hip_atomic_load(p, __ATOMIC_RELAXED, __HIP_MEMORY_SCOPE_AGENT); }
__device__ __forceinline__ unsigned xb_add(unsigned* p, unsigned v) { return __hip_atomic_fetch_add(p, v, __ATOMIC_RELAXED, __HIP_MEMORY_SCOPE_AGENT); }
__device__ __forceinline__ unsigned xb_xcc_id() { return (unsigned)__builtin_amdgcn_s_getreg((3 << 11) | 20) & 0xFu; }
#define XB_SPIN(cond, bar) do { unsigned _sp = 0; while (cond) { __builtin_amdgcn_s_sleep(1); \
    if ((++_sp & 255u) == 0u) { if (xb_ld(&(bar)[XB_TMO])) break; if (_sp > XB_SPIN_CAP) { atomicAdd(&(bar)[XB_TMO], 1u); break; } } } } while (0)

struct XcdBarrier {
    unsigned* bar; unsigned x;
    volatile LAS unsigned* st;
};

__device__ __forceinline__ XcdBarrier xcd_barrier_post(unsigned* bar, volatile LAS unsigned* st) {
    XcdBarrier b; b.bar = bar; b.x = xb_xcc_id(); b.st = st;
    if (threadIdx.x == 0) (void)xb_add(&bar[XB_XCNT(b.x)], 1u);
    return b;
}
__device__ __forceinline__ void xcd_barrier_complete(unsigned* bar, unsigned x, unsigned& nloc, unsigned& nx) {
    const unsigned G = gridDim.x * gridDim.y * gridDim.z;
    unsigned sum, cnt, mine, sp = 0u;
    for (;;) {
        sum = 0u; cnt = 0u; mine = 0u;
#pragma unroll
        for (unsigned j = 0; j < 16; ++j) { const unsigned c = xb_ld(&bar[XB_XCNT(j)]); sum += c; cnt += (c > 0u) ? 1u : 0u; mine = (j == x) ? c : mine; }
        if (sum == G) break;
        __builtin_amdgcn_s_sleep(1);
        if ((++sp & 255u) == 0u) { if (xb_ld(&bar[XB_TMO])) break; if (sp > XB_SPIN_CAP) { atomicAdd(&bar[XB_TMO], 1u); break; } }
    }
    nloc = mine > 0u ? mine : 1u; nx = cnt > 0u ? cnt : 1u;
}

__device__ __forceinline__ void xcd_barrier(const XcdBarrier& b) {
    asm volatile("s_waitcnt vmcnt(0)" ::: "memory");
    __syncthreads();
    if (threadIdx.x == 0) {
        unsigned* bar = b.bar;
        __builtin_amdgcn_s_waitcnt(0);
        unsigned nloc = b.st[0], nx = b.st[1];
        if (nloc == 0u) { xcd_barrier_complete(bar, b.x, nloc, nx); b.st[0] = nloc; b.st[1] = nx; }
        const unsigned old = xb_add(&bar[XB_XSUB(b.x)], 1u);
        const unsigned gen = old / nloc;
        if (old + 1u == (gen + 1u) * nloc) {
            __builtin_amdgcn_fence(__ATOMIC_RELEASE, "agent");
            asm volatile("s_waitcnt vmcnt(0)" ::: "memory");
            const unsigned og = xb_add(&bar[XB_TOP], 1u);
            const unsigned tg = og / nx;
            if (og + 1u == (tg + 1u) * nx) xb_add(&bar[XB_TOPGEN], 1u);
            else XB_SPIN(xb_ld(&bar[XB_TOPGEN]) == tg, bar);
            __builtin_amdgcn_fence(__ATOMIC_ACQUIRE, "agent");
            xb_add(&bar[XB_XGEN(b.x)], 1u);
            asm volatile("s_waitcnt vmcnt(0)" ::: "memory");
        } else {
            XB_SPIN(xb_ld(&bar[XB_XGEN(b.x)]) == gen, bar);
            __builtin_amdgcn_fence(__ATOMIC_ACQUIRE, "agent");
            asm volatile("s_waitcnt vmcnt(0)" ::: "memory");
        }
    }
    __syncthreads();
}

#ifndef STAG_TICKS
#define STAG_TICKS 0
#endif
__device__ __forceinline__ void xcd_stagger(unsigned x, unsigned ticks) {
    const unsigned long long t0 = __builtin_amdgcn_s_memrealtime(), dt = (unsigned long long)x * ticks;
    while (__builtin_amdgcn_s_memrealtime() - t0 < dt) __builtin_amdgcn_s_sleep(4);
}
#ifndef DUP_MIX
#define DUP_MIX 0
#endif
#ifndef DUP_G13
#define DUP_G13 0
#endif
#ifndef DUP_G2
#define DUP_G2 0
#endif
#ifndef REV_G4
#define REV_G4 1
#endif
#ifndef DUP_G3
#define DUP_G3 0
#endif
#ifndef DUP_G4
#define DUP_G4 0
#endif
#ifndef DUP_CARRY
#define DUP_CARRY 0
#endif
#ifndef DUP_LRU
#define DUP_LRU 0
#endif
#ifndef DUP_RET
#define DUP_RET 0
#endif
#ifndef DUP_GS
#define DUP_GS 0
#endif
#ifndef DUP_PRO
#define DUP_PRO 0
#endif
#define GRID_SYNC() do { asm volatile("s_waitcnt vmcnt(0) lgkmcnt(0)" ::: "memory"); grid.sync(); __builtin_amdgcn_fence(__ATOMIC_ACQUIRE, "agent"); asm volatile("s_waitcnt vmcnt(0)" ::: "memory"); } while (0)
typedef const __attribute__((address_space(4))) Args* KArgP;
__device__ __forceinline__ KArgP launder(KArgP p) { asm volatile("" : "+s"(p)); return p; }
__device__ __forceinline__ Ctx make_ctx(KArgP ap) {
    const __attribute__((address_space(4))) Args& args = *ap;
    Ctx C;
    C.x = (const float*)args.in[0]; C.pos = (const int*)args.in[1]; C.w_in = (const float*)args.in[2]; C.gmlp_ln_g = (const float*)args.in[3]; C.gmlp_ln_b = (const float*)args.in[4];
    C.gmlp_ws = (const float*)args.in[5]; C.gmlp_bs = (const float*)args.in[6]; C.ret_gn_g = (const float*)args.in[7]; C.ret_gn_b = (const float*)args.in[8];
    C.lru_conv_w = (const float*)args.in[9]; C.lru_conv_b = (const float*)args.in[10]; C.lru_wa = (const float*)args.in[11]; C.lru_ba = (const float*)args.in[12];
    C.lru_wx = (const float*)args.in[13]; C.lru_bx = (const float*)args.in[14]; C.lru_lambda = (const float*)args.in[15]; C.sc_conv_w = (const float*)args.in[16];
    C.w_out = (const float*)args.in[17]; C.ln1_g = (const float*)args.in[18]; C.ln1_b = (const float*)args.in[19]; C.ffn_wg = (const float*)args.in[20]; C.ffn_wu = (const float*)args.in[21];
    C.ffn_wd = (const float*)args.in[22]; C.ln2_g = (const float*)args.in[23]; C.ln2_b = (const float*)args.in[24];
    C.out = args.out; unsigned char* ws = args.ws;
    C.WIN = (bf16*)(ws + OFF_WIN); C.WOUT = (bf16*)(ws + OFF_WOUT); C.WGU = (bf16*)(ws + OFF_WGU); C.WD = (bf16*)(ws + OFF_WD); C.LRUW = (bf16*)(ws + OFF_LRUW);
    C.XB = (bf16*)(ws + OFF_XB); C.Z = (bf16*)(ws + OFF_Z); C.Y = (bf16*)(ws + OFF_Y); C.UF = (bf16*)(ws + OFF_UF); C.UB = (bf16*)(ws + OFF_UB); C.CA = (float*)(ws + OFF_CA); C.CH = (float*)(ws + OFF_CH); C.SP = (float*)(ws + OFF_SP); C.BA2 = C.SP + DEPTH * 2 * GWID; C.BX2 = C.SP + 2 * DEPTH * 2 * GWID; C.S1 = (float*)(ws + OFF_S1); C.T1 = (float*)(ws + OFF_T1); C.S3 = (float*)(ws + OFF_S3); C.T3 = (float*)(ws + OFF_T3); C.WSB = (bf16*)(ws + OFF_WSB); C.P0 = (long long*)(ws + OFF_P0); C.P1 = (long long*)(ws + OFF_P1);
    return C;
}
__global__ void __launch_bounds__(512) hybrid_fwd(Args args) {
    extern __shared__ __attribute__((aligned(16))) unsigned char lds_raw[];
    LAS unsigned char* lds = (LAS unsigned char*)lds_raw;
    cg::grid_group grid = cg::this_grid();
    (void)args; const KArgP ap0 = (KArgP)__builtin_amdgcn_kernarg_segment_ptr();
    unsigned char* const args_ws_ptr = ap0->ws;
    const int G = gridDim.x;
    if (threadIdx.x < 64) ((LAS unsigned*)(lds + LDS_MISC_OFF))[threadIdx.x] = 0u;
    __syncthreads();
    const XcdBarrier bar = xcd_barrier_post((unsigned*)(args_ws_ptr + OFF_CTL), (volatile LAS unsigned*)(lds + LDS_MISC_OFF));

    for (int q = 0; q <= DUP_PRO; ++q) { const Ctx C = make_ctx(launder(ap0)); prologue(C, lds); __syncthreads(); }
    if (G > 1024) GRID_SYNC();
    else xcd_barrier(bar);
#pragma unroll 1
    for (int l = 0; l < DEPTH; ++l) {
        {
            const Ctx C = make_ctx(launder(ap0));
            pg8::Gemm g{C.XB, C.WIN + (size_t)l * INW * DM, M, INW, DM}; pg8::StaticOrder S; S.init(M, INW, G, (int)blockIdx.x);
            EpiLnBf16 E{C.Z, INW, C.P0, C.S1 + l * INW, C.T1 + l * INW, l ? 1 : 0};
#pragma unroll 1
            for (int rep = 0; rep <= DUP_G13; ++rep)
            pg8::gemm_phase<EpiLnBf16, pg8::StaticOrder, true, true>(lds, g, S, E);
        }
        xcd_barrier(bar);
#pragma unroll 1
        for (int rep = 0; rep <= DUP_MIX; ++rep)
#pragma unroll 1
        for (int c = blockIdx.x; c < NCHUNK; c += G) {
            for (int q = 0; q <= DUP_GS; ++q) { const Ctx C = make_ctx(launder(ap0)); gmlp_chunk(C, l, c, lds); }
            for (int q = 0; q <= DUP_RET; ++q) { const Ctx C = make_ctx(launder(ap0)); ret_pass1(C, c, lds); }
            for (int q = 0; q <= DUP_LRU; ++q) { const Ctx C = make_ctx(launder(ap0)); lru_pass<0>(C, l, c, lds); }
            for (int q = 0; q <= DUP_GS; ++q) { const Ctx C = make_ctx(launder(ap0)); sc_chunk(C, l, c); } }
        xcd_barrier(bar);
        { const Ctx C = make_ctx(launder(ap0)); carry_phase(C); zero_rows(C.P1); }
        xcd_barrier(bar);
#pragma unroll 1
        for (int rep = 0; rep <= DUP_MIX; ++rep)
#pragma unroll 1
        for (int c = blockIdx.x; c < NCHUNK; c += G) {
            for (int q = 0; q <= DUP_RET; ++q) { const Ctx C = make_ctx(launder(ap0)); ret_pass2(C, l, c, lds); }
            for (int q = 0; q <= DUP_LRU; ++q) { const Ctx C = make_ctx(launder(ap0)); lru_pass<1>(C, l, c, lds); } }
        xcd_barrier(bar);
        {
            const Ctx C = make_ctx(launder(ap0));
            pg8::Gemm g{C.Y, C.WOUT + (size_t)l * DM * DM, M, DM, DM}; pg8::StaticOrder S; S.init(M, DM, G, (int)blockIdx.x);
            stage_gain_bias((LAS float*)(lds + LDS_GB_OFF), C.ln2_g + (l ? l - 1 : 0) * DM, C.ln2_b + (l ? l - 1 : 0) * DM, l == 0 ? 1 : 0);
            if (l == 0) { EpiResLn<1> E{C.x, C.out, C.XB, C.XB, C.P0, (const LAS float*)(lds + LDS_GB_OFF), C.P1, 0, DN_ALPHA};
                pg8::gemm_phase<EpiResLn<1>, pg8::StaticOrder, true, true>(lds, g, S, E); }
            else { EpiResLn<0> E{C.x, C.out, C.XB, C.XB, C.P0, (const LAS float*)(lds + LDS_GB_OFF), C.P1, 0, DN_ALPHA};
                pg8::gemm_phase<EpiResLn<0>, pg8::StaticOrder, true, true>(lds, g, S, E); }
        }
        xcd_barrier(bar);
        {
            const Ctx C = make_ctx(launder(ap0));
            zero_rows(C.P0);
            pg8::Gemm g{C.XB, C.WGU + (size_t)l * 2 * DFF * DM, M, 2 * DFF, DM}; pg8::StaticOrder S; S.init(M, 2 * DFF, G, (int)blockIdx.x);
            EpiSwiGLU E{C.Z, C.P1, C.S3 + l * 2 * DFF, C.T3 + l * 2 * DFF};
            pg8::gemm_phase<EpiSwiGLU, pg8::StaticOrder, true, true>(lds, g, S, E);
        }
        xcd_barrier(bar);
        {
            const Ctx C = make_ctx(launder(ap0));
            pg8::Gemm g{C.Z, C.WD + (size_t)l * DM * DFF, M, DM, DFF}; pg8::StaticOrder S; S.init(M, DM, G, (int)blockIdx.x, REV_G4);
            stage_gain_bias((LAS float*)(lds + LDS_GB_OFF), C.ln1_g + l * DM, C.ln1_b + l * DM, 0);
            EpiResLn<0> E{C.x, C.out, C.XB, C.XB, C.P1, (const LAS float*)(lds + LDS_GB_OFF), C.P0, l + 1 == DEPTH ? 1 : 0, DN_ALPHA};
            pg8::gemm_phase<EpiResLn<0>, pg8::StaticOrder, true, true>(lds, g, S, E);
        }
        xcd_barrier(bar);
    }
    { const Ctx C = make_ctx(launder(ap0)); final_ln(C.out, C.P0, C.ln2_g + (DEPTH - 1) * DM, C.ln2_b + (DEPTH - 1) * DM); }
}

extern "C" void kernel_launch(void* const* d_in, const int* in_sizes, int n_in, void* d_out, int out_size, void* d_ws, size_t ws_size, hipStream_t stream) {
    static int grid = 0;
    if (grid == 0) {
        if (n_in != 25 || out_size != M * DM || ws_size < WS_END) { fprintf(stderr, "kernel_launch: unexpected shapes (n_in %d out %d ws %zu need %zu)\n", n_in, out_size, ws_size, (size_t)WS_END); grid = -1; return; }
        int dev = 0, cus = 0, per_cu = 0;
        (void)hipGetDevice(&dev); (void)hipDeviceGetAttribute(&cus, hipDeviceAttributeMultiprocessorCount, dev);
        if (hipFuncSetAttribute((const void*)hybrid_fwd, hipFuncAttributeMaxDynamicSharedMemorySize, LDS_BYTES) != hipSuccess) { fprintf(stderr, "kernel_launch: hipFuncSetAttribute failed\n"); grid = -1; return; }
        if (hipOccupancyMaxActiveBlocksPerMultiprocessor(&per_cu, (const void*)hybrid_fwd, 512, LDS_BYTES) != hipSuccess || per_cu < 1) { fprintf(stderr, "kernel_launch: occupancy query says %d\n", per_cu); per_cu = 1; }
        (void)hipGetLastError();
        grid = cus * per_cu; if (grid > 256) grid = 256; if (grid < 1) grid = 256;
    }
    if (grid < 0) return;
    if (hipMemsetAsync((char*)d_ws + OFF_CTL, 0, CTL_BYTES, stream) != hipSuccess) { fprintf(stderr, "kernel_launch: memset failed\n"); return; }
    Args a{};
    for (int i = 0; i < 25; ++i) a.in[i] = d_in[i];
    a.out = (float*)d_out; a.ws = (unsigned char*)d_ws;
    void* kargs[] = {&a};
    hipError_t e = hipLaunchCooperativeKernel((const void*)hybrid_fwd, dim3(grid), dim3(512), kargs, LDS_BYTES, stream);
    if (e != hipSuccess) fprintf(stderr, "cooperative launch failed: %s (grid %d)\n", hipGetErrorString(e), grid);
}
```
